# Optimizing an MI355X kernel written in HIP

```python
import math
import jax, jax.numpy as jnp
from jax import lax
import numpy as np

D_MODEL = 1024
BATCH = 16
SEQ = 2048
DEPTH = 4

HEAD_DIM = 64
N_HEADS_DIL = 6
N_HEADS_DSA = 4
N_HEADS_MLA = 6
MIX_WIDTH = (N_HEADS_DIL + N_HEADS_DSA + N_HEADS_MLA) * HEAD_DIM
DILATIONS = ((128, 1), (512, 4), (2048, 16))
IDX_HEADS = 8
IDX_DIM = 64
DSA_TOPK = 256
Q_BLOCK = 128
MLA_Q_RANK = 256
MLA_KV_RANK = 128
MLA_NOPE = 64
MLA_ROPE = 32
MLA_V = 64
ROPE_THETA = 10000.0
N_BUCKETS = 32
MAX_DISTANCE = 2048
N_BIAS_HEADS = N_HEADS_DIL + N_HEADS_DSA
N_EXPERTS = 64
TOP_K = 8
EXPERT_FF = 256
SHARED_FF = 256
ROUTED_SCALE = 2.5
MOE_BLOCK = 128
DN_ALPHA = (2 * DEPTH) ** 0.25
DN_BETA = (8 * DEPTH) ** -0.25
LN_EPS = 1e-5
RMS_EPS = 1e-6

IN_SIZES = (
    N_HEADS_DIL * HEAD_DIM, N_HEADS_DIL * HEAD_DIM, N_HEADS_DIL * HEAD_DIM,
    N_HEADS_DSA * HEAD_DIM, N_HEADS_DSA * HEAD_DIM, N_HEADS_DSA * HEAD_DIM,
    IDX_HEADS * IDX_DIM, IDX_DIM, IDX_HEADS,
    MLA_Q_RANK, MLA_KV_RANK, MLA_ROPE,
)
VALUE_SEGMENTS = (2, 5)
IN_WIDTH = sum(IN_SIZES)

kernel_name = "hybrid_dilated_dsa_mla_moe"

F32 = jnp.float32


def layer_norm(x, g, b):
    xf = x.astype(F32)
    mu = jnp.mean(xf, -1, keepdims=True)
    var = jnp.mean(jnp.square(xf - mu), -1, keepdims=True)
    return ((xf - mu) * lax.rsqrt(var + LN_EPS) * g + b).astype(x.dtype)


def rms_norm(x, g):
    xf = x.astype(F32)
    return (xf * lax.rsqrt(jnp.mean(jnp.square(xf), -1, keepdims=True) + RMS_EPS) * g).astype(x.dtype)


def t5_bucket(dist):
    max_exact = N_BUCKETS // 2
    d_f = jnp.maximum(dist, 1).astype(F32)
    large = max_exact + (jnp.log(d_f / max_exact) / math.log(MAX_DISTANCE / max_exact)
                         * (N_BUCKETS - max_exact)).astype(jnp.int32)
    large = jnp.minimum(large, N_BUCKETS - 1)
    return jnp.where(dist < max_exact, dist, large)


def apply_rope(x, cos, sin):
    half = x.shape[-1] // 2
    x1, x2 = x[..., :half].astype(F32), x[..., half:].astype(F32)
    return jnp.concatenate([x1 * cos - x2 * sin, x2 * cos + x1 * sin], -1).astype(x.dtype)


def split_cols(u):
    out, start = [], 0
    for n in IN_SIZES:
        out.append(u[..., start:start + n])
        start += n
    return out


def dilated_branch(q, k, v, dilation, span, table):
    B, S, H, E = q.shape
    Ls = S // dilation
    nb = -(-Ls // span)
    Lp = nb * span

    def strided(t):
        t = t.reshape(B, Ls, dilation, H, E).transpose(0, 2, 1, 3, 4)
        t = jnp.pad(t, ((0, 0), (0, 0), (0, Lp - Ls), (0, 0), (0, 0)))
        return t.reshape(B, dilation, nb, span, H, E)

    def band(t):
        prev = jnp.pad(t[:, :, :-1], ((0, 0), (0, 0), (1, 0), (0, 0), (0, 0), (0, 0)))
        return jnp.concatenate([prev, t], axis=3)

    qs = strided(q)
    kb, vb = band(strided(k)), band(strided(v))
    qi = jnp.arange(span)[:, None]
    kj = jnp.arange(2 * span)[None, :]
    delta = span + qi - kj
    in_band = (delta >= 0) & (delta <= span)
    has_prev = (jnp.arange(nb)[:, None, None] > 0) | (kj >= span)[None]
    valid = in_band[None] & has_prev
    bias = table[t5_bucket(jnp.maximum(delta, 0) * dilation)].transpose(2, 0, 1)
    logits = jnp.einsum('brnqhe,brnkhe->brnhqk', qs, kb, preferred_element_type=F32) * (HEAD_DIM ** -0.5)
    logits = jnp.where(valid[:, None], logits + bias, -jnp.inf)
    lse = jax.nn.logsumexp(logits, axis=-1)
    p = jnp.exp(logits - lse[..., None])
    o = jnp.einsum('brnhqk,brnkhe->brnqhe', p.astype(v.dtype), vb, preferred_element_type=F32)

    def unstride(t):
        t = t.reshape(B, dilation, Lp, *t.shape[4:])[:, :, :Ls]
        return jnp.swapaxes(t, 1, 2).reshape(B, S, *t.shape[3:])

    return unstride(o), unstride(jnp.swapaxes(lse, 3, 4))


def dilated_mixture(q, k, v, table):
    outs, lses = [], []
    for window, dilation in DILATIONS:
        o, l = dilated_branch(q, k, v, dilation, window // dilation, table)
        outs.append(o)
        lses.append(l)
    wts = jax.nn.softmax(jnp.stack(lses), axis=0)
    return jnp.einsum('gbsh,gbshe->bshe', wts, jnp.stack(outs)).astype(q.dtype)


def dsa_attention(q, k, v, iq, ik, iw, table):
    B, S, H, E = q.shape
    n_sel = min(DSA_TOPK, S // 4)
    nq = S // Q_BLOCK
    key_pos = jnp.arange(S)
    gather = jax.vmap(lambda t, i: t[i])

    def to_blocks(t):
        return jnp.swapaxes(t.reshape(B, nq, Q_BLOCK, *t.shape[2:]), 0, 1)

    def block(args):
        qb, iqb, iwb, start = args
        t = start + jnp.arange(Q_BLOCK)
        causal = key_pos[None, :] <= t[:, None]
        rel = jax.nn.relu(jnp.einsum('bqhe,bse->bqhs', iqb, ik, preferred_element_type=F32))
        score = jnp.einsum('bqh,bqhs->bqs', iwb.astype(F32), rel)
        score = jnp.where(causal[None], score, -jnp.inf)
        _, idx = lax.top_k(score, n_sel)
        valid = idx <= t[None, :, None]
        ksel, vsel = gather(k, idx), gather(v, idx)
        bias = table[t5_bucket(jnp.maximum(t[None, :, None] - idx, 0))]
        logits = jnp.einsum('bqhe,bqkhe->bqhk', qb, ksel, preferred_element_type=F32) * (HEAD_DIM ** -0.5)
        logits = jnp.where(valid[:, :, None, :], logits + jnp.swapaxes(bias, 2, 3), -jnp.inf)
        p = jax.nn.softmax(logits, axis=-1)
        return jnp.einsum('bqhk,bqkhe->bqhe', p.astype(v.dtype), vsel, preferred_element_type=F32)

    out = lax.map(block, (to_blocks(q), to_blocks(iq), to_blocks(iw), jnp.arange(nq) * Q_BLOCK))
    return jnp.swapaxes(out, 0, 1).reshape(B, S, H, E).astype(q.dtype)


def mla_attention(cq, ckv, k_rope, positions, q_norm, w_uq, kv_norm, w_ukv):
    B, S, _ = cq.shape
    q = (rms_norm(cq, q_norm) @ w_uq).reshape(B, S, N_HEADS_MLA, MLA_NOPE + MLA_ROPE)
    kv = (rms_norm(ckv, kv_norm) @ w_ukv).reshape(B, S, N_HEADS_MLA, MLA_NOPE + MLA_V)
    inv = ROPE_THETA ** (-jnp.arange(0, MLA_ROPE, 2, dtype=F32) / MLA_ROPE)
    ang = positions.astype(F32)[..., None] * inv
    cos, sin = jnp.cos(ang), jnp.sin(ang)
    q_nope = q[..., :MLA_NOPE]
    q_rope = apply_rope(q[..., MLA_NOPE:], cos[:, :, None], sin[:, :, None])
    k_nope, v = kv[..., :MLA_NOPE], kv[..., MLA_NOPE:]
    k_r = apply_rope(k_rope, cos, sin)
    scale = (MLA_NOPE + MLA_ROPE) ** -0.5
    nq = S // Q_BLOCK
    key_pos = jnp.arange(S)

    def to_blocks(t):
        return jnp.swapaxes(t.reshape(B, nq, Q_BLOCK, *t.shape[2:]), 0, 1)

    def block(args):
        qn, qr, start = args
        t = start + jnp.arange(Q_BLOCK)
        logits = (jnp.einsum('bqhe,bshe->bhqs', qn, k_nope, preferred_element_type=F32)
                  + jnp.einsum('bqhe,bse->bhqs', qr, k_r, preferred_element_type=F32)) * scale
        logits = jnp.where(key_pos[None, :] <= t[:, None], logits, -jnp.inf)
        p = jax.nn.softmax(logits, axis=-1)
        return jnp.einsum('bhqs,bshe->bqhe', p.astype(v.dtype), v, preferred_element_type=F32)

    out = lax.map(block, (to_blocks(q_nope), to_blocks(q_rope), jnp.arange(nq) * Q_BLOCK))
    return jnp.swapaxes(out, 0, 1).reshape(B, S, N_HEADS_MLA, MLA_V).astype(cq.dtype)


def hybrid_mixer(x, positions, w_in, q_norm, w_uq, kv_norm, w_ukv, w_out, rel_bias):
    B, S, _ = x.shape
    dq, dk, dv, sq, sk, sv, iq, ik, iw, cq, ckv, kr = split_cols(x @ w_in)
    heads = lambda t, h: t.reshape(B, S, h, -1)
    o_a = dilated_mixture(heads(dq, N_HEADS_DIL), heads(dk, N_HEADS_DIL), heads(dv, N_HEADS_DIL),
                          rel_bias[:, :N_HEADS_DIL])
    o_b = dsa_attention(heads(sq, N_HEADS_DSA), heads(sk, N_HEADS_DSA), heads(sv, N_HEADS_DSA),
                        heads(iq, IDX_HEADS), ik, iw, rel_bias[:, N_HEADS_DIL:])
    o_c = mla_attention(cq, ckv, kr, positions, q_norm, w_uq, kv_norm, w_ukv)
    o = jnp.concatenate([o_a.reshape(B, S, -1), o_b.reshape(B, S, -1), o_c.reshape(B, S, -1)], -1)
    return o.astype(x.dtype) @ w_out


def moe_ffn(x, router_w, router_bias, w1, w3, w2, sw1, sw3, sw2):
    B, S, D = x.shape
    xf = x.reshape(-1, D)
    T = xf.shape[0]
    scores = jax.nn.sigmoid(jnp.matmul(xf, router_w, preferred_element_type=F32))
    _, idx = lax.top_k(scores + router_bias.astype(F32), TOP_K)
    gates = jnp.take_along_axis(scores, idx, -1)
    gates = gates / jnp.sum(gates, -1, keepdims=True) * ROUTED_SCALE
    n_assign = T * TOP_K
    e_flat = idx.reshape(-1)
    tok_flat = jnp.repeat(jnp.arange(T, dtype=jnp.int32), TOP_K)
    g_flat = gates.reshape(-1)
    order = jnp.argsort(e_flat)
    e_s, tok_s, g_s = e_flat[order], tok_flat[order], g_flat[order]
    counts = jnp.bincount(e_flat, length=N_EXPERTS)
    starts = jnp.cumsum(counts) - counts
    pcounts = (counts + MOE_BLOCK - 1) // MOE_BLOCK * MOE_BLOCK
    pstarts = jnp.cumsum(pcounts) - pcounts
    dest = pstarts[e_s] + (jnp.arange(n_assign) - starts[e_s])
    n_blocks = -(-n_assign // MOE_BLOCK) + N_EXPERTS
    n_rows = n_blocks * MOE_BLOCK
    row_tok = jnp.zeros((n_rows,), jnp.int32).at[dest].set(tok_s)
    row_gate = jnp.zeros((n_rows,), F32).at[dest].set(g_s)
    block_end = jnp.cumsum(pcounts) // MOE_BLOCK
    block_expert = jnp.minimum(jnp.searchsorted(block_end, jnp.arange(n_blocks), side='right'), N_EXPERTS - 1)

    def expert_block(args):
        tok, gate, e = args
        h = xf[tok]
        y = (jax.nn.silu(h @ w1[e]) * (h @ w3[e])) @ w2[e]
        return y.astype(F32) * gate[:, None]

    ys = lax.map(expert_block, (row_tok.reshape(n_blocks, MOE_BLOCK), row_gate.reshape(n_blocks, MOE_BLOCK),
                                block_expert))
    routed = jnp.zeros((T, D), F32).at[row_tok].add(ys.reshape(n_rows, D))
    shared = (jax.nn.silu(xf @ sw1) * (xf @ sw3)) @ sw2
    return (routed + shared.astype(F32)).astype(x.dtype).reshape(B, S, D)


def setup_inputs(seed: int = 0) -> dict:
    key = jax.random.key(seed)
    ks = jax.random.split(key, 24)
    nrm = lambda k, s: jax.random.normal(k, s, F32)
    col_scale = jnp.concatenate([jnp.full((n,), DN_BETA if i in VALUE_SEGMENTS else 1.0, F32)
                                 for i, n in enumerate(IN_SIZES)])
    ukv_scale = jnp.tile(jnp.concatenate([jnp.ones((MLA_NOPE,), F32), jnp.full((MLA_V,), DN_BETA, F32)]),
                         N_HEADS_MLA)
    return {
        "x": nrm(ks[0], (BATCH, SEQ, D_MODEL)),
        "positions": jnp.broadcast_to(jnp.arange(SEQ, dtype=jnp.int32), (BATCH, SEQ)),
        "w_in": nrm(ks[1], (DEPTH, D_MODEL, IN_WIDTH)) * D_MODEL ** -0.5 * col_scale,
        "mla_q_norm": 1.0 + 0.02 * nrm(ks[2], (DEPTH, MLA_Q_RANK)),
        "mla_w_uq": nrm(ks[3], (DEPTH, MLA_Q_RANK, N_HEADS_MLA * (MLA_NOPE + MLA_ROPE))) * MLA_Q_RANK ** -0.5,
        "mla_kv_norm": 1.0 + 0.02 * nrm(ks[4], (DEPTH, MLA_KV_RANK)),
        "mla_w_ukv": nrm(ks[5], (DEPTH, MLA_KV_RANK, N_HEADS_MLA * (MLA_NOPE + MLA_V))) * MLA_KV_RANK ** -0.5 * ukv_scale,
        "w_out": nrm(ks[6], (DEPTH, MIX_WIDTH, D_MODEL)) * MIX_WIDTH ** -0.5 * DN_BETA,
        "ln1_g": 1.0 + 0.02 * nrm(ks[7], (DEPTH, D_MODEL)),
        "ln1_b": 0.02 * nrm(ks[8], (DEPTH, D_MODEL)),
        "router_w": nrm(ks[9], (DEPTH, D_MODEL, N_EXPERTS)) * D_MODEL ** -0.5,
        "router_bias": 0.01 * nrm(ks[10], (DEPTH, N_EXPERTS)),
        "exp_w1": nrm(ks[11], (DEPTH, N_EXPERTS, D_MODEL, EXPERT_FF)) * D_MODEL ** -0.5,
        "exp_w3": nrm(ks[12], (DEPTH, N_EXPERTS, D_MODEL, EXPERT_FF)) * D_MODEL ** -0.5,
        "exp_w2": nrm(ks[13], (DEPTH, N_EXPERTS, EXPERT_FF, D_MODEL)) * EXPERT_FF ** -0.5 * DN_BETA,
        "sh_w1": nrm(ks[14], (DEPTH, D_MODEL, SHARED_FF)) * D_MODEL ** -0.5,
        "sh_w3": nrm(ks[15], (DEPTH, D_MODEL, SHARED_FF)) * D_MODEL ** -0.5,
        "sh_w2": nrm(ks[16], (DEPTH, SHARED_FF, D_MODEL)) * SHARED_FF ** -0.5 * DN_BETA,
        "ln2_g": 1.0 + 0.02 * nrm(ks[17], (DEPTH, D_MODEL)),
        "ln2_b": 0.02 * nrm(ks[18], (DEPTH, D_MODEL)),
        "rel_bias": 0.3 * nrm(ks[19], (N_BUCKETS, N_BIAS_HEADS)),
    }


def reference(x, positions, w_in, mla_q_norm, mla_w_uq, mla_kv_norm, mla_w_ukv, w_out, ln1_g, ln1_b,
              router_w, router_bias, exp_w1, exp_w3, exp_w2, sh_w1, sh_w3, sh_w2, ln2_g, ln2_b, rel_bias):
    for l in range(DEPTH):
        mix = hybrid_mixer(x, positions, w_in[l], mla_q_norm[l], mla_w_uq[l], mla_kv_norm[l], mla_w_ukv[l],
                           w_out[l], rel_bias)
        x = layer_norm(DN_ALPHA * x + mix, ln1_g[l], ln1_b[l])
        ffn = moe_ffn(x, router_w[l], router_bias[l], exp_w1[l], exp_w3[l], exp_w2[l],
                      sh_w1[l], sh_w3[l], sh_w2[l])
        x = layer_norm(DN_ALPHA * x + ffn, ln2_g[l], ln2_b[l])
    return x
```

```cpp
#define DBG 0
#define DBG_STOP 41
#define MULTI_LAUNCH
#include <hip/hip_runtime.h>
#include <cstdio>
#include <cstdint>

#define LAS __attribute__((address_space(3)))
typedef unsigned short bf16_t;
typedef short bf16x8 __attribute__((ext_vector_type(8)));
typedef short s16x4 __attribute__((ext_vector_type(4)));
typedef float f32x2 __attribute__((ext_vector_type(2)));
typedef float f32x4 __attribute__((ext_vector_type(4)));
typedef float f32x16 __attribute__((ext_vector_type(16)));
typedef unsigned u32x4 __attribute__((ext_vector_type(4)));
typedef unsigned u32x2 __attribute__((ext_vector_type(2)));
typedef __bf16 bf16x2_t __attribute__((ext_vector_type(2)));

constexpr int NB = 16, SEQ = 2048, T = NB * SEQ, DM = 1024, NL = 4;
constexpr int IN_W = 2920, LDU = 3072;
constexpr int U_DQ = 0, U_DK = 384, U_DV = 768, U_SQ = 1152, U_SK = 1408, U_SV = 1664, U_IQ = 1920, U_IK = 2432, U_IW = 2496, U_CQ = 2560, U_CKV = 2816, U_KR = 2944;
constexpr int NE = 64, FF = 256;
constexpr float LOG2E = 1.4426950408889634f;
constexpr float QSCALE = 0.125f * LOG2E;
constexpr float MLA_QSCALE = 0.10206207261596575f * LOG2E;
constexpr float DN_ALPHA = 1.6817928305074290f;
constexpr float LN_EPS = 1e-5f, RMS_EPS = 1e-6f;
constexpr float ROUTED_SCALE = 2.5f;

constexpr size_t MiB = (size_t)1 << 20;
constexpr size_t WS_CTL = 0, CTL_BYTES = 1 * MiB;
constexpr size_t WS_W = 1 * MiB;
constexpr size_t W_IN = 0, W_UQ = W_IN + (size_t)3072 * 1024 * 2, W_UKV = W_UQ + (size_t)768 * 256 * 2, W_OUT = W_UKV + (size_t)768 * 256 * 2,
                 W_R = W_OUT + (size_t)1024 * 1024 * 2, W_13 = W_R + (size_t)256 * 1024 * 2, W_2 = W_13 + (size_t)65 * 512 * 1024 * 2, W_END = W_2 + (size_t)65 * 1024 * 256 * 2;
static_assert(W_END <= 108 * MiB, "weights region");
constexpr size_t WS_XF = 109 * MiB;
constexpr size_t WS_XB = 237 * MiB;
constexpr size_t WS_H = 301 * MiB;
constexpr size_t WS_LST = 445 * MiB;
constexpr size_t WS_GATE = 453 * MiB;
constexpr size_t WS_ROPE = 454 * MiB;
constexpr size_t WS_R = 458 * MiB;
constexpr size_t R_U = 0, R_MQ = 192 * MiB, R_MK = 228 * MiB, R_MV = 252 * MiB, R_KR = 276 * MiB, R_AO = 278 * MiB, R_MASK = 342 * MiB, R_SCR = 350 * MiB, R_LG = 414 * MiB;
constexpr size_t WS_END = 970 * MiB;
constexpr int CW_TMO = 0, CW_FLAG = 16  , CW_BAR = 4096, CW_CNT = 8192  , CW_Q = 16384  ;

__device__ __forceinline__ unsigned f2bf(float f) { unsigned u = __builtin_bit_cast(unsigned, f); return (u + 0x7fffu + ((u >> 16) & 1u)) >> 16; }
__device__ __forceinline__ float bf2f(unsigned b) { return __builtin_bit_cast(float, b << 16); }
__device__ __forceinline__ unsigned cvt_pk(float lo, float hi) { f32x2 v = {lo, hi}; bf16x2_t b = __builtin_convertvector(v, bf16x2_t); return __builtin_bit_cast(unsigned, b); }
#define LDS_WAIT() asm volatile("s_waitcnt lgkmcnt(0)" ::: "memory")
#define VM_WAIT() asm volatile("s_waitcnt vmcnt(0)" ::: "memory")
__device__ __forceinline__ float wave_sum(float v) {
#pragma unroll
    for (int o = 1; o < 64; o <<= 1) v += __shfl_xor(v, o);
    return v;
}

#define XB_TMO      128
#define XB_XCNT(j)  (256  + 64 * (j))
#define XB_XSUB(j)  (1280 + 64 * (j))
#define XB_XGEN(j)  (2304 + 64 * (j))
#define XB_TOP      3328
#define XB_TOPGEN   3392
#define XCD_BAR_WORDS 3456
#define XB_SPIN_CAP (1u << 18)
__device__ __forceinline__ unsigned xb_ld(unsigned* p)              { return __hip_atomic_load(p, __ATOMIC_RELAXED, __HIP_MEMORY_SCOPE_AGENT); }
__device__ __forceinline__ unsigned xb_add(unsigned* p, unsigned v) { return __hip_atomic_fetch_add(p, v, __ATOMIC_RELAXED, __HIP_MEMORY_SCOPE_AGENT); }
__device__ __forceinline__ unsigned xb_xcc_id() { return (unsigned)__builtin_amdgcn_s_getreg((3 << 11) | 20) & 0xFu; }
#define XB_SPIN(cond, bar) do { unsigned _sp = 0; while (cond) { __builtin_amdgcn_s_sleep(1); \
    if ((++_sp & 255u) == 0u) { if (xb_ld(&(bar)[XB_TMO])) break; if (_sp > XB_SPIN_CAP) { atomicAdd(&(bar)[XB_TMO], 1u); break; } } } } while (0)
struct XcdBarrier { unsigned* bar; unsigned x; volatile LAS unsigned* st; };
__device__ __forceinline__ XcdBarrier xcd_barrier_post(unsigned* bar, volatile LAS unsigned* st) {
    XcdBarrier b; b.bar = bar; b.x = xb_xcc_id(); b.st = st;
    if (threadIdx.x == 0) (void)xb_add(&bar[XB_XCNT(b.x)], 1u);
    return b;
}
__device__ __forceinline__ void xcd_barrier_complete(unsigned* bar, unsigned x, unsigned& nloc, unsigned& nx) {
    const unsigned G = gridDim.x * gridDim.y * gridDim.z;
    unsigned sum, cnt, mine, sp = 0u;
    for (;;) {
        sum = 0u; cnt = 0u; mine = 0u;
#pragma unroll
        for (unsigned j = 0; j < 16; ++j) { const unsigned c = xb_ld(&bar[XB_XCNT(j)]); sum += c; cnt += (c > 0u) ? 1u : 0u; mine = (j == x) ? c : mine; }
        if (sum == G) break;
        __builtin_amdgcn_s_sleep(1);
        if ((++sp & 255u) == 0u) { if (xb_ld(&bar[XB_TMO])) break; if (sp > XB_SPIN_CAP) { atomicAdd(&bar[XB_TMO], 1u); break; } }
    }
    nloc = mine > 0u ? mine : 1u; nx = cnt > 0u ? cnt : 1u;
}
__device__ __forceinline__ void xcd_barrier(const XcdBarrier& b) {
    asm volatile("s_waitcnt vmcnt(0)" ::: "memory");
    __syncthreads();
    if (threadIdx.x == 0) {
        unsigned* bar = b.bar;
        __builtin_amdgcn_s_waitcnt(0);
        unsigned nloc = b.st[0], nx = b.st[1];
        if (nloc == 0u) { xcd_barrier_complete(bar, b.x, nloc, nx); b.st[0] = nloc; b.st[1] = nx; }
        const unsigned old = xb_add(&bar[XB_XSUB(b.x)], 1u);
        const unsigned gen = old / nloc;
        if (old + 1u == (gen + 1u) * nloc) {
            __builtin_amdgcn_fence(__ATOMIC_RELEASE, "agent");
            asm volatile("s_waitcnt vmcnt(0)" ::: "memory");
            const unsigned og = xb_add(&bar[XB_TOP], 1u);
            const unsigned tg = og / nx;
            if (og + 1u == (tg + 1u) * nx) xb_add(&bar[XB_TOPGEN], 1u);
            else XB_SPIN(xb_ld(&bar[XB_TOPGEN]) == tg, bar);
            __builtin_amdgcn_fence(__ATOMIC_ACQUIRE, "agent");
            xb_add(&bar[XB_XGEN(b.x)], 1u);
            asm volatile("s_waitcnt vmcnt(0)" ::: "memory");
        } else {
            XB_SPIN(xb_ld(&bar[XB_XGEN(b.x)]) == gen, bar);
            __builtin_amdgcn_fence(__ATOMIC_ACQUIRE, "agent");
            asm volatile("s_waitcnt vmcnt(0)" ::: "memory");
        }
    }
    __syncthreads();
}

namespace pg8 {
constexpr int BM = 256, BK = 64, HALF = 128, HTB = HALF * BK * 2, STAGE_BYTES = 8 * HTB, NXCD = 8, WGM = 8;
__device__ __forceinline__ int lds_byte(int r, int c) { const int st = (r >> 4) * 2 + (c >> 5), rr = r & 15, cc = c & 31, ob = rr * 64 + cc * 2; return st * 1024 + (ob ^ (((ob >> 9) & 1) << 5)); }
__device__ __forceinline__ void stage_rc(int b, int& R, int& C) { const int st = b / 1024, sb = b % 1024, swz = sb ^ (((sb >> 9) & 1) << 5); R = (st >> 1) * 16 + swz / 64; C = (st & 1) * 32 + (swz % 64) / 2; }
__device__ __forceinline__ int perm32(int rho) { const int n = rho >> 4, i = rho & 15; return 8 * (i >> 2) + 4 * n + (i & 3); }
struct Unit { int pm, pn, e, seq; };

__device__ __forceinline__ int xcd_remap(int L, int nwg) { const int q = nwg / NXCD, r = nwg % NXCD, xcd = L % NXCD, off = L / NXCD; return (xcd < r ? xcd * (q + 1) : r * (q + 1) + (xcd - r) * q) + off; }

struct DenseOrder {
    int nM, nN, nwg, G, c; unsigned lda, acol; const char* Bt; unsigned ldb;
    __device__ void init(int M, int N, int G_, int c_, unsigned lda_, unsigned acol_, const void* Bt_, unsigned ldb_) { nM = M / BM; nN = N / BM; nwg = nM * nN; G = G_; c = c_; lda = lda_; acol = acol_; Bt = (const char*)Bt_; ldb = ldb_; }
    __device__ __forceinline__ bool next(int i, Unit& u) const {
        const long L = (long)i * G + c; if (L >= nwg) return false;
        const int wgid = xcd_remap((int)L, nwg);
        const int nig = WGM * nN, gid = wgid / nig, fm = gid * WGM, gsz = (nM - fm) < WGM ? (nM - fm) : WGM;
        u.pm = fm + ((wgid % nig) % gsz); u.pn = (wgid % nig) / gsz; u.e = 0; u.seq = i; return true;
    }
    __device__ __forceinline__ void a_voff(const Unit& u, int tid, unsigned (&v)[2][2]) const {
#pragma unroll
        for (int i = 0; i < 2; ++i) { int R, C; stage_rc(tid * 16 + i * 8192, R, C);
#pragma unroll
            for (int h = 0; h < 2; ++h) v[h][i] = ((unsigned)(u.pm * BM + h * HALF + R) * lda + acol + (unsigned)C) * 2u; }
    }
    __device__ __forceinline__ const char* b_base(const Unit& u) const { return Bt + (size_t)u.pn * BM * ldb * 2; }
};

template <class Epi, class Sched>
__device__ __forceinline__ void gemm_phase(LAS unsigned char* lds, LAS unsigned char* vslot  , const char* Abase, const int K, const unsigned ldb, const Sched& S, const Epi& E) {
    int tid = threadIdx.x; asm volatile("" : "+v"(tid));
    const int wid = __builtin_amdgcn_readfirstlane(tid >> 6), wr = wid >> 2, wc = wid & 3;
    const int nt = K / BK;
    unsigned voffB[2];
#pragma unroll
    for (int i = 0; i < 2; ++i) { int R, C; stage_rc(tid * 16 + i * 8192, R, C); const int Rb = Epi::PERM ? ((R & ~31) + perm32(R & 31)) : R; voffB[i] = ((unsigned)Rb * ldb + (unsigned)C) * 2u; }
    const size_t kstep = (size_t)(BK * 2);
    const size_t hstepB = (size_t)HALF * ldb * 2;
    const unsigned ldsw = (unsigned)wid * 1024u;
    const int aoff = lds_byte(wr * 64 + (tid & 15), ((tid & 63) >> 4) * 8), boff = lds_byte(wc * 32 + (tid & 15), ((tid & 63) >> 4) * 8);
#define PG8_SA(b, h) (((b) * 2 + (h)) * HTB)
#define PG8_SB(b, h) ((4 + (b) * 2 + (h)) * HTB)
#define PG8_STAGE(bufoff, gbase, voff) do { _Pragma("unroll") for (int _i = 0; _i < 2; ++_i) \
        __builtin_amdgcn_global_load_lds((const unsigned*)((const char*)(gbase) + (voff)[_i]), (LAS unsigned*)(lds + (bufoff) + ldsw + _i * 8192), 16, 0, 0); } while (0)
#define PG8_LDA(dst, b, h) do { _Pragma("unroll") for (int m = 0; m < 4; ++m) _Pragma("unroll") for (int k = 0; k < 2; ++k) dst[m][k] = *(const LAS bf16x8*)(lds + PG8_SA(b, h) + aoff + m * 2048 + k * 1024); } while (0)
#define PG8_LDB(dst, b, h) do { _Pragma("unroll") for (int n = 0; n < 2; ++n) _Pragma("unroll") for (int k = 0; k < 2; ++k) dst[n][k] = *(const LAS bf16x8*)(lds + PG8_SB(b, h) + boff + n * 2048 + k * 1024); } while (0)
#define PG8_MMA(ai, bj, At, Bt) do { __builtin_amdgcn_s_setprio(1); _Pragma("unroll") for (int m = 0; m < 4; ++m) _Pragma("unroll") for (int n = 0; n < 2; ++n) _Pragma("unroll") for (int k = 0; k < 2; ++k) \
        acc[ai][bj][m][n] = __builtin_amdgcn_mfma_f32_16x16x32_bf16(Bt[n][k], At[m][k], acc[ai][bj][m][n], 0, 0, 0); __builtin_amdgcn_s_setprio(0); } while (0)
#define PG8_WAIT_V(n) asm volatile("s_waitcnt vmcnt(" #n ")" ::: "memory")
#define PG8_WAIT_L(n) asm volatile("s_waitcnt lgkmcnt(" #n ")" ::: "memory")
#define PG8_BAR __builtin_amdgcn_s_barrier()
#define PG8_SCHED __builtin_amdgcn_sched_barrier(0)
    Unit cur, nxt; int ui = 0;
    if (!S.next(0, cur)) return;
    f32x4 acc[2][2][4][2];
#pragma unroll
    for (int a = 0; a < 2; ++a)
#pragma unroll
        for (int b = 0; b < 2; ++b)
#pragma unroll
            for (int m = 0; m < 4; ++m)
#pragma unroll
                for (int n = 0; n < 2; ++n) acc[a][b][m][n] = (f32x4){0.f, 0.f, 0.f, 0.f};
    bf16x8 At[4][2], B0[2][2], B1[2][2];
    unsigned vc[2][2];
    S.a_voff(cur, tid, vc);
    const char* cB = S.b_base(cur);
    PG8_STAGE(PG8_SB(0, 0), cB, voffB); PG8_STAGE(PG8_SA(0, 0), Abase, vc[0]); PG8_STAGE(PG8_SB(0, 1), cB + hstepB, voffB); PG8_STAGE(PG8_SA(0, 1), Abase, vc[1]);
    if (wr == 1) PG8_BAR;
    PG8_WAIT_V(4); PG8_BAR;
    PG8_STAGE(PG8_SB(1, 0), cB + kstep, voffB); PG8_STAGE(PG8_SA(1, 0), Abase + kstep, vc[0]); PG8_STAGE(PG8_SB(1, 1), cB + hstepB + kstep, voffB);
    PG8_WAIT_V(6); PG8_BAR;
    for (;;) {
        const bool has_next = S.next(ui + 1, nxt);
        const char* nB = has_next ? S.b_base(nxt) : cB;
        if (has_next) { unsigned vn[2][2]; int tz = threadIdx.x; asm volatile("" : "+v"(tz)); S.a_voff(nxt, tz, vn); *(LAS u32x4*)(vslot + tz * 16) = (u32x4){vn[0][0], vn[0][1], vn[1][0], vn[1][1]}; }
#pragma unroll 1
        for (int t = 0; t < nt; t += 2) {
            const bool last = (t == nt - 2);
            const char* a1 = Abase + (size_t)(t + 1) * kstep;
            const char* a2 = last ? Abase : Abase + (size_t)(t + 2) * kstep; const char* b2 = last ? nB : cB + (size_t)(t + 2) * kstep;
            const char* a3 = a2 + kstep; const char* b3 = b2 + kstep;
            u32x4 vnx = (u32x4){vc[0][0], vc[0][1], vc[1][0], vc[1][1]};
            if (last && has_next) vnx = *(const LAS u32x4*)(vslot + tid * 16);
            PG8_LDB(B0, 0, 0); PG8_SCHED; PG8_LDA(At, 0, 0); PG8_STAGE(PG8_SA(1, 1), a1, vc[1]);
            vc[0][0] = vnx[0]; vc[0][1] = vnx[1]; vc[1][0] = vnx[2]; vc[1][1] = vnx[3];
            PG8_WAIT_L(8); PG8_BAR; PG8_WAIT_L(0); PG8_MMA(0, 0, At, B0); PG8_BAR; PG8_SCHED;
            PG8_LDB(B1, 0, 1); PG8_STAGE(PG8_SB(0, 0), b2, voffB);
            PG8_BAR; PG8_WAIT_L(0); PG8_MMA(0, 1, At, B1); PG8_BAR;
            PG8_LDA(At, 0, 1); PG8_STAGE(PG8_SA(0, 0), a2, vc[0]);
            PG8_BAR; PG8_WAIT_L(0); PG8_MMA(1, 0, At, B0); PG8_BAR; PG8_SCHED;
            PG8_STAGE(PG8_SB(0, 1), b2 + hstepB, voffB);
            PG8_WAIT_V(6); PG8_BAR; PG8_MMA(1, 1, At, B1); PG8_BAR;
            PG8_LDB(B0, 1, 0); PG8_SCHED; PG8_LDA(At, 1, 0); PG8_STAGE(PG8_SA(0, 1), a2, vc[1]);
            PG8_WAIT_L(8); PG8_BAR; PG8_WAIT_L(0); PG8_MMA(0, 0, At, B0); PG8_BAR; PG8_SCHED;
            PG8_LDB(B1, 1, 1); PG8_STAGE(PG8_SB(1, 0), b3, voffB);
            PG8_BAR; PG8_WAIT_L(0); PG8_MMA(0, 1, At, B1); PG8_BAR;
            PG8_LDA(At, 1, 1); PG8_STAGE(PG8_SA(1, 0), a3, vc[0]);
            PG8_BAR; PG8_WAIT_L(0); PG8_MMA(1, 0, At, B0); PG8_BAR; PG8_SCHED;
            PG8_STAGE(PG8_SB(1, 1), b3 + hstepB, voffB);
            PG8_WAIT_V(6); PG8_BAR; PG8_MMA(1, 1, At, B1); PG8_BAR;
        }
        { int tz = threadIdx.x; asm volatile("" : "+v"(tz)); const int ln = tz & 63; E(acc, cur, wr, wc, ln & 15, ln >> 4); }
        if (!has_next) break;
#pragma unroll
        for (int a = 0; a < 2; ++a)
#pragma unroll
            for (int b = 0; b < 2; ++b)
#pragma unroll
                for (int m = 0; m < 4; ++m)
#pragma unroll
                    for (int n = 0; n < 2; ++n) acc[a][b][m][n] = (f32x4){0.f, 0.f, 0.f, 0.f};
        cur = nxt; cB = nB; ++ui;
    }
    PG8_WAIT_V(0);
    if (wr == 0) PG8_BAR;
    PG8_BAR;
#undef PG8_SA
#undef PG8_SB
#undef PG8_STAGE
#undef PG8_LDA
#undef PG8_LDB
#undef PG8_MMA
#undef PG8_WAIT_V
#undef PG8_WAIT_L
#undef PG8_BAR
#undef PG8_SCHED
}
}
constexpr int NWAVES = 8, NTHR = 512;
constexpr int LDS_RING = 131072;
constexpr int LDS_TBL = LDS_RING;
constexpr int LDS_VOFF = LDS_TBL + 12288;
constexpr int LDS_MISC = LDS_VOFF + 8192;
constexpr int LDS_BYTES = 152064;

struct Params {
    const float* x; const int* pos; const float* w_in; const float* q_norm; const float* w_uq; const float* kv_norm; const float* w_ukv; const float* w_out;
    const float* ln1_g; const float* ln1_b; const float* router_w; const float* router_b; const float* w1; const float* w3; const float* w2;
    const float* sw1; const float* sw3; const float* sw2; const float* ln2_g; const float* ln2_b; const float* rel_bias;
    float* out; unsigned char* ws;
    int ph_lo, ph_hi;
};

struct Frame {
    LAS unsigned char* lds; volatile LAS unsigned* MISC; unsigned* ctl;
    int tid, lane, wave, G, vcu;
    unsigned char* ws;
};
#define FP(name, type, off) __device__ __forceinline__ type* name(const Frame& F) { return (type*)(F.ws + (off)); }
FP(fWin, bf16_t, WS_W + W_IN) FP(fWuq, bf16_t, WS_W + W_UQ) FP(fWukv, bf16_t, WS_W + W_UKV) FP(fWout, bf16_t, WS_W + W_OUT) FP(fWr, bf16_t, WS_W + W_R) FP(fW13, bf16_t, WS_W + W_13) FP(fW2, bf16_t, WS_W + W_2)
FP(fXF, float, WS_XF) FP(fXB, bf16_t, WS_XB) FP(fH, bf16_t, WS_H) FP(fLST, unsigned, WS_LST) FP(fGATE, float, WS_GATE) FP(fROPE, float, WS_ROPE)
FP(fU, bf16_t, WS_R + R_U) FP(fMQ, bf16_t, WS_R + R_MQ) FP(fMK, bf16_t, WS_R + R_MK) FP(fMV, bf16_t, WS_R + R_MV) FP(fKR, bf16_t, WS_R + R_KR) FP(fAO, bf16_t, WS_R + R_AO)
FP(fMASK, unsigned, WS_R + R_MASK) FP(fSCR, float, WS_R + R_SCR) FP(fLG, float, WS_R + R_LG) FP(fYB, bf16_t, WS_R)
__device__ __forceinline__ Frame phase_frame(const Frame& F0) { Frame F = F0; int tz = threadIdx.x; asm volatile("" : "+v"(tz)); F.tid = tz; F.lane = tz & 63; return F; }

struct MapIn  { __device__ int row(int n) const { return n < 2504 ? n : n + 56; }   __device__ float sc(int k, int n) const { return (n < 384 || (n >= 1152 && n < 1408)) ? QSCALE : 1.0f; } };
struct MapUq  { const float* g; __device__ int row(int n) const { return n; }         __device__ float sc(int k, int n) const { return g[k] * MLA_QSCALE; } };
struct MapUkv { const float* g; __device__ int row(int n) const { const int h = n >> 7, c = n & 127; return c < 64 ? h * 64 + c : 384 + h * 64 + (c - 64); } __device__ float sc(int k, int n) const { return g[k]; } };
struct MapId  { __device__ int row(int n) const { return n; }                         __device__ float sc(int k, int n) const { return 1.0f; } };
struct MapW13 { int add; __device__ int row(int f) const { return 32 * (f >> 4) + (f & 15) + add; } __device__ float sc(int k, int n) const { return 1.0f; } };

template <class MAP>
__device__ __forceinline__ void tr_item(const float* W, int N, int kb, int nb, bf16_t* WT, int ldk, const MAP map, LAS float* scr, int lane) {
    const int k0 = 64 * kb, n0 = 32 * nb;
    const int nn = n0 + (lane & 31); const bool ok = nn < N;
#pragma unroll 8
    for (int i = 0; i < 32; ++i) { const int kk = 2 * i + (lane >> 5); scr[kk * 33 + (lane & 31)] = ok ? W[(size_t)(k0 + kk) * N + nn] * map.sc(k0 + kk, nn) : 0.f; }
    LDS_WAIT(); asm volatile("" ::: "memory");
    const int c = lane & 7;
#pragma unroll
    for (int j = 0; j < 4; ++j) { const int n = (lane >> 3) + 8 * j; const LAS float* s = scr + (8 * c) * 33 + n;
        u32x4 o; o.x = cvt_pk(s[0 * 33], s[1 * 33]); o.y = cvt_pk(s[2 * 33], s[3 * 33]); o.z = cvt_pk(s[4 * 33], s[5 * 33]); o.w = cvt_pk(s[6 * 33], s[7 * 33]);
        if (n0 + n < N) *(u32x4*)(WT + (size_t)map.row(n0 + n) * ldk + k0 + 8 * c) = o; }
    LDS_WAIT(); asm volatile("" ::: "memory");
}

__device__ __forceinline__ void zero_rows(bf16_t* base, int row0, int nrows, int ldk, int k0, int kn, int gt, int ngt) {
    const int per = kn / 8; const int total = nrows * per;
    for (int i = gt; i < total; i += ngt) { const int r = i / per, c = i % per; *(u32x4*)(base + (size_t)(row0 + r) * ldk + k0 + 8 * c) = (u32x4){0u, 0u, 0u, 0u}; }
}

__device__ __forceinline__ void convert_layer(const Frame& F, const Params& p, int l) {
    LAS float* scr = (LAS float*)(F.lds + F.wave * 16384);
    const int gw = F.vcu * NWAVES + F.wave, NGW = F.G * NWAVES;
    constexpr int I_IN = 16 * 92, I_UQ = 4 * 18, I_UKV = 2 * 24, I_OUT = 16 * 32, I_R = 16 * 2, I_E1 = 16 * 8, I_E2 = 4 * 32, I_EXP = 2 * I_E1 + I_E2;
    constexpr int NIT = I_IN + I_UQ + I_UKV + I_OUT + I_R + 65 * I_EXP;
    const float* w_in = p.w_in + (size_t)l * 1024 * IN_W;
    const float* w_uq = p.w_uq + (size_t)l * 256 * 576; const float* w_ukv = p.w_ukv + (size_t)l * 128 * 768;
    const float* w_out = p.w_out + (size_t)l * 1024 * 1024; const float* rw = p.router_w + (size_t)l * 1024 * 64;
    for (int it = gw; it < NIT; it += NGW) {
        int r = it;
        if (r < I_IN) { tr_item(w_in, IN_W, r / 92, r % 92, fWin(F), 1024, MapIn{}, scr, F.lane); continue; } r -= I_IN;
        if (r < I_UQ) { tr_item(w_uq, 576, r / 18, r % 18, fWuq(F), 256, MapUq{p.q_norm + l * 256}, scr, F.lane); continue; } r -= I_UQ;
        if (r < I_UKV) { tr_item(w_ukv, 768, r / 24, r % 24, fWukv(F), 256, MapUkv{p.kv_norm + l * 128}, scr, F.lane); continue; } r -= I_UKV;
        if (r < I_OUT) { tr_item(w_out, 1024, r / 32, r % 32, fWout(F), 1024, MapId{}, scr, F.lane); continue; } r -= I_OUT;
        if (r < I_R) { tr_item(rw, 64, r / 2, r % 2, fWr(F), 1024, MapId{}, scr, F.lane); continue; } r -= I_R;
        const int e = r / I_EXP; r -= e * I_EXP;
        const float *s1, *s3, *s2;
        if (e < 64) { s1 = p.w1 + ((size_t)l * 64 + e) * 1024 * 256; s3 = p.w3 + ((size_t)l * 64 + e) * 1024 * 256; s2 = p.w2 + ((size_t)l * 64 + e) * 256 * 1024; }
        else { s1 = p.sw1 + (size_t)l * 1024 * 256; s3 = p.sw3 + (size_t)l * 1024 * 256; s2 = p.sw2 + (size_t)l * 256 * 1024; }
        bf16_t* d13 = fW13(F) + (size_t)e * 512 * 1024; bf16_t* d2 = fW2(F) + (size_t)e * 1024 * 256;
        if (r < I_E1) { tr_item(s1, 256, r / 8, r % 8, d13, 1024, MapW13{0}, scr, F.lane); continue; } r -= I_E1;
        if (r < I_E1) { tr_item(s3, 256, r / 8, r % 8, d13, 1024, MapW13{16}, scr, F.lane); continue; } r -= I_E1;
        tr_item(s2, 1024, r / 32, r % 32, d2, 256, MapId{}, scr, F.lane);
    }
    const int gt = F.vcu * NTHR + F.tid, ngt = F.G * NTHR;
    zero_rows(fWin(F), 2504, 56, 1024, 0, 1024, gt, ngt); zero_rows(fWin(F), 2976, 96, 1024, 0, 1024, gt, ngt);
    zero_rows(fWuq(F), 576, 192, 256, 0, 256, gt, ngt);
    zero_rows(fWukv(F), 0, 768, 256, 128, 128, gt, ngt);
    zero_rows(fWr(F), 64, 192, 1024, 0, 1024, gt, ngt);
}

typedef f32x4 Acc[2][2][4][2];
#define EPI_ROWS(ai, m) for (int ai = 0; ai < 2; ++ai) for (int m = 0; m < 4; ++m)

struct EpiU {
    static constexpr bool PERM = true; bf16_t* U;
    __device__ __forceinline__ void operator()(const Acc& acc, const pg8::Unit& u, int wr, int wc, int fr, int fq) const {
#pragma unroll
        EPI_ROWS(ai, m) { bf16_t* rowp = U + (size_t)(u.pm * 256 + ai * 128 + wr * 64 + m * 16 + fr) * LDU + u.pn * 256 + wc * 32 + 8 * fq;
#pragma unroll
            for (int bj = 0; bj < 2; ++bj) { const f32x4 a = acc[ai][bj][m][0], b = acc[ai][bj][m][1];
                *(u32x4*)(rowp + bj * 128) = (u32x4){cvt_pk(a[0], a[1]), cvt_pk(a[2], a[3]), cvt_pk(b[0], b[1]), cvt_pk(b[2], b[3])}; } }
    }
};
struct EpiQup {
    static constexpr bool PERM = false; bf16_t* MQ; const LAS float* tbl; const float* rope;
    __device__ __forceinline__ void operator()(const Acc& acc, const pg8::Unit& u, int wr, int wc, int fr, int fq) const {
#pragma unroll
        EPI_ROWS(ai, m) { const int rl = ai * 128 + wr * 64 + m * 16 + fr, row = u.pm * 256 + rl; const float rs = tbl[u.seq * 256 + rl];
#pragma unroll
            for (int bj = 0; bj < 2; ++bj) { const int c0 = u.pn * 256 + bj * 128 + wc * 32; f32x4 a = acc[ai][bj][m][0] * rs, b = acc[ai][bj][m][1] * rs;
                if (((c0 >> 5) % 3) == 2) {
                    const f32x4 cs = *(const f32x4*)(rope + (size_t)row * 32 + 4 * fq), sn = *(const f32x4*)(rope + (size_t)row * 32 + 16 + 4 * fq);
                    const f32x4 x1 = a, x2 = b; a = x1 * cs - x2 * sn; b = x2 * cs + x1 * sn; }
                if (c0 < 576) { bf16_t* o = MQ + (size_t)row * 576 + c0 + 4 * fq; *(u32x2*)o = (u32x2){cvt_pk(a[0], a[1]), cvt_pk(a[2], a[3])}; *(u32x2*)(o + 16) = (u32x2){cvt_pk(b[0], b[1]), cvt_pk(b[2], b[3])}; } }
            asm volatile("" ::: "memory"); }
    }
};
struct EpiKVup {
    static constexpr bool PERM = true; bf16_t* MK; bf16_t* MV; const LAS float* tbl;
    __device__ __forceinline__ void operator()(const Acc& acc, const pg8::Unit& u, int wr, int wc, int fr, int fq) const {
#pragma unroll
        EPI_ROWS(ai, m) { const int rl = ai * 128 + wr * 64 + m * 16 + fr, row = u.pm * 256 + rl; const float rs = tbl[u.seq * 256 + rl];
#pragma unroll
            for (int bj = 0; bj < 2; ++bj) { const int c = u.pn * 256 + bj * 128 + wc * 32 + 8 * fq; const f32x4 a = acc[ai][bj][m][0] * rs, b = acc[ai][bj][m][1] * rs;
                bf16_t* o = c < 384 ? MK + (size_t)row * 384 + c : MV + (size_t)row * 384 + (c - 384);
                *(u32x4*)o = (u32x4){cvt_pk(a[0], a[1]), cvt_pk(a[2], a[3]), cvt_pk(b[0], b[1]), cvt_pk(b[2], b[3])}; } }
    }
};
struct EpiRes {
    static constexpr bool PERM = false; const float* res; float* out; int row_off;
    __device__ __forceinline__ void operator()(const Acc& acc, const pg8::Unit& u, int wr, int wc, int fr, int fq) const {
#pragma unroll
        EPI_ROWS(ai, m) { const size_t off = (size_t)(u.pm * 256 + ai * 128 + wr * 64 + m * 16 + fr) * 1024 + u.pn * 256 + wc * 32 + 4 * fq;
#pragma unroll
            for (int bj = 0; bj < 2; ++bj)
#pragma unroll
                for (int n = 0; n < 2; ++n) { const f32x4 r = *(const f32x4*)(res + off + bj * 128 + n * 16); *(f32x4*)(out + off + bj * 128 + n * 16) = r * DN_ALPHA + acc[ai][bj][m][n]; } }
    }
};
struct EpiLogit {
    static constexpr bool PERM = false; float* LG;
    __device__ __forceinline__ void operator()(const Acc& acc, const pg8::Unit& u, int wr, int wc, int fr, int fq) const {
        if (wc >= 2) return;
#pragma unroll
        EPI_ROWS(ai, m) { float* o = LG + ((size_t)u.pn * T + (u.pm * 256 + ai * 128 + wr * 64 + m * 16 + fr)) * 64 + wc * 32 + 4 * fq;
            *(f32x4*)o = acc[ai][0][m][0]; *(f32x4*)(o + 16) = acc[ai][0][m][1]; }
    }
};
__device__ __forceinline__ float silu_f(float v) { return v / (1.0f + __expf(-v)); }
struct EpiG1 {
    static constexpr bool PERM = false; bf16_t* H; const unsigned* LST; const LAS int* cnt; int shared_base;
    __device__ __forceinline__ void operator()(const Acc& acc, const pg8::Unit& u, int wr, int wc, int fr, int fq) const {
#pragma unroll
        EPI_ROWS(ai, m) { const int idx = u.pm * 256 + ai * 128 + wr * 64 + m * 16 + fr; size_t hrow;
            if (LST) { if (idx >= cnt[u.e]) continue; hrow = LST[(size_t)u.e * T + idx]; } else hrow = (size_t)shared_base + idx;
            bf16_t* o = H + hrow * 256 + u.pn * 128 + wc * 16 + 4 * fq;
#pragma unroll
            for (int bj = 0; bj < 2; ++bj) { const f32x4 a = acc[ai][bj][m][0], b = acc[ai][bj][m][1];
                *(u32x2*)(o + bj * 64) = (u32x2){cvt_pk(silu_f(a[0]) * b[0], silu_f(a[1]) * b[1]), cvt_pk(silu_f(a[2]) * b[2], silu_f(a[3]) * b[3])}; }
            asm volatile("" ::: "memory"); }
    }
};
struct EpiG2 {
    static constexpr bool PERM = true; bf16_t* YB; const unsigned* LST; const LAS int* cnt; const float* GATE;
    __device__ __forceinline__ void operator()(const Acc& acc, const pg8::Unit& u, int wr, int wc, int fr, int fq) const {
#pragma unroll
        EPI_ROWS(ai, m) { const int idx = u.pm * 256 + ai * 128 + wr * 64 + m * 16 + fr; if (idx >= cnt[u.e]) continue;
            const unsigned aid = LST[(size_t)u.e * T + idx]; const float g = GATE[aid];
            bf16_t* o = YB + (size_t)aid * 1024 + u.pn * 256 + wc * 32 + 8 * fq;
#pragma unroll
            for (int bj = 0; bj < 2; ++bj) { const f32x4 a = acc[ai][bj][m][0] * g, b = acc[ai][bj][m][1] * g;
                *(u32x4*)(o + bj * 128) = (u32x4){cvt_pk(a[0], a[1]), cvt_pk(a[2], a[3]), cvt_pk(b[0], b[1]), cvt_pk(b[2], b[3])}; }
            asm volatile("" ::: "memory"); }
    }
};

struct MoeOrder {
    const LAS int* cnt; const LAS int* ubase;
    int npn, total, G, c; const unsigned* LST; int shift  ; unsigned lda; const char* Bt; size_t bexp  ; unsigned ldb;
    __device__ __forceinline__ bool next(int i, pg8::Unit& u) const {
        const long L = (long)i * G + c; if (L >= total) return false;
        const int w = pg8::xcd_remap((int)L, total);
        int lo = 0, hi = 64;
        while (hi - lo > 1) { const int mid = (lo + hi) >> 1; if (ubase[mid] <= w) lo = mid; else hi = mid; }
        const int loc = w - ubase[lo]; u.e = lo; u.pn = loc % npn; u.pm = loc / npn; u.seq = i; return true;
    }
    __device__ __forceinline__ void a_voff(const pg8::Unit& u, int tid, unsigned (&v)[2][2]) const {
        const int n = cnt[u.e];
#pragma unroll
        for (int i = 0; i < 2; ++i) { int R, C; pg8::stage_rc(tid * 16 + i * 8192, R, C);
#pragma unroll
            for (int h = 0; h < 2; ++h) { int idx = u.pm * 256 + h * 128 + R; idx = idx < n ? idx : 0; const unsigned ent = LST[(size_t)u.e * T + idx];
                v[h][i] = ((ent >> shift) * lda + (unsigned)C) * 2u; } }
    }
    __device__ __forceinline__ const char* b_base(const pg8::Unit& u) const { return Bt + (size_t)u.e * bexp + (size_t)u.pn * 256 * ldb * 2; }
};
struct RouterOrder {
    int G, c; const char* Bt;
    __device__ __forceinline__ bool next(int i, pg8::Unit& u) const { const long L = (long)i * G + c; if (L >= 256) return false; u.pm = (int)L >> 1; u.pn = (int)L & 1; u.e = 0; u.seq = i; return true; }
    __device__ __forceinline__ void a_voff(const pg8::Unit& u, int tid, unsigned (&v)[2][2]) const {
#pragma unroll
        for (int i = 0; i < 2; ++i) { int R, C; pg8::stage_rc(tid * 16 + i * 8192, R, C);
#pragma unroll
            for (int h = 0; h < 2; ++h) v[h][i] = ((unsigned)(u.pm * 256 + h * 128 + R) * 1024u + (unsigned)(u.pn * 512 + C)) * 2u; }
    }
    __device__ __forceinline__ const char* b_base(const pg8::Unit& u) const { return Bt + (size_t)u.pn * 512 * 2; }
};

__device__ __forceinline__ void phase_x_to_xb(const Frame& F, const float* x) {
    const size_t n8 = (size_t)T * 1024 / 8;
    for (size_t i = (size_t)F.vcu * NTHR + F.tid; i < n8; i += (size_t)F.G * NTHR) {
        const f32x4 a = *(const f32x4*)(x + i * 8), b = *(const f32x4*)(x + i * 8 + 4);
        *(u32x4*)(fXB(F) + i * 8) = (u32x4){cvt_pk(a[0], a[1]), cvt_pk(a[2], a[3]), cvt_pk(b[0], b[1]), cvt_pk(b[2], b[3])};
    }
}

__device__ __forceinline__ void phase_rope_table(const Frame& F, const int* pos) {
    for (int i = F.vcu * NTHR + F.tid; i < T * 16; i += F.G * NTHR) { const int t = i >> 4, j = i & 15;
        const double inv = exp2(-(double)j * (13.287712379549449 / 16.0));
        const double rev = (double)pos[t] * inv * 0.15915494309189535; const float fr = (float)(rev - floor(rev));
        fROPE(F)[(size_t)t * 32 + j] = __builtin_amdgcn_cosf(fr); fROPE(F)[(size_t)t * 32 + 16 + j] = __builtin_amdgcn_sinf(fr); }
}

__device__ __forceinline__ void phase_inproj(const Frame& F) {
    pg8::DenseOrder S; S.init(T, LDU, F.G, (int)blockIdx.x, 1024, 0, fWin(F), 1024);
    EpiU E{fU(F)};
    pg8::gemm_phase<EpiU, pg8::DenseOrder>(F.lds, F.lds + LDS_VOFF, (const char*)fXB(F), 1024, 1024, S, E);
}

__device__ __forceinline__ void rms_tables(const Frame& F, const pg8::DenseOrder& S, LAS float* tbl, int col0, int width) {
    pg8::Unit u;
    for (int i = 0; S.next(i, u) && i < 4; ++i) {
        if (u.pn != 0 && i > 0) {   }
        if (F.tid < 256) { const bf16_t* xr = fU(F) + (size_t)(u.pm * 256 + F.tid) * LDU + col0; float ss = 0.f;
            for (int c = 0; c < width; c += 8) { const u32x4 v = *(const u32x4*)(xr + c);
#pragma unroll
                for (int j = 0; j < 4; ++j) { const float lo = bf2f(v[j] & 0xffffu), hi = bf2f(v[j] >> 16); ss += lo * lo + hi * hi; } }
            tbl[i * 256 + F.tid] = 1.0f / sqrtf(ss / (float)width + RMS_EPS); }
    }
}

__device__ __forceinline__ void phase_mla_up(const Frame& F, const Params& p) {
    LAS float* tq = (LAS float*)(F.lds + LDS_TBL); LAS float* tkv = tq + 1024;
    pg8::DenseOrder Sq; Sq.init(T, 768, F.G, (int)blockIdx.x, LDU, U_CQ, fWuq(F), 256);
    pg8::DenseOrder Sk; Sk.init(T, 768, F.G, (int)blockIdx.x, LDU, U_CKV, fWukv(F), 256);
    rms_tables(F, Sq, tq, U_CQ, 256); rms_tables(F, Sk, tkv, U_CKV, 128);
    __syncthreads();
    { EpiQup E{fMQ(F), tq, fROPE(F)}; pg8::gemm_phase<EpiQup, pg8::DenseOrder>(F.lds, F.lds + LDS_VOFF, (const char*)fU(F), 256, 256, Sq, E); }
    { EpiKVup E{fMK(F), fMV(F), tkv}; pg8::gemm_phase<EpiKVup, pg8::DenseOrder>(F.lds, F.lds + LDS_VOFF, (const char*)fU(F), 256, 256, Sk, E); }
    for (int i = F.vcu * NTHR + F.tid; i < T * 16; i += F.G * NTHR) { const int t = i >> 4, j = i & 15;
        const float x1 = bf2f(fU(F)[(size_t)t * LDU + U_KR + j]), x2 = bf2f(fU(F)[(size_t)t * LDU + U_KR + 16 + j]);
        const float cs = fROPE(F)[(size_t)t * 32 + j], sn = fROPE(F)[(size_t)t * 32 + 16 + j];
        fKR(F)[(size_t)t * 32 + j] = (bf16_t)f2bf(x1 * cs - x2 * sn); fKR(F)[(size_t)t * 32 + 16 + j] = (bf16_t)f2bf(x2 * cs + x1 * sn); }
}

__device__ __forceinline__ void phase_outproj(const Frame& F, const float* res) {
    pg8::DenseOrder S; S.init(T, 1024, F.G, (int)blockIdx.x, 1024, 0, fWout(F), 1024);
    EpiRes E{res, fXF(F), 0};
    pg8::gemm_phase<EpiRes, pg8::DenseOrder>(F.lds, F.lds + LDS_VOFF, (const char*)fAO(F), 1024, 1024, S, E);
}

__device__ __forceinline__ void phase_router_sharedg1(const Frame& F) {
    { RouterOrder S{F.G, (int)blockIdx.x, (const char*)fWr(F)}; EpiLogit E{fLG(F)}; pg8::gemm_phase<EpiLogit, RouterOrder>(F.lds, F.lds + LDS_VOFF, (const char*)fXB(F), 512, 1024, S, E); }
    { pg8::DenseOrder S; S.init(T, 512, F.G, (int)blockIdx.x, 1024, 0, fW13(F) + (size_t)64 * 512 * 1024, 1024);
      EpiG1 E{fH(F), nullptr, nullptr, T * 8}; pg8::gemm_phase<EpiG1, pg8::DenseOrder>(F.lds, F.lds + LDS_VOFF, (const char*)fXB(F), 1024, 1024, S, E); }
}

__device__ __forceinline__ void phase_shared_g2(const Frame& F) {
    pg8::DenseOrder S; S.init(T, 1024, F.G, (int)blockIdx.x, 256, 0, fW2(F) + (size_t)64 * 1024 * 256, 256);
    EpiRes E{fXF(F), fXF(F), 0};
    pg8::gemm_phase<EpiRes, pg8::DenseOrder>(F.lds, F.lds + LDS_VOFF, (const char*)(fH(F) + (size_t)T * 8 * 256), 256, 256, S, E);
}

__device__ __forceinline__ void moe_tables(const Frame& F, int l, int npn, LAS int*& cnt, LAS int*& ubase) {
    cnt = (LAS int*)(F.lds + LDS_TBL + 8192); ubase = cnt + 64;
    __syncthreads();
    if (F.tid < 64) cnt[F.tid] = (int)F.ctl[CW_CNT + l * 64 + F.tid];
    __syncthreads();
    if (F.tid == 0) { int s = 0; for (int e = 0; e < 64; ++e) { ubase[e] = s; s += ((cnt[e] + 255) >> 8) * npn; } ubase[64] = s; }
    __syncthreads();
}
__device__ __forceinline__ void phase_moe_g1(const Frame& F, int l) {
    LAS int *cnt, *ubase; moe_tables(F, l, 2, cnt, ubase);
    MoeOrder S{cnt, ubase, 2, ubase[64], F.G, (int)blockIdx.x, fLST(F), 3, 1024u, (const char*)fW13(F), (size_t)512 * 1024 * 2, 1024u};
    EpiG1 E{fH(F), fLST(F), cnt, 0};
    pg8::gemm_phase<EpiG1, MoeOrder>(F.lds, F.lds + LDS_VOFF, (const char*)fXB(F), 1024, 1024, S, E);
}
__device__ __forceinline__ void phase_moe_g2(const Frame& F, int l) {
    LAS int *cnt, *ubase; moe_tables(F, l, 4, cnt, ubase);
    MoeOrder S{cnt, ubase, 4, ubase[64], F.G, (int)blockIdx.x, fLST(F), 0, 256u, (const char*)fW2(F), (size_t)1024 * 256 * 2, 256u};
    EpiG2 E{fYB(F), fLST(F), cnt, fGATE(F)};
    pg8::gemm_phase<EpiG2, MoeOrder>(F.lds, F.lds + LDS_VOFF, (const char*)fH(F), 256, 256, S, E);
}
constexpr int AT_K0 = 0, AT_KSZ = 12288, AT_V0 = 2 * AT_KSZ, AT_VSZ = 8192, AT_TBL = AT_V0 + 2 * AT_VSZ;

__device__ __forceinline__ float t5_dist_bias(const float* rel_bias, int head10, int d) {
    int bk;
    if (d < 16) bk = d;
    else { const float v = logf((float)d / 16.0f) / 4.852030263919617f * 16.0f; bk = 16 + (int)v; bk = bk < 31 ? bk : 31; }
    return rel_bias[bk * 10 + head10];
}

template <int MODE, int KS>
__device__ __forceinline__ void attn_unit(const Frame& F, const int b, const int qb,
                                          const bf16_t* __restrict__ Qp, const int ldq, const bf16_t* __restrict__ Kp, const int ldk, const bf16_t* __restrict__ KRp,
                                          const bf16_t* __restrict__ Vp, const int ldv, bf16_t* __restrict__ Op, const unsigned* __restrict__ maskp, const float* rel_bias, const int head10) {
    LAS unsigned char* lds = F.lds;
    const int tid = F.tid, lane = F.lane, w = F.wave, q32 = lane & 31, hh = lane >> 5;
    const size_t tb = (size_t)b * SEQ;
    const int qw0 = qb * 256 + 32 * w, qpos = qw0 + q32;
    const int ntile = 4 * (qb + 1);
    __syncthreads();
    if (MODE == 2) {
        LAS float* tblw = (LAS float*)(lds + AT_TBL);
        for (int d = tid; d < SEQ; d += NTHR) { const int mlt = (d <= 128 ? 1 : 0) + (((d & 3) == 0 && d <= 512) ? 1 : 0) + (((d & 15) == 0) ? 1 : 0);
            tblw[d] = mlt ? (t5_dist_bias(rel_bias, head10, d) + logf((float)mlt)) * LOG2E : -INFINITY; }
    }
    if (MODE == 1) {
        LAS float* tblw = (LAS float*)(lds + AT_TBL);
        for (int d = tid; d < SEQ; d += NTHR) tblw[d] = t5_dist_bias(rel_bias, head10, d) * LOG2E;
    }
    bf16x8 qf[KS];
    { const bf16_t* qr = Qp + (tb + qpos) * (size_t)ldq + 8 * hh;
#pragma unroll
      for (int ks = 0; ks < KS; ++ks) { if (MODE == 0 && ks >= 4) qf[ks] = *(const bf16x8*)(qr + 16 * ks); else qf[ks] = *(const bf16x8*)(qr + 16 * ks); } }
    const int skey = tid >> 3, sch = tid & 7;
    const bf16_t* kg = Kp + (tb + skey) * (size_t)ldk + 8 * sch;
    const bf16_t* vg = Vp + (tb + skey) * (size_t)ldv + 8 * sch;
    const bf16_t* rg = (MODE == 0) ? KRp + (tb + (tid >> 2)) * 32 + 8 * (tid & 3) : nullptr;
    const int kdst = sch * 1024 + ((skey ^ sch) << 4);
    const int rdst = (8 + (tid & 3)) * 1024 + ((((tid >> 2) & 63) ^ (tid & 3)) << 4);
    const int vdst = (sch >> 2) * 4096 + skey * 64 + (sch & 3) * 16;
    const unsigned* mg = (MODE == 1) ? maskp + (tb + qpos) * 64 : nullptr;
    u32x4 kreg, vreg, rreg; u32x2 mw = {0u, 0u}, mwn = {0u, 0u};
    kreg = *(const u32x4*)kg; vreg = *(const u32x4*)vg; if (MODE == 0 && tid < 256) rreg = *(const u32x4*)rg;
    if (MODE == 1) mw = *(const u32x2*)mg;
    *(LAS u32x4*)(lds + AT_K0 + kdst) = kreg; *(LAS u32x4*)(lds + AT_V0 + vdst) = vreg; if (MODE == 0 && tid < 256) *(LAS u32x4*)(lds + AT_K0 + rdst) = rreg;
    __syncthreads();
    f32x16 o0, o1;
#pragma unroll
    for (int r = 0; r < 16; ++r) { o0[r] = 0.f; o1[r] = 0.f; }
    float mrun = -INFINITY, lsum = 0.f;
    const LAS float* tbl = (const LAS float*)(lds + AT_TBL);
    for (int t = 0; t < ntile; ++t) {
        const int buf = t & 1;
        if (t + 1 < ntile) { kreg = *(const u32x4*)(kg + (size_t)(t + 1) * 64 * ldk); vreg = *(const u32x4*)(vg + (size_t)(t + 1) * 64 * ldv);
            if (MODE == 0 && tid < 256) rreg = *(const u32x4*)(rg + (size_t)(t + 1) * 64 * 32);
            if (MODE == 1) mwn = *(const u32x2*)(mg + 2 * (t + 1)); }
        const int k0 = 64 * t;
        if (k0 <= qw0 + 31) {
            const LAS unsigned char* kb = lds + AT_K0 + buf * AT_KSZ; const LAS unsigned char* vb = lds + AT_V0 + buf * AT_VSZ;
            f32x16 s0, s1;
#pragma unroll
            for (int r = 0; r < 16; ++r) { s0[r] = 0.f; s1[r] = 0.f; }
#pragma unroll
            for (int ks = 0; ks < KS; ++ks) { const int c = 2 * ks + hh;
                const bf16x8 a0 = *(const LAS bf16x8*)(kb + c * 1024 + ((q32 ^ (c & 7)) << 4));
                const bf16x8 a1 = *(const LAS bf16x8*)(kb + c * 1024 + (((32 + q32) ^ (c & 7)) << 4));
                s0 = __builtin_amdgcn_mfma_f32_32x32x16_bf16(a0, qf[ks], s0, 0, 0, 0);
                s1 = __builtin_amdgcn_mfma_f32_32x32x16_bf16(a1, qf[ks], s1, 0, 0, 0); }
            if (MODE == 0) { if (k0 + 63 > qw0) {
#pragma unroll
                for (int r = 0; r < 16; ++r) { const int key = k0 + (r & 3) + 8 * (r >> 2) + 4 * hh; if (key > qpos) s0[r] = -INFINITY; if (key + 32 > qpos) s1[r] = -INFINITY; } } }
            if (MODE == 1) { const unsigned w0 = mw[0] >> (4 * hh), w1 = mw[1] >> (4 * hh); const int dbase = qpos - k0 - 4 * hh;
#pragma unroll
                for (int r = 0; r < 16; ++r) { const int bit = (r & 3) + 8 * (r >> 2); const int d0 = dbase - bit, d1 = d0 - 32;
                    s0[r] = ((w0 >> bit) & 1u) ? s0[r] + tbl[d0 > 0 ? d0 : 0] : -INFINITY; s1[r] = ((w1 >> bit) & 1u) ? s1[r] + tbl[d1 > 0 ? d1 : 0] : -INFINITY; } }
            if (MODE == 2) { const int dbase = qpos - k0 - 4 * hh;
#pragma unroll
                for (int r = 0; r < 16; ++r) { const int d0 = dbase - ((r & 3) + 8 * (r >> 2)), d1 = d0 - 32;
                    s0[r] = d0 >= 0 ? s0[r] + tbl[d0] : -INFINITY; s1[r] = d1 >= 0 ? s1[r] + tbl[d1] : -INFINITY; } }
            float mx = s0[0];
#pragma unroll
            for (int r = 1; r < 16; ++r) mx = fmaxf(mx, s0[r]);
#pragma unroll
            for (int r = 0; r < 16; ++r) mx = fmaxf(mx, s1[r]);
            mx = fmaxf(mx, __shfl_xor(mx, 32));
            const float mnew = fmaxf(mrun, mx), muse = (mnew == -INFINITY) ? 0.f : mnew;
            const float alpha = exp2f(mrun - muse);
            mrun = mnew;
            float ps = 0.f;
#pragma unroll
            for (int r = 0; r < 16; ++r) { s0[r] = exp2f(s0[r] - muse); s1[r] = exp2f(s1[r] - muse); ps += s0[r] + s1[r]; }
            lsum = lsum * alpha + ps;
#pragma unroll
            for (int r = 0; r < 16; ++r) { o0[r] *= alpha; o1[r] *= alpha; }
            bf16x8 pb[4];
#pragma unroll
            for (int s2 = 0; s2 < 2; ++s2) {
                u32x4 a = {cvt_pk(s0[8 * s2 + 0], s0[8 * s2 + 1]), cvt_pk(s0[8 * s2 + 2], s0[8 * s2 + 3]), cvt_pk(s0[8 * s2 + 4], s0[8 * s2 + 5]), cvt_pk(s0[8 * s2 + 6], s0[8 * s2 + 7])};
                u32x4 c = {cvt_pk(s1[8 * s2 + 0], s1[8 * s2 + 1]), cvt_pk(s1[8 * s2 + 2], s1[8 * s2 + 3]), cvt_pk(s1[8 * s2 + 4], s1[8 * s2 + 5]), cvt_pk(s1[8 * s2 + 6], s1[8 * s2 + 7])};
                pb[s2] = __builtin_bit_cast(bf16x8, a); pb[2 + s2] = __builtin_bit_cast(bf16x8, c); }
            const int vlane = (4 * hh + ((lane & 15) >> 2)) * 64 + (((lane >> 4) & 1) * 16 + 4 * (lane & 3)) * 2;
#pragma unroll
            for (int dt = 0; dt < 2; ++dt) {
#pragma unroll
                for (int kk = 0; kk < 4; ++kk) {
                    const LAS unsigned char* va = vb + dt * 4096 + kk * 16 * 64 + vlane;
                    const s16x4 lo = __builtin_bit_cast(s16x4, __builtin_amdgcn_ds_read_tr16_b64_v4i16((LAS s16x4*)(va)));
                    const s16x4 hi = __builtin_bit_cast(s16x4, __builtin_amdgcn_ds_read_tr16_b64_v4i16((LAS s16x4*)(va + 8 * 64)));
                    const bf16x8 vf = {lo[0], lo[1], lo[2], lo[3], hi[0], hi[1], hi[2], hi[3]};
                    if (dt == 0) o0 = __builtin_amdgcn_mfma_f32_32x32x16_bf16(vf, pb[kk], o0, 0, 0, 0);
                    else o1 = __builtin_amdgcn_mfma_f32_32x32x16_bf16(vf, pb[kk], o1, 0, 0, 0); } }
        }
        if (t + 1 < ntile) { const int nb = (t + 1) & 1;
            *(LAS u32x4*)(lds + AT_K0 + nb * AT_KSZ + kdst) = kreg; *(LAS u32x4*)(lds + AT_V0 + nb * AT_VSZ + vdst) = vreg;
            if (MODE == 0 && tid < 256) *(LAS u32x4*)(lds + AT_K0 + nb * AT_KSZ + rdst) = rreg;
            if (MODE == 1) mw = mwn; }
        __syncthreads();
    }
    const float ltot = lsum + __shfl_xor(lsum, 32);
    const float inv = ltot > 0.f ? 1.0f / ltot : 0.f;
    bf16_t* orow = Op + (tb + qpos) * 1024 + 4 * hh;
#pragma unroll
    for (int g = 0; g < 4; ++g) {
        *(u32x2*)(orow + 8 * g) = (u32x2){cvt_pk(o0[4 * g] * inv, o0[4 * g + 1] * inv), cvt_pk(o0[4 * g + 2] * inv, o0[4 * g + 3] * inv)};
        *(u32x2*)(orow + 32 + 8 * g) = (u32x2){cvt_pk(o1[4 * g] * inv, o1[4 * g + 1] * inv), cvt_pk(o1[4 * g + 2] * inv, o1[4 * g + 3] * inv)}; }
}

__device__ __forceinline__ void phase_attention(const Frame& F, const Params& p) {
    for (int L = (int)blockIdx.x; L < 2048; L += F.G) {
        const int level = L >> 8, idx = ((L & 255) + 37 * level) & 255, qb = 7 - level;
        if (idx < 96) { const int b = idx / 6, h = idx % 6;
            attn_unit<0, 6>(F, b, qb, fMQ(F) + h * 96, 576, fMK(F) + h * 64, 384, fKR(F), fMV(F) + h * 64, 384, fAO(F) + 640 + h * 64, nullptr, nullptr, 0);
        } else if (idx < 160) { const int j = idx - 96, b = j >> 2, h = j & 3;
            attn_unit<1, 4>(F, b, qb, fU(F) + U_SQ + h * 64, LDU, fU(F) + U_SK + h * 64, LDU, nullptr, fU(F) + U_SV + h * 64, LDU, fAO(F) + 384 + h * 64, fMASK(F), p.rel_bias, 6 + h);
        } else { const int j = idx - 160, b = j / 6, h = j % 6;
            attn_unit<2, 4>(F, b, qb, fU(F) + U_DQ + h * 64, LDU, fU(F) + U_DK + h * 64, LDU, nullptr, fU(F) + U_DV + h * 64, LDU, fAO(F) + h * 64, nullptr, p.rel_bias, h);
        }
    }
}
__device__ __forceinline__ void indexer_block(const Frame& F, const int b, const int qk) {
    LAS unsigned char* lds = F.lds;
    const int tid = F.tid, lane = F.lane, w = F.wave, q32 = lane & 31, hh = lane >> 5;
    const size_t tb = (size_t)b * SEQ; const int q0 = 32 * qk, ntile = qk + 1;
    float* scr = fSCR(F) + (size_t)blockIdx.x * (32 * 2048);
    __syncthreads();
#pragma unroll
    for (int i = 0; i < 4; ++i) { const int idx = tid + 512 * i, q = idx >> 6, c = idx & 63;
        *(LAS u32x4*)(lds + c * 512 + q * 16) = *(const u32x4*)(fU(F) + (tb + q0 + q) * LDU + U_IQ + 8 * c); }
    if (tid < 256) { const int q = tid >> 3, h8 = tid & 7; ((LAS float*)(lds + 32768))[h8 * 32 + q] = bf2f(fU(F)[(tb + q0 + q) * LDU + U_IW + h8]); }
    __syncthreads();
    const int qpos = q0 + q32;
#pragma unroll 1
    for (int ti = w; ti < ntile; ti += NWAVES) {
        const int key0 = 32 * ti;
        bf16x8 kf[4];
        { const bf16_t* kr = fU(F) + (tb + key0 + q32) * LDU + U_IK + 8 * hh;
#pragma unroll
          for (int ks = 0; ks < 4; ++ks) kf[ks] = *(const bf16x8*)(kr + 16 * ks); }
        f32x16 sc;
#pragma unroll
        for (int r = 0; r < 16; ++r) sc[r] = 0.f;
#pragma unroll 1
        for (int h8 = 0; h8 < 8; ++h8) {
            const float iwq = ((const LAS float*)(lds + 32768))[h8 * 32 + q32];
            f32x16 a;
#pragma unroll
            for (int r = 0; r < 16; ++r) a[r] = 0.f;
#pragma unroll
            for (int ks = 0; ks < 4; ++ks) { const bf16x8 qv = *(const LAS bf16x8*)(lds + (8 * h8 + 2 * ks + hh) * 512 + q32 * 16);
                a = __builtin_amdgcn_mfma_f32_32x32x16_bf16(kf[ks], qv, a, 0, 0, 0); }
#pragma unroll
            for (int r = 0; r < 16; ++r) sc[r] += iwq * fmaxf(a[r], 0.f);
        }
        if (ti == qk) {
#pragma unroll
            for (int r = 0; r < 16; ++r) { const int key = key0 + (r & 3) + 8 * (r >> 2) + 4 * hh; if (key > qpos) sc[r] = -INFINITY; } }
        float* o = scr + (size_t)q32 * 2048 + key0 + 4 * hh;
#pragma unroll
        for (int g = 0; g < 4; ++g) *(f32x4*)(o + 8 * g) = (f32x4){sc[4 * g], sc[4 * g + 1], sc[4 * g + 2], sc[4 * g + 3]};
    }
    VM_WAIT(); __syncthreads();
#pragma unroll 1
    for (int rr = 0; rr < 4; ++rr) {
        const int ql = w + 8 * rr, q = q0 + ql, n = q + 1;
        unsigned long long myw = 0ull;
        if (n <= 256) {
            if (lane < 32) { const int lo = 64 * lane; myw = (lo + 63 <= q) ? ~0ull : (lo <= q ? ((1ull << (q - lo + 1)) - 1ull) : 0ull); }
        } else {
            float x[32];
            const float* srow = scr + (size_t)ql * 2048 + lane;
#pragma unroll
            for (int j = 0; j < 32; ++j) { x[j] = -INFINITY; if (64 * j < n) { const float v = __builtin_nontemporal_load(srow + 64 * j); x[j] = (64 * j + lane <= q) ? v : -INFINITY; } }
            float mx = -INFINITY, mn = INFINITY;
#pragma unroll
            for (int j = 0; j < 32; ++j) { mx = fmaxf(mx, x[j]); mn = fminf(mn, x[j] == -INFINITY ? INFINITY : x[j]); }
#pragma unroll
            for (int o = 1; o < 64; o <<= 1) { mx = fmaxf(mx, __shfl_xor(mx, o)); mn = fminf(mn, __shfl_xor(mn, o)); }
            float lo = mn, hi = mx, thr = 0.f; bool exact = false;
            int c_hi = 0;
#pragma unroll
            for (int j = 0; j < 32; ++j) c_hi += __builtin_popcountll(__ballot(x[j] >= hi));
            if (c_hi < 256) {
#pragma unroll 1
                for (int it = 0; it < 200; ++it) {
                    const float mid = 0.5f * lo + 0.5f * hi;
                    if (!(mid > lo && mid < hi)) break;
                    int c = 0;
#pragma unroll
                    for (int j = 0; j < 32; ++j) c += __builtin_popcountll(__ballot(x[j] >= mid));
                    if (c == 256) { thr = mid; exact = true; break; }
                    if (c > 256) lo = mid; else { hi = mid; c_hi = c; }
                }
            } else { lo = hi; hi = INFINITY; c_hi = 0; }
            int need = 256 - c_hi;
#pragma unroll
            for (int j = 0; j < 32; ++j) {
                unsigned long long sel;
                if (exact) sel = __ballot(x[j] >= thr);
                else { const unsigned long long eq = __ballot(x[j] == lo); const int rank = __builtin_popcountll(eq & ((1ull << lane) - 1ull));
                    sel = __ballot(x[j] >= hi) | __ballot(x[j] == lo && rank < need); const int ne = __builtin_popcountll(eq); need = need > ne ? need - ne : 0; }
                if (lane == j) myw = sel;
            }
        }
        if (lane < 32) *(unsigned long long*)(fMASK(F) + (tb + q) * 64 + 2 * lane) = myw;
    }
}
__device__ __forceinline__ void phase_indexer(const Frame& F) {
    for (int L = (int)blockIdx.x; L < 512; L += F.G) { const int b = L >> 5, j = L & 31;
#pragma unroll 1
        for (int s = 0; s < 2; ++s) indexer_block(F, b, s ? j : 63 - j); }
}

__device__ __forceinline__ void ln_finish(const Frame& F, f32x4 (&v)[4], const float* g, const float* bta, float* of, bf16_t* ob) {
    float s = 0.f;
#pragma unroll
    for (int j = 0; j < 4; ++j) s += (v[j][0] + v[j][1]) + (v[j][2] + v[j][3]);
    const float mean = wave_sum(s) * (1.f / 1024.f); float s2 = 0.f;
#pragma unroll
    for (int j = 0; j < 4; ++j) { v[j] = v[j] - mean; s2 += (v[j][0] * v[j][0] + v[j][1] * v[j][1]) + (v[j][2] * v[j][2] + v[j][3] * v[j][3]); }
    const float rstd = 1.f / sqrtf(wave_sum(s2) * (1.f / 1024.f) + LN_EPS);
#pragma unroll
    for (int j = 0; j < 4; ++j) { const f32x4 gg = *(const f32x4*)(g + 4 * F.lane + 256 * j), bb = *(const f32x4*)(bta + 4 * F.lane + 256 * j);
        const f32x4 o = v[j] * rstd * gg + bb;
        *(f32x4*)(of + 4 * F.lane + 256 * j) = o;
        if (ob) *(u32x2*)(ob + 4 * F.lane + 256 * j) = (u32x2){cvt_pk(o[0], o[1]), cvt_pk(o[2], o[3])}; }
}
__device__ __forceinline__ void phase_ln1(const Frame& F, const Params& p, int l) {
    const int gw = F.vcu * NWAVES + F.wave, NGW = F.G * NWAVES;
    for (int m = gw; m < T; m += NGW) { float* row = fXF(F) + (size_t)m * 1024; f32x4 v[4];
#pragma unroll
        for (int j = 0; j < 4; ++j) v[j] = *(const f32x4*)(row + 4 * F.lane + 256 * j);
        ln_finish(F, v, p.ln1_g + l * 1024, p.ln1_b + l * 1024, row, fXB(F) + (size_t)m * 1024); }
}
__device__ __forceinline__ void phase_ln2(const Frame& F, const Params& p, int l) {
    const int gw = F.vcu * NWAVES + F.wave, NGW = F.G * NWAVES; const bool lastl = (l == NL - 1);
    for (int m = gw; m < T; m += NGW) { float* row = fXF(F) + (size_t)m * 1024; f32x4 v[4];
#pragma unroll
        for (int j = 0; j < 4; ++j) v[j] = *(const f32x4*)(row + 4 * F.lane + 256 * j);
#pragma unroll
        for (int k = 0; k < 8; ++k) { const bf16_t* y = fYB(F) + ((size_t)m * 8 + k) * 1024 + 4 * F.lane;
#pragma unroll
            for (int j = 0; j < 4; ++j) { const u32x2 u = *(const u32x2*)(y + 256 * j); v[j][0] += bf2f(u[0] & 0xffffu); v[j][1] += bf2f(u[0] >> 16); v[j][2] += bf2f(u[1] & 0xffffu); v[j][3] += bf2f(u[1] >> 16); } }
        ln_finish(F, v, p.ln2_g + l * 1024, p.ln2_b + l * 1024, lastl ? p.out + (size_t)m * 1024 : row, lastl ? nullptr : fXB(F) + (size_t)m * 1024); }
}

__device__ __forceinline__ void phase_route(const Frame& F, const Params& p, int l) {
    LAS int* lcnt = (LAS int*)(F.lds + LDS_TBL + 8192 + 1024); LAS int* lbase = lcnt + 64;
    const float* rb = p.router_b + l * 64;
    const int nth = F.G * NTHR, iters = (T + nth - 1) / nth;
    for (int it = 0; it < iters; ++it) {
        const int t = it * nth + F.vcu * NTHR + F.tid; const bool act = t < T;
        __syncthreads();
        if (F.tid < 64) lcnt[F.tid] = 0;
        __syncthreads();
        int ek[8], pk[8]; float gk[8];
        if (act) {
            float sel[64];
            const float* l0 = fLG(F) + (size_t)t * 64; const float* l1 = fLG(F) + ((size_t)T + t) * 64;
#pragma unroll
            for (int e4 = 0; e4 < 16; ++e4) { const f32x4 a = *(const f32x4*)(l0 + 4 * e4), c = *(const f32x4*)(l1 + 4 * e4), bb = *(const f32x4*)(rb + 4 * e4);
#pragma unroll
                for (int j = 0; j < 4; ++j) sel[4 * e4 + j] = 1.0f / (1.0f + __expf(-(a[j] + c[j]))) + bb[j]; }
            float gs = 0.f;
#pragma unroll
            for (int k = 0; k < 8; ++k) { float best = -INFINITY; int bi = 0;
#pragma unroll
                for (int e = 0; e < 64; ++e) { const bool gt = sel[e] > best; best = gt ? sel[e] : best; bi = gt ? e : bi; }
#pragma unroll
                for (int e = 0; e < 64; ++e) sel[e] = (e == bi) ? -INFINITY : sel[e];
                ek[k] = bi; gk[k] = best - rb[bi]; gs += gk[k]; }
            const float sc = ROUTED_SCALE / gs;
#pragma unroll
            for (int k = 0; k < 8; ++k) { gk[k] *= sc; pk[k] = __hip_atomic_fetch_add(lcnt + ek[k], 1, __ATOMIC_RELAXED, __HIP_MEMORY_SCOPE_WORKGROUP); }
        }
        __syncthreads();
        if (F.tid < 64) { const int c = lcnt[F.tid]; lbase[F.tid] = c ? (int)__hip_atomic_fetch_add(F.ctl + CW_CNT + l * 64 + F.tid, (unsigned)c, __ATOMIC_RELAXED, __HIP_MEMORY_SCOPE_AGENT) : 0; }
        __syncthreads();
        if (act) {
#pragma unroll
            for (int k = 0; k < 8; ++k) { fLST(F)[(size_t)ek[k] * T + lbase[ek[k]] + pk[k]] = (unsigned)(t * 8 + k); fGATE(F)[(size_t)t * 8 + k] = gk[k]; } }
    }
}
__device__ __forceinline__ void frame_init(Frame& F, const Params& p, unsigned char* lds) {
    F.lds = (LAS unsigned char*)lds; F.MISC = (volatile LAS unsigned*)(F.lds + LDS_MISC);
    F.tid = threadIdx.x; F.lane = F.tid & 63; F.wave = __builtin_amdgcn_readfirstlane(F.tid >> 6);
    F.G = gridDim.x; { const int bx = blockIdx.x; F.vcu = (F.G % 8 == 0) ? (bx % 8) * (F.G / 8) + bx / 8 : bx; }
    F.ws = p.ws; F.ctl = (unsigned*)(p.ws + WS_CTL);
}

constexpr int NPHASE = 1 + 10 * NL;
__global__ void __launch_bounds__(NTHR, 2) mega(Params p) {
    extern __shared__ __attribute__((aligned(16))) unsigned char lds_raw[];
    Frame F; frame_init(F, p, lds_raw);
    if (F.tid < 64) F.MISC[F.tid] = 0u;
    __syncthreads();
    const int lo = p.ph_lo, hi = p.ph_hi;
    XcdBarrier bar; bar.bar = F.ctl + CW_BAR; bar.x = 0; bar.st = F.MISC + 8;
    if (hi - lo > 1) bar = xcd_barrier_post(F.ctl + CW_BAR, F.MISC + 8);
#define IN(k) (lo <= (k) && (k) < hi)
#define SEAM(k) do { if (IN(k) && IN((k) + 1)) xcd_barrier(bar); } while (0)
    if (IN(0)) { const Frame Fp = phase_frame(F); phase_x_to_xb(Fp, p.x); phase_rope_table(Fp, p.pos); convert_layer(Fp, p, 0); }
    SEAM(0);
    for (int l = 0; l < NL; ++l) {
        const int pb = 1 + 10 * l;
        if (IN(pb + 0)) phase_inproj(phase_frame(F));
        SEAM(pb + 0);
        if (IN(pb + 1)) { phase_mla_up(phase_frame(F), p); phase_indexer(phase_frame(F)); }
        SEAM(pb + 1);
        if (IN(pb + 2)) phase_attention(phase_frame(F), p);
        SEAM(pb + 2);
        if (IN(pb + 3)) { const Frame Fp = phase_frame(F); phase_outproj(Fp, l == 0 ? p.x : fXF(Fp)); }
        SEAM(pb + 3);
        if (IN(pb + 4)) phase_ln1(phase_frame(F), p, l);
        SEAM(pb + 4);
        if (IN(pb + 5)) phase_router_sharedg1(phase_frame(F));
        SEAM(pb + 5);
        if (IN(pb + 6)) { phase_route(phase_frame(F), p, l); phase_shared_g2(phase_frame(F)); }
        SEAM(pb + 6);
        if (IN(pb + 7)) phase_moe_g1(phase_frame(F), l);
        SEAM(pb + 7);
        if (IN(pb + 8)) phase_moe_g2(phase_frame(F), l);
        SEAM(pb + 8);
        if (IN(pb + 9)) { phase_ln2(phase_frame(F), p, l); if (l + 1 < NL) convert_layer(phase_frame(F), p, l + 1); }
        SEAM(pb + 9);
    }
#undef IN
#undef SEAM
}
#ifndef DBG
#define DBG 0
#endif
#if DBG
__device__ __forceinline__ unsigned dhash(unsigned x) { x ^= x >> 16; x *= 0x7feb352du; x ^= x >> 15; x *= 0x846ca68bu; x ^= x >> 16; return x; }
__device__ __forceinline__ float bfr(float v) { return bf2f(f2bf(v)); }
__device__ double blk_sum(double v, double* sh) {
    sh[threadIdx.x] = v; __syncthreads();
    for (int o = 128; o > 0; o >>= 1) { if ((int)threadIdx.x < o) sh[threadIdx.x] += sh[threadIdx.x + o]; __syncthreads(); }
    const double r = sh[0]; __syncthreads(); return r;
}
__device__ void dflag(unsigned* ctl, int id, float got, float ref) { atomicOr(&ctl[CW_FLAG + id], 1u); atomicMax(&ctl[CW_FLAG + 32 + id], __float_as_uint(fabsf(got - ref))); }
__device__ bool dbad(float got, float ref, float rt, float at) { return !(fabsf(got - ref) <= at + rt * fabsf(ref)); }
#define DF Frame F; F.ws = p.ws; F.ctl = (unsigned*)p.ws;

__global__ void __launch_bounds__(256) chk_u(Params p) { DF __shared__ double sh[256];
    const unsigned hsh = dhash(blockIdx.x * 2654435761u + 1u); const int t = hsh % T; const int col = (blockIdx.x < 8) ? 2976 + blockIdx.x : (dhash(hsh) % 2976);
    int n = -1; if (col < 2504) n = col; else if (col >= 2560 && col < 2976) n = col - 56;
    double s = 0; if (n >= 0) { const float sc = (n < 384 || (n >= 1152 && n < 1408)) ? QSCALE : 1.f; for (int k = threadIdx.x; k < 1024; k += 256) s += (double)bf2f(fXB(F)[(size_t)t * 1024 + k]) * bfr(p.w_in[(size_t)k * IN_W + n] * sc); }
    s = blk_sum(s, sh); if (threadIdx.x == 0) { const float got = bf2f(fU(F)[(size_t)t * LDU + col]); if (dbad(got, (float)s, 0.02f, 0.02f)) dflag(F.ctl, 1, got, (float)s); } }
__global__ void __launch_bounds__(256) chk_mq(Params p) { DF __shared__ double sh[256];
    const unsigned hsh = dhash(blockIdx.x * 2654435761u + 2u); const int t = hsh % T, c = dhash(hsh) % 576, w = c % 96;
    const int cp = w >= 80 ? c - 16 : (w >= 64 ? c + 16 : c);
    double a = 0, b = 0, ss = 0; { const int k = threadIdx.x; const float x = bf2f(fU(F)[(size_t)t * LDU + U_CQ + k]); ss = (double)x * x;
        a = (double)x * bfr(p.w_uq[(size_t)k * 576 + c] * (p.q_norm[k] * MLA_QSCALE)); b = (double)x * bfr(p.w_uq[(size_t)k * 576 + cp] * (p.q_norm[k] * MLA_QSCALE)); }
    a = blk_sum(a, sh); b = blk_sum(b, sh); ss = blk_sum(ss, sh);
    if (threadIdx.x == 0) { const double r = 1.0 / sqrt(ss / 256.0 + 1e-6); double v = a * r;
        if (w >= 64) { const int i = (w - 64) & 15; const double ang = (double)p.pos[t] * pow(10000.0, -(double)i / 16.0); v = w < 80 ? a * r * cos(ang) - b * r * sin(ang) : a * r * cos(ang) + b * r * sin(ang); }
        const float got = bf2f(fMQ(F)[(size_t)t * 576 + c]); if (dbad(got, (float)v, 0.03f, 0.02f)) dflag(F.ctl, 2, got, (float)v); } }
__global__ void __launch_bounds__(256) chk_kv(Params p) { DF __shared__ double sh[256];
    const unsigned hsh = dhash(blockIdx.x * 2654435761u + 3u); const int t = hsh % T, which = blockIdx.x % 3, c = dhash(hsh) % 384, h = c >> 6, d = c & 63;
    if (which < 2) { double a = 0, ss = 0; if (threadIdx.x < 128) { const int k = threadIdx.x; const float x = bf2f(fU(F)[(size_t)t * LDU + U_CKV + k]); ss = (double)x * x; a = (double)x * bfr(p.w_ukv[(size_t)k * 768 + h * 128 + which * 64 + d] * p.kv_norm[k]); }
        a = blk_sum(a, sh); ss = blk_sum(ss, sh);
        if (threadIdx.x == 0) { const float ref = (float)(a / sqrt(ss / 128.0 + 1e-6)); const float got = bf2f((which ? fMV(F) : fMK(F))[(size_t)t * 384 + c]); if (dbad(got, ref, 0.03f, 0.02f)) dflag(F.ctl, 3, got, ref); } }
    else if (threadIdx.x == 0) { const int j = c & 15, hi = (c >> 4) & 1; const double x1 = bf2f(fU(F)[(size_t)t * LDU + U_KR + j]), x2 = bf2f(fU(F)[(size_t)t * LDU + U_KR + 16 + j]);
        const double ang = (double)p.pos[t] * pow(10000.0, -(double)j / 16.0); const float ref = (float)(hi ? x2 * cos(ang) + x1 * sin(ang) : x1 * cos(ang) - x2 * sin(ang));
        const float got = bf2f(fKR(F)[(size_t)t * 32 + hi * 16 + j]); if (dbad(got, ref, 0.02f, 0.02f)) dflag(F.ctl, 3, got, ref); } }
__global__ void __launch_bounds__(256) chk_mask(Params p) { DF __shared__ float sc[2048]; __shared__ float iq[512]; __shared__ float iw[8]; __shared__ int mism;
    const unsigned hsh = dhash(blockIdx.x * 2654435761u + 4u); const int b = hsh % NB; int q = dhash(hsh) % SEQ; if (blockIdx.x < 4) q = 254 + blockIdx.x; if (blockIdx.x == 4) q = 2047; if (blockIdx.x == 5) q = 3;
    const size_t tb = (size_t)b * SEQ;
    for (int i = threadIdx.x; i < 512; i += 256) iq[i] = bf2f(fU(F)[(tb + q) * LDU + U_IQ + i]); if (threadIdx.x < 8) iw[threadIdx.x] = bf2f(fU(F)[(tb + q) * LDU + U_IW + threadIdx.x]); if (threadIdx.x == 0) mism = 0;
    __syncthreads();
    for (int s = threadIdx.x; s < SEQ; s += 256) { float v = -INFINITY; if (s <= q) { v = 0.f; _Pragma("unroll 1") for (int h = 0; h < 8; ++h) { float d = 0.f; _Pragma("unroll 2") for (int k = 0; k < 64; ++k) d += iq[h * 64 + k] * bf2f(fU(F)[(tb + s) * LDU + U_IK + k]); v += iw[h] * fmaxf(d, 0.f); } } sc[s] = v; }
    __syncthreads();
    for (int s = threadIdx.x; s < SEQ; s += 256) { bool want = false; if (s <= q) { if (q + 1 <= 256) want = true; else { int rank = 0; const float v = sc[s]; _Pragma("unroll 4") for (int j = 0; j <= q; ++j) rank += (sc[j] > v || (sc[j] == v && j < s)) ? 1 : 0; want = rank < 256; } }
        const bool got = (fMASK(F)[(tb + q) * 64 + (s >> 5)] >> (s & 31)) & 1u; if (got != want) atomicAdd(&mism, 1); }
    __syncthreads(); if (threadIdx.x == 0 && mism > 6) dflag(F.ctl, 4, (float)mism, 0.f); }
__global__ void __launch_bounds__(256) chk_ao(Params p) { DF __shared__ double sh[256]; __shared__ float lg[2048]; __shared__ float qv[96];
    const unsigned hsh = dhash(blockIdx.x * 2654435761u + 5u); const int b = hsh % NB; int q = dhash(hsh) % SEQ; if (blockIdx.x < 6) q = (blockIdx.x & 1) ? 2047 : 700; const int mode = blockIdx.x % 3;
    const size_t tb = (size_t)b * SEQ; const unsigned h2 = dhash(hsh + 77u);
    int h, d, col; if (mode == 0) { h = h2 % 6; d = (h2 >> 8) & 63; col = 640 + h * 64 + d; } else if (mode == 1) { h = h2 % 4; d = (h2 >> 8) & 63; col = 384 + h * 64 + d; } else { h = h2 % 6; d = (h2 >> 8) & 63; col = h * 64 + d; }
    if (threadIdx.x < 96) { float v = 0.f; if (mode == 0) v = bf2f(fMQ(F)[(tb + q) * 576 + h * 96 + threadIdx.x]); else if (threadIdx.x < 64) v = bf2f(fU(F)[(tb + q) * LDU + (mode == 1 ? U_SQ : U_DQ) + h * 64 + threadIdx.x]); qv[threadIdx.x] = v; }
    __syncthreads();
    float mx = -INFINITY;
    for (int s = threadIdx.x; s < SEQ; s += 256) { float v = -INFINITY;
        if (s <= q) { const int dist = q - s; float dot = 0.f;
            if (mode == 0) { _Pragma("unroll 2") for (int k = 0; k < 64; ++k) dot += qv[k] * bf2f(fMK(F)[(tb + s) * 384 + h * 64 + k]); _Pragma("unroll 2") for (int k = 0; k < 32; ++k) dot += qv[64 + k] * bf2f(fKR(F)[(tb + s) * 32 + k]); v = dot; }
            else if (mode == 1) { if ((fMASK(F)[(tb + q) * 64 + (s >> 5)] >> (s & 31)) & 1u) { _Pragma("unroll 2") for (int k = 0; k < 64; ++k) dot += qv[k] * bf2f(fU(F)[(tb + s) * LDU + U_SK + h * 64 + k]); v = dot + t5_dist_bias(p.rel_bias, 6 + h, dist) * LOG2E; } }
            else { int mlt = 0; if (dist <= 128) ++mlt; if (dist % 4 == 0 && dist / 4 <= 128) ++mlt; if (dist % 16 == 0 && dist / 16 <= 128) ++mlt;
                if (mlt) { _Pragma("unroll 2") for (int k = 0; k < 64; ++k) dot += qv[k] * bf2f(fU(F)[(tb + s) * LDU + U_DK + h * 64 + k]); v = dot + t5_dist_bias(p.rel_bias, h, dist) * LOG2E + log2f((float)mlt); } } }
        lg[s] = v; mx = fmaxf(mx, v); }
    sh[threadIdx.x] = mx; __syncthreads(); for (int o = 128; o > 0; o >>= 1) { if ((int)threadIdx.x < o) sh[threadIdx.x] = fmax(sh[threadIdx.x], sh[threadIdx.x + o]); __syncthreads(); } const float M = (float)sh[0]; __syncthreads();
    double num = 0, den = 0;
    for (int s = threadIdx.x; s < SEQ; s += 256) if (lg[s] > -INFINITY) { const double pw = exp2((double)(lg[s] - M));
        const float vv = mode == 0 ? bf2f(fMV(F)[(tb + s) * 384 + h * 64 + d]) : bf2f(fU(F)[(tb + s) * LDU + (mode == 1 ? U_SV : U_DV) + h * 64 + d]); num += pw * vv; den += pw; }
    num = blk_sum(num, sh); den = blk_sum(den, sh);
    if (threadIdx.x == 0) { const float ref = (float)(num / den), got = bf2f(fAO(F)[(tb + q) * 1024 + col]); if (dbad(got, ref, 0.03f, 0.01f)) dflag(F.ctl, 5 + mode, got, ref); } }
__global__ void __launch_bounds__(256) chk_y1(Params p) { DF __shared__ double sh[256];
    const unsigned hsh = dhash(blockIdx.x * 2654435761u + 8u); const int t = hsh % T, c = dhash(hsh) % 1024;
    double s = 0; for (int k = threadIdx.x; k < 1024; k += 256) s += (double)bf2f(fAO(F)[(size_t)t * 1024 + k]) * bfr(p.w_out[(size_t)k * 1024 + c]);
    s = blk_sum(s, sh); if (threadIdx.x == 0) { const float ref = (float)(s + (double)DN_ALPHA * p.x[(size_t)t * 1024 + c]), got = fXF(F)[(size_t)t * 1024 + c]; if (dbad(got, ref, 0.01f, 0.01f)) dflag(F.ctl, 8, got, ref); } }
__global__ void __launch_bounds__(256) chk_ln_pre(Params p, float* side, const float* g, const float* bt, int with_yb) { DF __shared__ double sh[256];
    const int t = dhash(blockIdx.x * 2654435761u + 9u) % T; double v[4]; double s = 0;
    for (int j = 0; j < 4; ++j) { const int c = threadIdx.x + 256 * j; double x = fXF(F)[(size_t)t * 1024 + c]; if (with_yb) for (int k = 0; k < 8; ++k) x += bf2f(fYB(F)[((size_t)t * 8 + k) * 1024 + c]); v[j] = x; s += x; }
    const double mean = blk_sum(s, sh) / 1024.0; double s2 = 0; for (int j = 0; j < 4; ++j) s2 += (v[j] - mean) * (v[j] - mean);
    const double rstd = 1.0 / sqrt(blk_sum(s2, sh) / 1024.0 + 1e-5);
    for (int j = 0; j < 4; ++j) { const int c = threadIdx.x + 256 * j; side[(size_t)blockIdx.x * 1024 + c] = (float)((v[j] - mean) * rstd * g[c] + bt[c]); } }
__global__ void __launch_bounds__(256) chk_ln_post(Params p, const float* side, const float* got_base, int id, int chk_xb) { DF
    const int t = dhash(blockIdx.x * 2654435761u + 9u) % T;
    for (int j = 0; j < 4; ++j) { const int c = threadIdx.x + 256 * j; const float ref = side[(size_t)blockIdx.x * 1024 + c], got = got_base[(size_t)t * 1024 + c];
        if (dbad(got, ref, 1e-3f, 1e-3f)) dflag(F.ctl, id, got, ref);
        if (chk_xb) { const float gb = bf2f(fXB(F)[(size_t)t * 1024 + c]); if (dbad(gb, ref, 0.01f, 0.01f)) dflag(F.ctl, id, gb, ref); } } }
__global__ void __launch_bounds__(256) chk_lg(Params p) { DF __shared__ double sh[256];
    const unsigned hsh = dhash(blockIdx.x * 2654435761u + 11u); const int t = hsh % T;
    if (blockIdx.x & 1) { const int e = dhash(hsh) % 64; double s = 0; for (int k = threadIdx.x; k < 1024; k += 256) s += (double)bf2f(fXB(F)[(size_t)t * 1024 + k]) * bfr(p.router_w[(size_t)k * 64 + e]);
        s = blk_sum(s, sh); if (threadIdx.x == 0) { const float got = fLG(F)[(size_t)t * 64 + e] + fLG(F)[((size_t)T + t) * 64 + e]; if (dbad(got, (float)s, 0.01f, 0.01f)) dflag(F.ctl, 11, got, (float)s); } }
    else { const int f = dhash(hsh) % 256; double a = 0, b = 0; for (int k = threadIdx.x; k < 1024; k += 256) { const double x = bf2f(fXB(F)[(size_t)t * 1024 + k]); a += x * bfr(p.sw1[(size_t)k * 256 + f]); b += x * bfr(p.sw3[(size_t)k * 256 + f]); }
        a = blk_sum(a, sh); b = blk_sum(b, sh); if (threadIdx.x == 0) { const float ref = (float)(a / (1.0 + exp(-a)) * b), got = bf2f(fH(F)[((size_t)T * 8 + t) * 256 + f]); if (dbad(got, ref, 0.03f, 0.01f)) dflag(F.ctl, 12, got, ref); } } }
__global__ void __launch_bounds__(256) chk_route(Params p) { DF __shared__ float sel[64]; __shared__ float scv[64]; __shared__ int ek[8]; __shared__ float gk[8]; __shared__ int found[8];
    const int t = dhash(blockIdx.x * 2654435761u + 13u) % T;
    if (threadIdx.x < 64) { const float lgv = fLG(F)[(size_t)t * 64 + threadIdx.x] + fLG(F)[((size_t)T + t) * 64 + threadIdx.x]; const float s = 1.f / (1.f + expf(-lgv)); scv[threadIdx.x] = s; sel[threadIdx.x] = s + p.router_b[threadIdx.x]; }
    if (threadIdx.x < 8) found[threadIdx.x] = 0;
    __syncthreads();
    if (threadIdx.x == 0) { float gs = 0.f; for (int k = 0; k < 8; ++k) { int bi = 0; float best = -INFINITY; for (int e = 0; e < 64; ++e) if (sel[e] > best) { best = sel[e]; bi = e; } sel[bi] = -INFINITY; ek[k] = bi; gk[k] = scv[bi]; gs += scv[bi]; }
        for (int k = 0; k < 8; ++k) gk[k] = gk[k] / gs * ROUTED_SCALE;
        if (blockIdx.x == 0) { unsigned tot = 0; for (int e = 0; e < 64; ++e) tot += F.ctl[CW_CNT + e]; if (tot != (unsigned)T * 8u) dflag(F.ctl, 13, (float)tot, (float)(T * 8)); } }
    __syncthreads();
    for (int k = 0; k < 8; ++k) { const int e = ek[k]; const int n = (int)F.ctl[CW_CNT + e]; for (int i = threadIdx.x; i < n; i += 256) if (fLST(F)[(size_t)e * T + i] == (unsigned)(t * 8 + k)) atomicAdd(&found[k], 1); }
    __syncthreads();
    if (threadIdx.x < 8) { if (found[threadIdx.x] != 1) dflag(F.ctl, 14, (float)found[threadIdx.x], 1.f); const float got = fGATE(F)[(size_t)t * 8 + threadIdx.x]; if (dbad(got, gk[threadIdx.x], 2e-3f, 1e-4f)) dflag(F.ctl, 15, got, gk[threadIdx.x]); } }
__global__ void __launch_bounds__(256) chk_z0(Params p) { DF __shared__ double sh[256];
    const unsigned hsh = dhash(blockIdx.x * 2654435761u + 16u); const int t = hsh % T, c = dhash(hsh) % 1024;
    double s = 0; { const int f = threadIdx.x; s = (double)bf2f(fH(F)[((size_t)T * 8 + t) * 256 + f]) * bfr(p.sw2[(size_t)f * 1024 + c]); }
    s = blk_sum(s, sh); if (threadIdx.x == 0) { const float ref = (float)(s + (double)DN_ALPHA * bf2f(fXB(F)[(size_t)t * 1024 + c])), got = fXF(F)[(size_t)t * 1024 + c]; if (dbad(got, ref, 0.03f, 0.03f)) dflag(F.ctl, 16, got, ref); } }
__global__ void __launch_bounds__(256) chk_moe(Params p, int stage) { DF __shared__ double sh[256];
    const unsigned hsh = dhash(blockIdx.x * 2654435761u + 17u + stage); const int e = hsh % 64; const int n = (int)F.ctl[CW_CNT + e]; if (n == 0) return;
    const int i = (blockIdx.x < 8) ? ((blockIdx.x & 1) ? n - 1 : 0) : dhash(hsh) % n; const unsigned aid = fLST(F)[(size_t)e * T + i]; const int t = aid >> 3;
    if (stage == 0) { const int f = dhash(hsh + 5u) % 256; double a = 0, b = 0; const float* w1 = p.w1 + (size_t)e * 1024 * 256; const float* w3 = p.w3 + (size_t)e * 1024 * 256;
        for (int k = threadIdx.x; k < 1024; k += 256) { const double x = bf2f(fXB(F)[(size_t)t * 1024 + k]); a += x * bfr(w1[(size_t)k * 256 + f]); b += x * bfr(w3[(size_t)k * 256 + f]); }
        a = blk_sum(a, sh); b = blk_sum(b, sh); if (threadIdx.x == 0) { const float ref = (float)(a / (1.0 + exp(-a)) * b), got = bf2f(fH(F)[(size_t)aid * 256 + f]); if (dbad(got, ref, 0.03f, 0.01f)) dflag(F.ctl, 17, got, ref); } }
    else { const int c = dhash(hsh + 5u) % 1024; const float* w2 = p.w2 + (size_t)e * 256 * 1024; double s = (double)bf2f(fH(F)[(size_t)aid * 256 + threadIdx.x]) * bfr(w2[(size_t)threadIdx.x * 1024 + c]);
        s = blk_sum(s, sh); if (threadIdx.x == 0) { const float ref = (float)(s * fGATE(F)[aid]), got = bf2f(fYB(F)[(size_t)aid * 1024 + c]); if (dbad(got, ref, 0.03f, 0.005f)) dflag(F.ctl, 18, got, ref); } } }
__global__ void __launch_bounds__(256) chk_report(Params p, int zero_if_ok) { DF __shared__ int code;
    if (threadIdx.x == 0) { code = 0; for (int i = 31; i >= 1; --i) if (F.ctl[CW_FLAG + i]) code = i; if (F.ctl[CW_BAR + XB_TMO]) code = 30; } __syncthreads();
    if (code == 0 && !zero_if_ok) return; const float v = sqrtf((float)code);
    for (size_t i = (size_t)blockIdx.x * 256 + threadIdx.x; i < (size_t)T * 1024; i += (size_t)gridDim.x * 256) p.out[i] = v; }

#ifndef DBG_STOP
#define DBG_STOP 41
#endif
static void dbg_run(Params p, int grid, hipStream_t st) {
    float* side = (float*)(p.ws + WS_R + R_SCR);
    float* side2 = (float*)(p.ws + WS_H);
    for (int k = 0; k < NPHASE && k < DBG_STOP; ++k) {
        const int l = (k - 1) / 10, ph = (k - 1) % 10;
        if (k >= 1 && l == 0 && ph == 4) chk_ln_pre<<<64, 256, 0, st>>>(p, side, p.ln1_g, p.ln1_b, 0);
        if (k >= 1 && l == 0 && ph == 9) chk_ln_pre<<<64, 256, 0, st>>>(p, side2, p.ln2_g, p.ln2_b, 1);
        p.ph_lo = k; p.ph_hi = k + 1; mega<<<dim3(grid), dim3(NTHR), LDS_BYTES, st>>>(p);
        if (k < 1 || l != 0) continue;
        if (ph == 0) chk_u<<<256, 256, 0, st>>>(p);
        if (ph == 1) { chk_mq<<<256, 256, 0, st>>>(p); chk_kv<<<255, 256, 0, st>>>(p); chk_mask<<<48, 256, 0, st>>>(p); }
        if (ph == 2) chk_ao<<<96, 256, 0, st>>>(p);
        if (ph == 3) chk_y1<<<256, 256, 0, st>>>(p);
        if (ph == 4) chk_ln_post<<<64, 256, 0, st>>>(p, side, (const float*)(p.ws + WS_XF), 9, 1);
        if (ph == 5) chk_lg<<<256, 256, 0, st>>>(p);
        if (ph == 6) { chk_route<<<64, 256, 0, st>>>(p); chk_z0<<<256, 256, 0, st>>>(p); }
        if (ph == 7) chk_moe<<<256, 256, 0, st>>>(p, 0);
        if (ph == 8) chk_moe<<<256, 256, 0, st>>>(p, 1);
        if (ph == 9) chk_ln_post<<<64, 256, 0, st>>>(p, side2, (const float*)(p.ws + WS_XF), 19, 1);
    }
    chk_report<<<1024, 256, 0, st>>>(p, DBG_STOP < NPHASE ? 1 : 0);
}
#endif
extern "C" void kernel_launch(void* const* d_in, const int* in_sizes, int n_in, void* d_out, int out_size, void* d_ws, size_t ws_size, hipStream_t stream) {
    static int grid = 0;
    if (grid == 0) {
        if (n_in != 21 || out_size != T * DM || ws_size < WS_END) { fprintf(stderr, "kernel_launch: unexpected problem (n_in %d, out %d, ws %zu < %zu); nothing launched\n", n_in, out_size, ws_size, (size_t)WS_END); grid = -1; return; }
        int dev = 0, cus = 0, per_cu = 0;
        if (hipGetDevice(&dev) != hipSuccess || hipDeviceGetAttribute(&cus, hipDeviceAttributeMultiprocessorCount, dev) != hipSuccess) { grid = -1; return; }
        if (hipFuncSetAttribute((const void*)mega, hipFuncAttributeMaxDynamicSharedMemorySize, LDS_BYTES) != hipSuccess) { fprintf(stderr, "kernel_launch: hipFuncSetAttribute failed\n"); grid = -1; return; }
        if (hipOccupancyMaxActiveBlocksPerMultiprocessor(&per_cu, (const void*)mega, NTHR, LDS_BYTES) != hipSuccess || per_cu < 1) { fprintf(stderr, "kernel_launch: occupancy query says %d\n", per_cu); (void)hipGetLastError(); per_cu = 1; }
        grid = cus > 256 ? 256 : cus;
    }
    if (grid < 0) return;
    (void)hipMemsetAsync((char*)d_ws + WS_CTL, 0, CTL_BYTES, stream);
    Params p{};
    p.x = (const float*)d_in[0]; p.pos = (const int*)d_in[1]; p.w_in = (const float*)d_in[2]; p.q_norm = (const float*)d_in[3]; p.w_uq = (const float*)d_in[4];
    p.kv_norm = (const float*)d_in[5]; p.w_ukv = (const float*)d_in[6]; p.w_out = (const float*)d_in[7]; p.ln1_g = (const float*)d_in[8]; p.ln1_b = (const float*)d_in[9];
    p.router_w = (const float*)d_in[10]; p.router_b = (const float*)d_in[11]; p.w1 = (const float*)d_in[12]; p.w3 = (const float*)d_in[13]; p.w2 = (const float*)d_in[14];
    p.sw1 = (const float*)d_in[15]; p.sw3 = (const float*)d_in[16]; p.sw2 = (const float*)d_in[17]; p.ln2_g = (const float*)d_in[18]; p.ln2_b = (const float*)d_in[19]; p.rel_bias = (const float*)d_in[20];
    p.out = (float*)d_out; p.ws = (unsigned char*)d_ws;
#if DBG
    dbg_run(p, grid, stream);
#elif defined(MULTI_LAUNCH)
    for (int k = 0; k < NPHASE; ++k) { p.ph_lo = k; p.ph_hi = k + 1; mega<<<dim3(grid), dim3(NTHR), LDS_BYTES, stream>>>(p); }
#else
    p.ph_lo = 0; p.ph_hi = NPHASE;
    mega<<<dim3(grid), dim3(NTHR), LDS_BYTES, stream>>>(p);
#endif
}
```

```cpp
#define DBG 0
#define DBG_STOP 41
#include <hip/hip_runtime.h>
#include <cstdio>
#include <cstdint>

#define LAS __attribute__((address_space(3)))
typedef unsigned short bf16_t;
typedef short bf16x8 __attribute__((ext_vector_type(8)));
typedef short s16x4 __attribute__((ext_vector_type(4)));
typedef float f32x2 __attribute__((ext_vector_type(2)));
typedef float f32x4 __attribute__((ext_vector_type(4)));
typedef float f32x16 __attribute__((ext_vector_type(16)));
typedef unsigned u32x4 __attribute__((ext_vector_type(4)));
typedef unsigned u32x2 __attribute__((ext_vector_type(2)));
typedef __bf16 bf16x2_t __attribute__((ext_vector_type(2)));

constexpr int NB = 16, SEQ = 2048, T = NB * SEQ, DM = 1024, NL = 4;
constexpr int IN_W = 2920, LDU = 3072;
constexpr int U_DQ = 0, U_DK = 384, U_DV = 768, U_SQ = 1152, U_SK = 1408, U_SV = 1664, U_IQ = 1920, U_IK = 2432, U_IW = 2496, U_CQ = 2560, U_CKV = 2816, U_KR = 2944;
constexpr int NE = 64, FF = 256;
constexpr float LOG2E = 1.4426950408889634f;
constexpr float QSCALE = 0.125f * LOG2E;
constexpr float MLA_QSCALE = 0.10206207261596575f * LOG2E;
constexpr float DN_ALPHA = 1.6817928305074290f;
constexpr float LN_EPS = 1e-5f, RMS_EPS = 1e-6f;
constexpr float ROUTED_SCALE = 2.5f;

constexpr size_t MiB = (size_t)1 << 20;
constexpr size_t WS_CTL = 0, CTL_BYTES = 1 * MiB;
constexpr size_t WS_W = 1 * MiB;
constexpr size_t W_IN = 0, W_UQ = W_IN + (size_t)3072 * 1024 * 2, W_UKV = W_UQ + (size_t)768 * 256 * 2, W_OUT = W_UKV + (size_t)768 * 256 * 2,
                 W_R = W_OUT + (size_t)1024 * 1024 * 2, W_13 = W_R + (size_t)256 * 1024 * 2, W_2 = W_13 + (size_t)65 * 512 * 1024 * 2, W_END = W_2 + (size_t)65 * 1024 * 256 * 2;
static_assert(W_END <= 108 * MiB, "weights region");
constexpr size_t WS_XF = 109 * MiB;
constexpr size_t WS_XB = 237 * MiB;
constexpr size_t WS_H = 301 * MiB;
constexpr size_t WS_LST = 445 * MiB;
constexpr size_t WS_GATE = 453 * MiB;
constexpr size_t WS_ROPE = 454 * MiB;
constexpr size_t WS_R = 458 * MiB;
constexpr size_t R_U = 0, R_MQ = 192 * MiB, R_MK = 228 * MiB, R_MV = 252 * MiB, R_KR = 276 * MiB, R_AO = 278 * MiB, R_MASK = 342 * MiB, R_SCR = 350 * MiB, R_LG = 414 * MiB;
constexpr size_t WS_END = 970 * MiB;
constexpr int CW_TMO = 0, CW_FLAG = 16  , CW_BAR = 4096, CW_CNT = 8192  , CW_Q = 16384  ;

__device__ __forceinline__ unsigned f2bf(float f) { unsigned u = __builtin_bit_cast(unsigned, f); return (u + 0x7fffu + ((u >> 16) & 1u)) >> 16; }
__device__ __forceinline__ float bf2f(unsigned b) { return __builtin_bit_cast(float, b << 16); }
__device__ __forceinline__ unsigned cvt_pk(float lo, float hi) { f32x2 v = {lo, hi}; bf16x2_t b = __builtin_convertvector(v, bf16x2_t); return __builtin_bit_cast(unsigned, b); }
#define LDS_WAIT() asm volatile("s_waitcnt lgkmcnt(0)" ::: "memory")
#define VM_WAIT() asm volatile("s_waitcnt vmcnt(0)" ::: "memory")
__device__ __forceinline__ float wave_sum(float v) {
#pragma unroll
    for (int o = 1; o < 64; o <<= 1) v += __shfl_xor(v, o);
    return v;
}

#define XB_TMO      128
#define XB_XCNT(j)  (256  + 64 * (j))
#define XB_XSUB(j)  (1280 + 64 * (j))
#define XB_XGEN(j)  (2304 + 64 * (j))
#define XB_TOP      3328
#define XB_TOPGEN   3392
#define XCD_BAR_WORDS 3456
#define XB_SPIN_CAP (1u << 18)
__device__ __forceinline__ unsigned xb_ld(unsigned* p)              { return __hip_atomic_load(p, __ATOMIC_RELAXED, __HIP_MEMORY_SCOPE_AGENT); }
__device__ __forceinline__ unsigned xb_add(unsigned* p, unsigned v) { return __hip_atomic_fetch_add(p, v, __ATOMIC_RELAXED, __HIP_MEMORY_SCOPE_AGENT); }
__device__ __forceinline__ unsigned xb_xcc_id() { return (unsigned)__builtin_amdgcn_s_getreg((3 << 11) | 20) & 0xFu; }
#define XB_SPIN(cond, bar) do { unsigned _sp = 0; while (cond) { __builtin_amdgcn_s_sleep(1); \
    if ((++_sp & 255u) == 0u) { if (xb_ld(&(bar)[XB_TMO])) break; if (_sp > XB_SPIN_CAP) { atomicAdd(&(bar)[XB_TMO], 1u); break; } } } } while (0)
struct XcdBarrier { unsigned* bar; unsigned x; volatile LAS unsigned* st; };
__device__ __forceinline__ XcdBarrier xcd_barrier_post(unsigned* bar, volatile LAS unsigned* st) {
    XcdBarrier b; b.bar = bar; b.x = xb_xcc_id(); b.st = st;
    if (threadIdx.x == 0) (void)xb_add(&bar[XB_XCNT(b.x)], 1u);
    return b;
}
__device__ __forceinline__ void xcd_barrier_complete(unsigned* bar, unsigned x, unsigned& nloc, unsigned& nx) {
    const unsigned G = gridDim.x * gridDim.y * gridDim.z;
    unsigned sum, cnt, mine, sp = 0u;
    for (;;) {
        sum = 0u; cnt = 0u; mine = 0u;
#pragma unroll
        for (unsigned j = 0; j < 16; ++j) { const unsigned c = xb_ld(&bar[XB_XCNT(j)]); sum += c; cnt += (c > 0u) ? 1u : 0u; mine = (j == x) ? c : mine; }
        if (sum == G) break;
        __builtin_amdgcn_s_sleep(1);
        if ((++sp & 255u) == 0u) { if (xb_ld(&bar[XB_TMO])) break; if (sp > XB_SPIN_CAP) { atomicAdd(&bar[XB_TMO], 1u); break; } }
    }
    nloc = mine > 0u ? mine : 1u; nx = cnt > 0u ? cnt : 1u;
}
__device__ __forceinline__ void xcd_barrier(const XcdBarrier& b) {
    asm volatile("s_waitcnt vmcnt(0)" ::: "memory");
    __syncthreads();
    if (threadIdx.x == 0) {
        unsigned* bar = b.bar;
        __builtin_amdgcn_s_waitcnt(0);
        unsigned nloc = b.st[0], nx = b.st[1];
        if (nloc == 0u) { xcd_barrier_complete(bar, b.x, nloc, nx); b.st[0] = nloc; b.st[1] = nx; }
        const unsigned old = xb_add(&bar[XB_XSUB(b.x)], 1u);
        const unsigned gen = old / nloc;
        if (old + 1u == (gen + 1u) * nloc) {
            __builtin_amdgcn_fence(__ATOMIC_RELEASE, "agent");
            asm volatile("s_waitcnt vmcnt(0)" ::: "memory");
            const unsigned og = xb_add(&bar[XB_TOP], 1u);
            const unsigned tg = og / nx;
            if (og + 1u == (tg + 1u) * nx) xb_add(&bar[XB_TOPGEN], 1u);
            else XB_SPIN(xb_ld(&bar[XB_TOPGEN]) == tg, bar);
            __builtin_amdgcn_fence(__ATOMIC_ACQUIRE, "agent");
            xb_add(&bar[XB_XGEN(b.x)], 1u);
            asm volatile("s_waitcnt vmcnt(0)" ::: "memory");
        } else {
            XB_SPIN(xb_ld(&bar[XB_XGEN(b.x)]) == gen, bar);
            __builtin_amdgcn_fence(__ATOMIC_ACQUIRE, "agent");
            asm volatile("s_waitcnt vmcnt(0)" ::: "memory");
        }
    }
    __syncthreads();
}

namespace pg8 {
constexpr int BM = 256, BK = 64, HALF = 128, HTB = HALF * BK * 2, STAGE_BYTES = 8 * HTB, NXCD = 8, WGM = 8;
__device__ __forceinline__ int lds_byte(int r, int c) { const int st = (r >> 4) * 2 + (c >> 5), rr = r & 15, cc = c & 31, ob = rr * 64 + cc * 2; return st * 1024 + (ob ^ (((ob >> 9) & 1) << 5)); }
__device__ __forceinline__ void stage_rc(int b, int& R, int& C) { const int st = b / 1024, sb = b % 1024, swz = sb ^ (((sb >> 9) & 1) << 5); R = (st >> 1) * 16 + swz / 64; C = (st & 1) * 32 + (swz % 64) / 2; }
__device__ __forceinline__ int perm32(int rho) { const int n = rho >> 4, i = rho & 15; return 8 * (i >> 2) + 4 * n + (i & 3); }
struct Unit { int pm, pn, e, seq; };

__device__ __forceinline__ int xcd_remap(int L, int nwg) { const int q = nwg / NXCD, r = nwg % NXCD, xcd = L % NXCD, off = L / NXCD; return (xcd < r ? xcd * (q + 1) : r * (q + 1) + (xcd - r) * q) + off; }

struct DenseOrder {
    int nM, nN, nwg, G, c; unsigned lda, acol; const char* Bt; unsigned ldb;
    __device__ void init(int M, int N, int G_, int c_, unsigned lda_, unsigned acol_, const void* Bt_, unsigned ldb_) { nM = M / BM; nN = N / BM; nwg = nM * nN; G = G_; c = c_; lda = lda_; acol = acol_; Bt = (const char*)Bt_; ldb = ldb_; }
    __device__ __forceinline__ bool next(int i, Unit& u) const {
        const long L = (long)i * G + c; if (L >= nwg) return false;
        const int wgid = xcd_remap((int)L, nwg);
        const int nig = WGM * nN, gid = wgid / nig, fm = gid * WGM, gsz = (nM - fm) < WGM ? (nM - fm) : WGM;
        u.pm = fm + ((wgid % nig) % gsz); u.pn = (wgid % nig) / gsz; u.e = 0; u.seq = i; return true;
    }
    __device__ __forceinline__ void a_voff(const Unit& u, int tid, unsigned (&v)[2][2]) const {
#pragma unroll
        for (int i = 0; i < 2; ++i) { int R, C; stage_rc(tid * 16 + i * 8192, R, C);
#pragma unroll
            for (int h = 0; h < 2; ++h) v[h][i] = ((unsigned)(u.pm * BM + h * HALF + R) * lda + acol + (unsigned)C) * 2u; }
    }
    __device__ __forceinline__ const char* b_base(const Unit& u) const { return Bt + (size_t)u.pn * BM * ldb * 2; }
};

template <class Epi, class Sched>
__device__ __forceinline__ void gemm_phase(LAS unsigned char* lds, LAS unsigned char* vslot  , const char* Abase, const int K, const unsigned ldb, const Sched& S, const Epi& E) {
    int tid = threadIdx.x; asm volatile("" : "+v"(tid));
    const int wid = __builtin_amdgcn_readfirstlane(tid >> 6), wr = wid >> 2, wc = wid & 3;
    const int nt = K / BK;
    unsigned voffB[2];
#pragma unroll
    for (int i = 0; i < 2; ++i) { int R, C; stage_rc(tid * 16 + i * 8192, R, C); const int Rb = Epi::PERM ? ((R & ~31) + perm32(R & 31)) : R; voffB[i] = ((unsigned)Rb * ldb + (unsigned)C) * 2u; }
    const size_t kstep = (size_t)(BK * 2);
    const size_t hstepB = (size_t)HALF * ldb * 2;
    const unsigned ldsw = (unsigned)wid * 1024u;
    const int aoff = lds_byte(wr * 64 + (tid & 15), ((tid & 63) >> 4) * 8), boff = lds_byte(wc * 32 + (tid & 15), ((tid & 63) >> 4) * 8);
#define PG8_SA(b, h) (((b) * 2 + (h)) * HTB)
#define PG8_SB(b, h) ((4 + (b) * 2 + (h)) * HTB)
#define PG8_STAGE(bufoff, gbase, voff) do { _Pragma("unroll") for (int _i = 0; _i < 2; ++_i) \
        __builtin_amdgcn_global_load_lds((const unsigned*)((const char*)(gbase) + (voff)[_i]), (LAS unsigned*)(lds + (bufoff) + ldsw + _i * 8192), 16, 0, 0); } while (0)
#define PG8_LDA(dst, b, h) do { _Pragma("unroll") for (int m = 0; m < 4; ++m) _Pragma("unroll") for (int k = 0; k < 2; ++k) dst[m][k] = *(const LAS bf16x8*)(lds + PG8_SA(b, h) + aoff + m * 2048 + k * 1024); } while (0)
#define PG8_LDB(dst, b, h) do { _Pragma("unroll") for (int n = 0; n < 2; ++n) _Pragma("unroll") for (int k = 0; k < 2; ++k) dst[n][k] = *(const LAS bf16x8*)(lds + PG8_SB(b, h) + boff + n * 2048 + k * 1024); } while (0)
#define PG8_MMA(ai, bj, At, Bt) do { __builtin_amdgcn_s_setprio(1); _Pragma("unroll") for (int m = 0; m < 4; ++m) _Pragma("unroll") for (int n = 0; n < 2; ++n) _Pragma("unroll") for (int k = 0; k < 2; ++k) \
        acc[ai][bj][m][n] = __builtin_amdgcn_mfma_f32_16x16x32_bf16(Bt[n][k], At[m][k], acc[ai][bj][m][n], 0, 0, 0); __builtin_amdgcn_s_setprio(0); } while (0)
#define PG8_WAIT_V(n) asm volatile("s_waitcnt vmcnt(" #n ")" ::: "memory")
#define PG8_WAIT_L(n) asm volatile("s_waitcnt lgkmcnt(" #n ")" ::: "memory")
#define PG8_BAR __builtin_amdgcn_s_barrier()
#define PG8_SCHED __builtin_amdgcn_sched_barrier(0)
    Unit cur, nxt; int ui = 0;
    if (!S.next(0, cur)) return;
    f32x4 acc[2][2][4][2];
#pragma unroll
    for (int a = 0; a < 2; ++a)
#pragma unroll
        for (int b = 0; b < 2; ++b)
#pragma unroll
            for (int m = 0; m < 4; ++m)
#pragma unroll
                for (int n = 0; n < 2; ++n) acc[a][b][m][n] = (f32x4){0.f, 0.f, 0.f, 0.f};
    bf16x8 At[4][2], B0[2][2], B1[2][2];
    unsigned vc[2][2];
    S.a_voff(cur, tid, vc);
    const char* cB = S.b_base(cur);
    PG8_STAGE(PG8_SB(0, 0), cB, voffB); PG8_STAGE(PG8_SA(0, 0), Abase, vc[0]); PG8_STAGE(PG8_SB(0, 1), cB + hstepB, voffB); PG8_STAGE(PG8_SA(0, 1), Abase, vc[1]);
    if (wr == 1) PG8_BAR;
    PG8_WAIT_V(4); PG8_BAR;
    PG8_STAGE(PG8_SB(1, 0), cB + kstep, voffB); PG8_STAGE(PG8_SA(1, 0), Abase + kstep, vc[0]); PG8_STAGE(PG8_SB(1, 1), cB + hstepB + kstep, voffB);
    PG8_WAIT_V(6); PG8_BAR;
    for (;;) {
        const bool has_next = S.next(ui + 1, nxt);
        const char* nB = has_next ? S.b_base(nxt) : cB;
        if (has_next) { unsigned vn[2][2]; int tz = threadIdx.x; asm volatile("" : "+v"(tz)); S.a_voff(nxt, tz, vn); *(LAS u32x4*)(vslot + tz * 16) = (u32x4){vn[0][0], vn[0][1], vn[1][0], vn[1][1]}; }
#pragma unroll 1
        for (int t = 0; t < nt; t += 2) {
            const bool last = (t == nt - 2);
            const char* a1 = Abase + (size_t)(t + 1) * kstep;
            const char* a2 = last ? Abase : Abase + (size_t)(t + 2) * kstep; const char* b2 = last ? nB : cB + (size_t)(t + 2) * kstep;
            const char* a3 = a2 + kstep; const char* b3 = b2 + kstep;
            u32x4 vnx = (u32x4){vc[0][0], vc[0][1], vc[1][0], vc[1][1]};
            if (last && has_next) vnx = *(const LAS u32x4*)(vslot + tid * 16);
            PG8_LDB(B0, 0, 0); PG8_SCHED; PG8_LDA(At, 0, 0); PG8_STAGE(PG8_SA(1, 1), a1, vc[1]);
            vc[0][0] = vnx[0]; vc[0][1] = vnx[1]; vc[1][0] = vnx[2]; vc[1][1] = vnx[3];
            PG8_WAIT_L(8); PG8_BAR; PG8_WAIT_L(0); PG8_MMA(0, 0, At, B0); PG8_BAR; PG8_SCHED;
            PG8_LDB(B1, 0, 1); PG8_STAGE(PG8_SB(0, 0), b2, voffB);
            PG8_BAR; PG8_WAIT_L(0); PG8_MMA(0, 1, At, B1); PG8_BAR;
            PG8_LDA(At, 0, 1); PG8_STAGE(PG8_SA(0, 0), a2, vc[0]);
            PG8_BAR; PG8_WAIT_L(0); PG8_MMA(1, 0, At, B0); PG8_BAR; PG8_SCHED;
            PG8_STAGE(PG8_SB(0, 1), b2 + hstepB, voffB);
            PG8_WAIT_V(6); PG8_BAR; PG8_MMA(1, 1, At, B1); PG8_BAR;
            PG8_LDB(B0, 1, 0); PG8_SCHED; PG8_LDA(At, 1, 0); PG8_STAGE(PG8_SA(0, 1), a2, vc[1]);
            PG8_WAIT_L(8); PG8_BAR; PG8_WAIT_L(0); PG8_MMA(0, 0, At, B0); PG8_BAR; PG8_SCHED;
            PG8_LDB(B1, 1, 1); PG8_STAGE(PG8_SB(1, 0), b3, voffB);
            PG8_BAR; PG8_WAIT_L(0); PG8_MMA(0, 1, At, B1); PG8_BAR;
            PG8_LDA(At, 1, 1); PG8_STAGE(PG8_SA(1, 0), a3, vc[0]);
            PG8_BAR; PG8_WAIT_L(0); PG8_MMA(1, 0, At, B0); PG8_BAR; PG8_SCHED;
            PG8_STAGE(PG8_SB(1, 1), b3 + hstepB, voffB);
            PG8_WAIT_V(6); PG8_BAR; PG8_MMA(1, 1, At, B1); PG8_BAR;
        }
        { int tz = threadIdx.x; asm volatile("" : "+v"(tz)); const int ln = tz & 63; E(acc, cur, wr, wc, ln & 15, ln >> 4); }
        if (!has_next) break;
#pragma unroll
        for (int a = 0; a < 2; ++a)
#pragma unroll
            for (int b = 0; b < 2; ++b)
#pragma unroll
                for (int m = 0; m < 4; ++m)
#pragma unroll
                    for (int n = 0; n < 2; ++n) acc[a][b][m][n] = (f32x4){0.f, 0.f, 0.f, 0.f};
        cur = nxt; cB = nB; ++ui;
    }
    PG8_WAIT_V(0);
    if (wr == 0) PG8_BAR;
    PG8_BAR;
#undef PG8_SA
#undef PG8_SB
#undef PG8_STAGE
#undef PG8_LDA
#undef PG8_LDB
#undef PG8_MMA
#undef PG8_WAIT_V
#undef PG8_WAIT_L
#undef PG8_BAR
#undef PG8_SCHED
}
}
constexpr int NWAVES = 8, NTHR = 512;
constexpr int LDS_RING = 131072;
constexpr int LDS_TBL = LDS_RING;
constexpr int LDS_VOFF = LDS_TBL + 12288;
constexpr int LDS_MISC = LDS_VOFF + 8192;
constexpr int LDS_BYTES = 152064;

struct Params {
    const float* x; const int* pos; const float* w_in; const float* q_norm; const float* w_uq; const float* kv_norm; const float* w_ukv; const float* w_out;
    const float* ln1_g; const float* ln1_b; const float* router_w; const float* router_b; const float* w1; const float* w3; const float* w2;
    const float* sw1; const float* sw3; const float* sw2; const float* ln2_g; const float* ln2_b; const float* rel_bias;
    float* out; unsigned char* ws;
    int ph_lo, ph_hi;
};

struct Frame {
    LAS unsigned char* lds; volatile LAS unsigned* MISC; unsigned* ctl;
    int tid, lane, wave, G, vcu;
    unsigned char* ws;
};
#define FP(name, type, off) __device__ __forceinline__ type* name(const Frame& F) { return (type*)(F.ws + (off)); }
FP(fWin, bf16_t, WS_W + W_IN) FP(fWuq, bf16_t, WS_W + W_UQ) FP(fWukv, bf16_t, WS_W + W_UKV) FP(fWout, bf16_t, WS_W + W_OUT) FP(fWr, bf16_t, WS_W + W_R) FP(fW13, bf16_t, WS_W + W_13) FP(fW2, bf16_t, WS_W + W_2)
FP(fXF, float, WS_XF) FP(fXB, bf16_t, WS_XB) FP(fH, bf16_t, WS_H) FP(fLST, unsigned, WS_LST) FP(fGATE, float, WS_GATE) FP(fROPE, float, WS_ROPE)
FP(fU, bf16_t, WS_R + R_U) FP(fMQ, bf16_t, WS_R + R_MQ) FP(fMK, bf16_t, WS_R + R_MK) FP(fMV, bf16_t, WS_R + R_MV) FP(fKR, bf16_t, WS_R + R_KR) FP(fAO, bf16_t, WS_R + R_AO)
FP(fMASK, unsigned, WS_R + R_MASK) FP(fSCR, float, WS_R + R_SCR) FP(fLG, float, WS_R + R_LG) FP(fYB, bf16_t, WS_R)
__device__ __forceinline__ Frame phase_frame(const Frame& F0) { Frame F = F0; int tz = threadIdx.x; asm volatile("" : "+v"(tz)); F.tid = tz; F.lane = tz & 63; return F; }

struct MapIn  { __device__ int row(int n) const { return n < 2504 ? n : n + 56; }   __device__ float sc(int k, int n) const { return (n < 384 || (n >= 1152 && n < 1408)) ? QSCALE : 1.0f; } };
struct MapUq  { const float* g; __device__ int row(int n) const { return n; }         __device__ float sc(int k, int n) const { return g[k] * MLA_QSCALE; } };
struct MapUkv { const float* g; __device__ int row(int n) const { const int h = n >> 7, c = n & 127; return c < 64 ? h * 64 + c : 384 + h * 64 + (c - 64); } __device__ float sc(int k, int n) const { return g[k]; } };
struct MapId  { __device__ int row(int n) const { return n; }                         __device__ float sc(int k, int n) const { return 1.0f; } };
struct MapW13 { int add; __device__ int row(int f) const { return 32 * (f >> 4) + (f & 15) + add; } __device__ float sc(int k, int n) const { return 1.0f; } };

template <class MAP>
__device__ __forceinline__ void tr_item(const float* W, int N, int kb, int nb, bf16_t* WT, int ldk, const MAP map, LAS float* scr, int lane) {
    const int k0 = 64 * kb, n0 = 32 * nb;
    const int nn = n0 + (lane & 31); const bool ok = nn < N;
#pragma unroll 8
    for (int i = 0; i < 32; ++i) { const int kk = 2 * i + (lane >> 5); scr[kk * 33 + (lane & 31)] = ok ? W[(size_t)(k0 + kk) * N + nn] * map.sc(k0 + kk, nn) : 0.f; }
    LDS_WAIT(); asm volatile("" ::: "memory");
    const int c = lane & 7;
#pragma unroll
    for (int j = 0; j < 4; ++j) { const int n = (lane >> 3) + 8 * j; const LAS float* s = scr + (8 * c) * 33 + n;
        u32x4 o; o.x = cvt_pk(s[0 * 33], s[1 * 33]); o.y = cvt_pk(s[2 * 33], s[3 * 33]); o.z = cvt_pk(s[4 * 33], s[5 * 33]); o.w = cvt_pk(s[6 * 33], s[7 * 33]);
        if (n0 + n < N) *(u32x4*)(WT + (size_t)map.row(n0 + n) * ldk + k0 + 8 * c) = o; }
    LDS_WAIT(); asm volatile("" ::: "memory");
}

__device__ __forceinline__ void zero_rows(bf16_t* base, int row0, int nrows, int ldk, int k0, int kn, int gt, int ngt) {
    const int per = kn / 8; const int total = nrows * per;
    for (int i = gt; i < total; i += ngt) { const int r = i / per, c = i % per; *(u32x4*)(base + (size_t)(row0 + r) * ldk + k0 + 8 * c) = (u32x4){0u, 0u, 0u, 0u}; }
}

__device__ __forceinline__ void convert_layer(const Frame& F, const Params& p, int l) {
    LAS float* scr = (LAS float*)(F.lds + F.wave * 16384);
    const int gw = F.vcu * NWAVES + F.wave, NGW = F.G * NWAVES;
    constexpr int I_IN = 16 * 92, I_UQ = 4 * 18, I_UKV = 2 * 24, I_OUT = 16 * 32, I_R = 16 * 2, I_E1 = 16 * 8, I_E2 = 4 * 32, I_EXP = 2 * I_E1 + I_E2;
    constexpr int NIT = I_IN + I_UQ + I_UKV + I_OUT + I_R + 65 * I_EXP;
    const float* w_in = p.w_in + (size_t)l * 1024 * IN_W;
    const float* w_uq = p.w_uq + (size_t)l * 256 * 576; const float* w_ukv = p.w_ukv + (size_t)l * 128 * 768;
    const float* w_out = p.w_out + (size_t)l * 1024 * 1024; const float* rw = p.router_w + (size_t)l * 1024 * 64;
    for (int it = gw; it < NIT; it += NGW) {
        int r = it;
        if (r < I_IN) { tr_item(w_in, IN_W, r / 92, r % 92, fWin(F), 1024, MapIn{}, scr, F.lane); continue; } r -= I_IN;
        if (r < I_UQ) { tr_item(w_uq, 576, r / 18, r % 18, fWuq(F), 256, MapUq{p.q_norm + l * 256}, scr, F.lane); continue; } r -= I_UQ;
        if (r < I_UKV) { tr_item(w_ukv, 768, r / 24, r % 24, fWukv(F), 256, MapUkv{p.kv_norm + l * 128}, scr, F.lane); continue; } r -= I_UKV;
        if (r < I_OUT) { tr_item(w_out, 1024, r / 32, r % 32, fWout(F), 1024, MapId{}, scr, F.lane); continue; } r -= I_OUT;
        if (r < I_R) { tr_item(rw, 64, r / 2, r % 2, fWr(F), 1024, MapId{}, scr, F.lane); continue; } r -= I_R;
        const int e = r / I_EXP; r -= e * I_EXP;
        const float *s1, *s3, *s2;
        if (e < 64) { s1 = p.w1 + ((size_t)l * 64 + e) * 1024 * 256; s3 = p.w3 + ((size_t)l * 64 + e) * 1024 * 256; s2 = p.w2 + ((size_t)l * 64 + e) * 256 * 1024; }
        else { s1 = p.sw1 + (size_t)l * 1024 * 256; s3 = p.sw3 + (size_t)l * 1024 * 256; s2 = p.sw2 + (size_t)l * 256 * 1024; }
        bf16_t* d13 = fW13(F) + (size_t)e * 512 * 1024; bf16_t* d2 = fW2(F) + (size_t)e * 1024 * 256;
        if (r < I_E1) { tr_item(s1, 256, r / 8, r % 8, d13, 1024, MapW13{0}, scr, F.lane); continue; } r -= I_E1;
        if (r < I_E1) { tr_item(s3, 256, r / 8, r % 8, d13, 1024, MapW13{16}, scr, F.lane); continue; } r -= I_E1;
        tr_item(s2, 1024, r / 32, r % 32, d2, 256, MapId{}, scr, F.lane);
    }
    const int gt = F.vcu * NTHR + F.tid, ngt = F.G * NTHR;
    zero_rows(fWin(F), 2504, 56, 1024, 0, 1024, gt, ngt); zero_rows(fWin(F), 2976, 96, 1024, 0, 1024, gt, ngt);
    zero_rows(fWuq(F), 576, 192, 256, 0, 256, gt, ngt);
    zero_rows(fWukv(F), 0, 768, 256, 128, 128, gt, ngt);
    zero_rows(fWr(F), 64, 192, 1024, 0, 1024, gt, ngt);
}

typedef f32x4 Acc[2][2][4][2];
#define EPI_ROWS(ai, m) for (int ai = 0; ai < 2; ++ai) for (int m = 0; m < 4; ++m)

struct EpiU {
    static constexpr bool PERM = true; bf16_t* U;
    __device__ __forceinline__ void operator()(const Acc& acc, const pg8::Unit& u, int wr, int wc, int fr, int fq) const {
#pragma unroll
        EPI_ROWS(ai, m) { bf16_t* rowp = U + (size_t)(u.pm * 256 + ai * 128 + wr * 64 + m * 16 + fr) * LDU + u.pn * 256 + wc * 32 + 8 * fq;
#pragma unroll
            for (int bj = 0; bj < 2; ++bj) { const f32x4 a = acc[ai][bj][m][0], b = acc[ai][bj][m][1];
                *(u32x4*)(rowp + bj * 128) = (u32x4){cvt_pk(a[0], a[1]), cvt_pk(a[2], a[3]), cvt_pk(b[0], b[1]), cvt_pk(b[2], b[3])}; } }
    }
};
struct EpiQup {
    static constexpr bool PERM = false; bf16_t* MQ; const LAS float* tbl; const float* rope;
    __device__ __forceinline__ void operator()(const Acc& acc, const pg8::Unit& u, int wr, int wc, int fr, int fq) const {
#pragma unroll
        EPI_ROWS(ai, m) { const int rl = ai * 128 + wr * 64 + m * 16 + fr, row = u.pm * 256 + rl; const float rs = tbl[u.seq * 256 + rl];
#pragma unroll
            for (int bj = 0; bj < 2; ++bj) { const int c0 = u.pn * 256 + bj * 128 + wc * 32; f32x4 a = acc[ai][bj][m][0] * rs, b = acc[ai][bj][m][1] * rs;
                if (((c0 >> 5) % 3) == 2) {
                    const f32x4 cs = *(const f32x4*)(rope + (size_t)row * 32 + 4 * fq), sn = *(const f32x4*)(rope + (size_t)row * 32 + 16 + 4 * fq);
                    const f32x4 x1 = a, x2 = b; a = x1 * cs - x2 * sn; b = x2 * cs + x1 * sn; }
                if (c0 < 576) { bf16_t* o = MQ + (size_t)row * 576 + c0 + 4 * fq; *(u32x2*)o = (u32x2){cvt_pk(a[0], a[1]), cvt_pk(a[2], a[3])}; *(u32x2*)(o + 16) = (u32x2){cvt_pk(b[0], b[1]), cvt_pk(b[2], b[3])}; } }
            asm volatile("" ::: "memory"); }
    }
};
struct EpiKVup {
    static constexpr bool PERM = true; bf16_t* MK; bf16_t* MV; const LAS float* tbl;
    __device__ __forceinline__ void operator()(const Acc& acc, const pg8::Unit& u, int wr, int wc, int fr, int fq) const {
#pragma unroll
        EPI_ROWS(ai, m) { const int rl = ai * 128 + wr * 64 + m * 16 + fr, row = u.pm * 256 + rl; const float rs = tbl[u.seq * 256 + rl];
#pragma unroll
            for (int bj = 0; bj < 2; ++bj) { const int c = u.pn * 256 + bj * 128 + wc * 32 + 8 * fq; const f32x4 a = acc[ai][bj][m][0] * rs, b = acc[ai][bj][m][1] * rs;
                bf16_t* o = c < 384 ? MK + (size_t)row * 384 + c : MV + (size_t)row * 384 + (c - 384);
                *(u32x4*)o = (u32x4){cvt_pk(a[0], a[1]), cvt_pk(a[2], a[3]), cvt_pk(b[0], b[1]), cvt_pk(b[2], b[3])}; } }
    }
};
struct EpiRes {
    static constexpr bool PERM = false; const float* res; float* out; int row_off;
    __device__ __forceinline__ void operator()(const Acc& acc, const pg8::Unit& u, int wr, int wc, int fr, int fq) const {
#pragma unroll
        EPI_ROWS(ai, m) { const size_t off = (size_t)(u.pm * 256 + ai * 128 + wr * 64 + m * 16 + fr) * 1024 + u.pn * 256 + wc * 32 + 4 * fq;
#pragma unroll
            for (int bj = 0; bj < 2; ++bj)
#pragma unroll
                for (int n = 0; n < 2; ++n) { const f32x4 r = *(const f32x4*)(res + off + bj * 128 + n * 16); *(f32x4*)(out + off + bj * 128 + n * 16) = r * DN_ALPHA + acc[ai][bj][m][n]; } }
    }
};
struct EpiLogit {
    static constexpr bool PERM = false; float* LG;
    __device__ __forceinline__ void operator()(const Acc& acc, const pg8::Unit& u, int wr, int wc, int fr, int fq) const {
        if (wc >= 2) return;
#pragma unroll
        EPI_ROWS(ai, m) { float* o = LG + ((size_t)u.pn * T + (u.pm * 256 + ai * 128 + wr * 64 + m * 16 + fr)) * 64 + wc * 32 + 4 * fq;
            *(f32x4*)o = acc[ai][0][m][0]; *(f32x4*)(o + 16) = acc[ai][0][m][1]; }
    }
};
__device__ __forceinline__ float silu_f(float v) { return v / (1.0f + __expf(-v)); }
struct EpiG1 {
    static constexpr bool PERM = false; bf16_t* H; const unsigned* LST; const LAS int* cnt; int shared_base;
    __device__ __forceinline__ void operator()(const Acc& acc, const pg8::Unit& u, int wr, int wc, int fr, int fq) const {
#pragma unroll
        EPI_ROWS(ai, m) { const int idx = u.pm * 256 + ai * 128 + wr * 64 + m * 16 + fr; size_t hrow;
            if (LST) { if (idx >= cnt[u.e]) continue; hrow = LST[(size_t)u.e * T + idx]; } else hrow = (size_t)shared_base + idx;
            bf16_t* o = H + hrow * 256 + u.pn * 128 + wc * 16 + 4 * fq;
#pragma unroll
            for (int bj = 0; bj < 2; ++bj) { const f32x4 a = acc[ai][bj][m][0], b = acc[ai][bj][m][1];
                *(u32x2*)(o + bj * 64) = (u32x2){cvt_pk(silu_f(a[0]) * b[0], silu_f(a[1]) * b[1]), cvt_pk(silu_f(a[2]) * b[2], silu_f(a[3]) * b[3])}; }
            asm volatile("" ::: "memory"); }
    }
};
struct EpiG2 {
    static constexpr bool PERM = true; bf16_t* YB; const unsigned* LST; const LAS int* cnt; const float* GATE;
    __device__ __forceinline__ void operator()(const Acc& acc, const pg8::Unit& u, int wr, int wc, int fr, int fq) const {
#pragma unroll
        EPI_ROWS(ai, m) { const int idx = u.pm * 256 + ai * 128 + wr * 64 + m * 16 + fr; if (idx >= cnt[u.e]) continue;
            const unsigned aid = LST[(size_t)u.e * T + idx]; const float g = GATE[aid];
            bf16_t* o = YB + (size_t)aid * 1024 + u.pn * 256 + wc * 32 + 8 * fq;
#pragma unroll
            for (int bj = 0; bj < 2; ++bj) { const f32x4 a = acc[ai][bj][m][0] * g, b = acc[ai][bj][m][1] * g;
                *(u32x4*)(o + bj * 128) = (u32x4){cvt_pk(a[0], a[1]), cvt_pk(a[2], a[3]), cvt_pk(b[0], b[1]), cvt_pk(b[2], b[3])}; }
            asm volatile("" ::: "memory"); }
    }
};

struct MoeOrder {
    const LAS int* cnt; const LAS int* ubase;
    int npn, total, G, c; const unsigned* LST; int shift  ; unsigned lda; const char* Bt; size_t bexp  ; unsigned ldb;
    __device__ __forceinline__ bool next(int i, pg8::Unit& u) const {
        const long L = (long)i * G + c; if (L >= total) return false;
        const int w = pg8::xcd_remap((int)L, total);
        int lo = 0, hi = 64;
        while (hi - lo > 1) { const int mid = (lo + hi) >> 1; if (ubase[mid] <= w) lo = mid; else hi = mid; }
        const int loc = w - ubase[lo]; u.e = lo; u.pn = loc % npn; u.pm = loc / npn; u.seq = i; return true;
    }
    __device__ __forceinline__ void a_voff(const pg8::Unit& u, int tid, unsigned (&v)[2][2]) const {
        const int n = cnt[u.e];
#pragma unroll
        for (int i = 0; i < 2; ++i) { int R, C; pg8::stage_rc(tid * 16 + i * 8192, R, C);
#pragma unroll
            for (int h = 0; h < 2; ++h) { int idx = u.pm * 256 + h * 128 + R; idx = idx < n ? idx : 0; const unsigned ent = LST[(size_t)u.e * T + idx];
                v[h][i] = ((ent >> shift) * lda + (unsigned)C) * 2u; } }
    }
    __device__ __forceinline__ const char* b_base(const pg8::Unit& u) const { return Bt + (size_t)u.e * bexp + (size_t)u.pn * 256 * ldb * 2; }
};
struct RouterOrder {
    int G, c; const char* Bt;
    __device__ __forceinline__ bool next(int i, pg8::Unit& u) const { const long L = (long)i * G + c; if (L >= 256) return false; u.pm = (int)L >> 1; u.pn = (int)L & 1; u.e = 0; u.seq = i; return true; }
    __device__ __forceinline__ void a_voff(const pg8::Unit& u, int tid, unsigned (&v)[2][2]) const {
#pragma unroll
        for (int i = 0; i < 2; ++i) { int R, C; pg8::stage_rc(tid * 16 + i * 8192, R, C);
#pragma unroll
            for (int h = 0; h < 2; ++h) v[h][i] = ((unsigned)(u.pm * 256 + h * 128 + R) * 1024u + (unsigned)(u.pn * 512 + C)) * 2u; }
    }
    __device__ __forceinline__ const char* b_base(const pg8::Unit& u) const { return Bt + (size_t)u.pn * 512 * 2; }
};

__device__ __forceinline__ void phase_x_to_xb(const Frame& F, const float* x) {
    const size_t n8 = (size_t)T * 1024 / 8;
    for (size_t i = (size_t)F.vcu * NTHR + F.tid; i < n8; i += (size_t)F.G * NTHR) {
        const f32x4 a = *(const f32x4*)(x + i * 8), b = *(const f32x4*)(x + i * 8 + 4);
        *(u32x4*)(fXB(F) + i * 8) = (u32x4){cvt_pk(a[0], a[1]), cvt_pk(a[2], a[3]), cvt_pk(b[0], b[1]), cvt_pk(b[2], b[3])};
    }
}

__device__ __forceinline__ void phase_rope_table(const Frame& F, const int* pos) {
    for (int i = F.vcu * NTHR + F.tid; i < T * 16; i += F.G * NTHR) { const int t = i >> 4, j = i & 15;
        const double inv = exp2(-(double)j * (13.287712379549449 / 16.0));
        const double rev = (double)pos[t] * inv * 0.15915494309189535; const float fr = (float)(rev - floor(rev));
        fROPE(F)[(size_t)t * 32 + j] = __builtin_amdgcn_cosf(fr); fROPE(F)[(size_t)t * 32 + 16 + j] = __builtin_amdgcn_sinf(fr); }
}

__device__ __forceinline__ void phase_inproj(const Frame& F) {
    pg8::DenseOrder S; S.init(T, LDU, F.G, (int)blockIdx.x, 1024, 0, fWin(F), 1024);
    EpiU E{fU(F)};
    pg8::gemm_phase<EpiU, pg8::DenseOrder>(F.lds, F.lds + LDS_VOFF, (const char*)fXB(F), 1024, 1024, S, E);
}

__device__ __forceinline__ void rms_tables(const Frame& F, const pg8::DenseOrder& S, LAS float* tbl, int col0, int width) {
    pg8::Unit u;
    for (int i = 0; S.next(i, u) && i < 4; ++i) {
        if (u.pn != 0 && i > 0) {   }
        if (F.tid < 256) { const bf16_t* xr = fU(F) + (size_t)(u.pm * 256 + F.tid) * LDU + col0; float ss = 0.f;
            for (int c = 0; c < width; c += 8) { const u32x4 v = *(const u32x4*)(xr + c);
#pragma unroll
                for (int j = 0; j < 4; ++j) { const float lo = bf2f(v[j] & 0xffffu), hi = bf2f(v[j] >> 16); ss += lo * lo + hi * hi; } }
            tbl[i * 256 + F.tid] = 1.0f / sqrtf(ss / (float)width + RMS_EPS); }
    }
}

__device__ __forceinline__ void phase_mla_up(const Frame& F, const Params& p) {
    LAS float* tq = (LAS float*)(F.lds + LDS_TBL); LAS float* tkv = tq + 1024;
    pg8::DenseOrder Sq; Sq.init(T, 768, F.G, (int)blockIdx.x, LDU, U_CQ, fWuq(F), 256);
    pg8::DenseOrder Sk; Sk.init(T, 768, F.G, (int)blockIdx.x, LDU, U_CKV, fWukv(F), 256);
    rms_tables(F, Sq, tq, U_CQ, 256); rms_tables(F, Sk, tkv, U_CKV, 128);
    __syncthreads();
    { EpiQup E{fMQ(F), tq, fROPE(F)}; pg8::gemm_phase<EpiQup, pg8::DenseOrder>(F.lds, F.lds + LDS_VOFF, (const char*)fU(F), 256, 256, Sq, E); }
    { EpiKVup E{fMK(F), fMV(F), tkv}; pg8::gemm_phase<EpiKVup, pg8::DenseOrder>(F.lds, F.lds + LDS_VOFF, (const char*)fU(F), 256, 256, Sk, E); }
    for (int i = F.vcu * NTHR + F.tid; i < T * 16; i += F.G * NTHR) { const int t = i >> 4, j = i & 15;
        const float x1 = bf2f(fU(F)[(size_t)t * LDU + U_KR + j]), x2 = bf2f(fU(F)[(size_t)t * LDU + U_KR + 16 + j]);
        const float cs = fROPE(F)[(size_t)t * 32 + j], sn = fROPE(F)[(size_t)t * 32 + 16 + j];
        fKR(F)[(size_t)t * 32 + j] = (bf16_t)f2bf(x1 * cs - x2 * sn); fKR(F)[(size_t)t * 32 + 16 + j] = (bf16_t)f2bf(x2 * cs + x1 * sn); }
}

__device__ __forceinline__ void phase_outproj(const Frame& F, const float* res) {
    pg8::DenseOrder S; S.init(T, 1024, F.G, (int)blockIdx.x, 1024, 0, fWout(F), 1024);
    EpiRes E{res, fXF(F), 0};
    pg8::gemm_phase<EpiRes, pg8::DenseOrder>(F.lds, F.lds + LDS_VOFF, (const char*)fAO(F), 1024, 1024, S, E);
}

__device__ __forceinline__ void phase_router_sharedg1(const Frame& F) {
    { RouterOrder S{F.G, (int)blockIdx.x, (const char*)fWr(F)}; EpiLogit E{fLG(F)}; pg8::gemm_phase<EpiLogit, RouterOrder>(F.lds, F.lds + LDS_VOFF, (const char*)fXB(F), 512, 1024, S, E); }
    { pg8::DenseOrder S; S.init(T, 512, F.G, (int)blockIdx.x, 1024, 0, fW13(F) + (size_t)64 * 512 * 1024, 1024);
      EpiG1 E{fH(F), nullptr, nullptr, T * 8}; pg8::gemm_phase<EpiG1, pg8::DenseOrder>(F.lds, F.lds + LDS_VOFF, (const char*)fXB(F), 1024, 1024, S, E); }
}

__device__ __forceinline__ void phase_shared_g2(const Frame& F) {
    pg8::DenseOrder S; S.init(T, 1024, F.G, (int)blockIdx.x, 256, 0, fW2(F) + (size_t)64 * 1024 * 256, 256);
    EpiRes E{fXF(F), fXF(F), 0};
    pg8::gemm_phase<EpiRes, pg8::DenseOrder>(F.lds, F.lds + LDS_VOFF, (const char*)(fH(F) + (size_t)T * 8 * 256), 256, 256, S, E);
}

__device__ __forceinline__ void moe_tables(const Frame& F, int l, int npn, LAS int*& cnt, LAS int*& ubase) {
    cnt = (LAS int*)(F.lds + LDS_TBL + 8192); ubase = cnt + 64;
    __syncthreads();
    if (F.tid < 64) cnt[F.tid] = (int)F.ctl[CW_CNT + l * 64 + F.tid];
    __syncthreads();
    if (F.tid == 0) { int s = 0; for (int e = 0; e < 64; ++e) { ubase[e] = s; s += ((cnt[e] + 255) >> 8) * npn; } ubase[64] = s; }
    __syncthreads();
}
__device__ __forceinline__ void phase_moe_g1(const Frame& F, int l) {
    LAS int *cnt, *ubase; moe_tables(F, l, 2, cnt, ubase);
    MoeOrder S{cnt, ubase, 2, ubase[64], F.G, (int)blockIdx.x, fLST(F), 3, 1024u, (const char*)fW13(F), (size_t)512 * 1024 * 2, 1024u};
    EpiG1 E{fH(F), fLST(F), cnt, 0};
    pg8::gemm_phase<EpiG1, MoeOrder>(F.lds, F.lds + LDS_VOFF, (const char*)fXB(F), 1024, 1024, S, E);
}
__device__ __forceinline__ void phase_moe_g2(const Frame& F, int l) {
    LAS int *cnt, *ubase; moe_tables(F, l, 4, cnt, ubase);
    MoeOrder S{cnt, ubase, 4, ubase[64], F.G, (int)blockIdx.x, fLST(F), 0, 256u, (const char*)fW2(F), (size_t)1024 * 256 * 2, 256u};
    EpiG2 E{fYB(F), fLST(F), cnt, fGATE(F)};
    pg8::gemm_phase<EpiG2, MoeOrder>(F.lds, F.lds + LDS_VOFF, (const char*)fH(F), 256, 256, S, E);
}
constexpr int AT_K0 = 0, AT_KSZ = 12288, AT_V0 = 2 * AT_KSZ, AT_VSZ = 8192, AT_TBL = AT_V0 + 2 * AT_VSZ;

__device__ __forceinline__ float t5_dist_bias(const float* rel_bias, int head10, int d) {
    int bk;
    if (d < 16) bk = d;
    else { const float v = logf((float)d / 16.0f) / 4.852030263919617f * 16.0f; bk = 16 + (int)v; bk = bk < 31 ? bk : 31; }
    return rel_bias[bk * 10 + head10];
}

template <int MODE, int KS>
__device__ __forceinline__ void attn_unit(const Frame& F, const int b, const int qb,
                                          const bf16_t* __restrict__ Qp, const int ldq, const bf16_t* __restrict__ Kp, const int ldk, const bf16_t* __restrict__ KRp,
                                          const bf16_t* __restrict__ Vp, const int ldv, bf16_t* __restrict__ Op, const unsigned* __restrict__ maskp, const float* rel_bias, const int head10) {
    LAS unsigned char* lds = F.lds;
    const int tid = F.tid, lane = F.lane, w = F.wave, q32 = lane & 31, hh = lane >> 5;
    const size_t tb = (size_t)b * SEQ;
    const int qw0 = qb * 256 + 32 * w, qpos = qw0 + q32;
    const int ntile = 4 * (qb + 1);
    __syncthreads();
    if (MODE == 2) {
        LAS float* tblw = (LAS float*)(lds + AT_TBL);
        for (int d = tid; d < SEQ; d += NTHR) { const int mlt = (d <= 128 ? 1 : 0) + (((d & 3) == 0 && d <= 512) ? 1 : 0) + (((d & 15) == 0) ? 1 : 0);
            tblw[d] = mlt ? (t5_dist_bias(rel_bias, head10, d) + logf((float)mlt)) * LOG2E : -INFINITY; }
    }
    if (MODE == 1) {
        LAS float* tblw = (LAS float*)(lds + AT_TBL);
        for (int d = tid; d < SEQ; d += NTHR) tblw[d] = t5_dist_bias(rel_bias, head10, d) * LOG2E;
    }
    bf16x8 qf[KS];
    { const bf16_t* qr = Qp + (tb + qpos) * (size_t)ldq + 8 * hh;
#pragma unroll
      for (int ks = 0; ks < KS; ++ks) { if (MODE == 0 && ks >= 4) qf[ks] = *(const bf16x8*)(qr + 16 * ks); else qf[ks] = *(const bf16x8*)(qr + 16 * ks); } }
    const int skey = tid >> 3, sch = tid & 7;
    const bf16_t* kg = Kp + (tb + skey) * (size_t)ldk + 8 * sch;
    const bf16_t* vg = Vp + (tb + skey) * (size_t)ldv + 8 * sch;
    const bf16_t* rg = (MODE == 0) ? KRp + (tb + (tid >> 2)) * 32 + 8 * (tid & 3) : nullptr;
    const int kdst = sch * 1024 + ((skey ^ sch) << 4);
    const int rdst = (8 + (tid & 3)) * 1024 + ((((tid >> 2) & 63) ^ (tid & 3)) << 4);
    const int vdst = (sch >> 2) * 4096 + skey * 64 + (sch & 3) * 16;
    const unsigned* mg = (MODE == 1) ? maskp + (tb + qpos) * 64 : nullptr;
    u32x4 kreg, vreg, rreg; u32x2 mw = {0u, 0u}, mwn = {0u, 0u};
    kreg = *(const u32x4*)kg; vreg = *(const u32x4*)vg; if (MODE == 0 && tid < 256) rreg = *(const u32x4*)rg;
    if (MODE == 1) mw = *(const u32x2*)mg;
    *(LAS u32x4*)(lds + AT_K0 + kdst) = kreg; *(LAS u32x4*)(lds + AT_V0 + vdst) = vreg; if (MODE == 0 && tid < 256) *(LAS u32x4*)(lds + AT_K0 + rdst) = rreg;
    __syncthreads();
    f32x16 o0, o1;
#pragma unroll
    for (int r = 0; r < 16; ++r) { o0[r] = 0.f; o1[r] = 0.f; }
    float mrun = -INFINITY, lsum = 0.f;
    const LAS float* tbl = (const LAS float*)(lds + AT_TBL);
    for (int t = 0; t < ntile; ++t) {
        const int buf = t & 1;
        if (t + 1 < ntile) { kreg = *(const u32x4*)(kg + (size_t)(t + 1) * 64 * ldk); vreg = *(const u32x4*)(vg + (size_t)(t + 1) * 64 * ldv);
            if (MODE == 0 && tid < 256) rreg = *(const u32x4*)(rg + (size_t)(t + 1) * 64 * 32);
            if (MODE == 1) mwn = *(const u32x2*)(mg + 2 * (t + 1)); }
        const int k0 = 64 * t;
        if (k0 <= qw0 + 31) {
            const LAS unsigned char* kb = lds + AT_K0 + buf * AT_KSZ; const LAS unsigned char* vb = lds + AT_V0 + buf * AT_VSZ;
            f32x16 s0, s1;
#pragma unroll
            for (int r = 0; r < 16; ++r) { s0[r] = 0.f; s1[r] = 0.f; }
#pragma unroll
            for (int ks = 0; ks < KS; ++ks) { const int c = 2 * ks + hh;
                const bf16x8 a0 = *(const LAS bf16x8*)(kb + c * 1024 + ((q32 ^ (c & 7)) << 4));
                const bf16x8 a1 = *(const LAS bf16x8*)(kb + c * 1024 + (((32 + q32) ^ (c & 7)) << 4));
                s0 = __builtin_amdgcn_mfma_f32_32x32x16_bf16(a0, qf[ks], s0, 0, 0, 0);
                s1 = __builtin_amdgcn_mfma_f32_32x32x16_bf16(a1, qf[ks], s1, 0, 0, 0); }
            if (MODE == 0) { if (k0 + 63 > qw0) {
#pragma unroll
                for (int r = 0; r < 16; ++r) { const int key = k0 + (r & 3) + 8 * (r >> 2) + 4 * hh; if (key > qpos) s0[r] = -INFINITY; if (key + 32 > qpos) s1[r] = -INFINITY; } } }
            if (MODE == 1) { const unsigned w0 = mw[0] >> (4 * hh), w1 = mw[1] >> (4 * hh); const int dbase = qpos - k0 - 4 * hh;
#pragma unroll
                for (int r = 0; r < 16; ++r) { const int bit = (r & 3) + 8 * (r >> 2); const int d0 = dbase - bit, d1 = d0 - 32;
                    s0[r] = ((w0 >> bit) & 1u) ? s0[r] + tbl[d0 > 0 ? d0 : 0] : -INFINITY; s1[r] = ((w1 >> bit) & 1u) ? s1[r] + tbl[d1 > 0 ? d1 : 0] : -INFINITY; } }
            if (MODE == 2) { const int dbase = qpos - k0 - 4 * hh;
#pragma unroll
                for (int r = 0; r < 16; ++r) { const int d0 = dbase - ((r & 3) + 8 * (r >> 2)), d1 = d0 - 32;
                    s0[r] = d0 >= 0 ? s0[r] + tbl[d0] : -INFINITY; s1[r] = d1 >= 0 ? s1[r] + tbl[d1] : -INFINITY; } }
            float mx = s0[0];
#pragma unroll
            for (int r = 1; r < 16; ++r) mx = fmaxf(mx, s0[r]);
#pragma unroll
            for (int r = 0; r < 16; ++r) mx = fmaxf(mx, s1[r]);
            mx = fmaxf(mx, __shfl_xor(mx, 32));
            const float mnew = fmaxf(mrun, mx), muse = (mnew == -INFINITY) ? 0.f : mnew;
            const float alpha = exp2f(mrun - muse);
            mrun = mnew;
            float ps = 0.f;
#pragma unroll
            for (int r = 0; r < 16; ++r) { s0[r] = exp2f(s0[r] - muse); s1[r] = exp2f(s1[r] - muse); ps += s0[r] + s1[r]; }
            lsum = lsum * alpha + ps;
#pragma unroll
            for (int r = 0; r < 16; ++r) { o0[r] *= alpha; o1[r] *= alpha; }
            bf16x8 pb[4];
#pragma unroll
            for (int s2 = 0; s2 < 2; ++s2) {
                u32x4 a = {cvt_pk(s0[8 * s2 + 0], s0[8 * s2 + 1]), cvt_pk(s0[8 * s2 + 2], s0[8 * s2 + 3]), cvt_pk(s0[8 * s2 + 4], s0[8 * s2 + 5]), cvt_pk(s0[8 * s2 + 6], s0[8 * s2 + 7])};
                u32x4 c = {cvt_pk(s1[8 * s2 + 0], s1[8 * s2 + 1]), cvt_pk(s1[8 * s2 + 2], s1[8 * s2 + 3]), cvt_pk(s1[8 * s2 + 4], s1[8 * s2 + 5]), cvt_pk(s1[8 * s2 + 6], s1[8 * s2 + 7])};
                pb[s2] = __builtin_bit_cast(bf16x8, a); pb[2 + s2] = __builtin_bit_cast(bf16x8, c); }
            const int vlane = (4 * hh + ((lane & 15) >> 2)) * 64 + (((lane >> 4) & 1) * 16 + 4 * (lane & 3)) * 2;
#pragma unroll
            for (int dt = 0; dt < 2; ++dt) {
#pragma unroll
                for (int kk = 0; kk < 4; ++kk) {
                    const LAS unsigned char* va = vb + dt * 4096 + kk * 16 * 64 + vlane;
                    const s16x4 lo = __builtin_bit_cast(s16x4, __builtin_amdgcn_ds_read_tr16_b64_v4i16((LAS s16x4*)(va)));
                    const s16x4 hi = __builtin_bit_cast(s16x4, __builtin_amdgcn_ds_read_tr16_b64_v4i16((LAS s16x4*)(va + 8 * 64)));
                    const bf16x8 vf = {lo[0], lo[1], lo[2], lo[3], hi[0], hi[1], hi[2], hi[3]};
                    if (dt == 0) o0 = __builtin_amdgcn_mfma_f32_32x32x16_bf16(vf, pb[kk], o0, 0, 0, 0);
                    else o1 = __builtin_amdgcn_mfma_f32_32x32x16_bf16(vf, pb[kk], o1, 0, 0, 0); } }
        }
        if (t + 1 < ntile) { const int nb = (t + 1) & 1;
            *(LAS u32x4*)(lds + AT_K0 + nb * AT_KSZ + kdst) = kreg; *(LAS u32x4*)(lds + AT_V0 + nb * AT_VSZ + vdst) = vreg;
            if (MODE == 0 && tid < 256) *(LAS u32x4*)(lds + AT_K0 + nb * AT_KSZ + rdst) = rreg;
            if (MODE == 1) mw = mwn; }
        __syncthreads();
    }
    const float ltot = lsum + __shfl_xor(lsum, 32);
    const float inv = ltot > 0.f ? 1.0f / ltot : 0.f;
    bf16_t* orow = Op + (tb + qpos) * 1024 + 4 * hh;
#pragma unroll
    for (int g = 0; g < 4; ++g) {
        *(u32x2*)(orow + 8 * g) = (u32x2){cvt_pk(o0[4 * g] * inv, o0[4 * g + 1] * inv), cvt_pk(o0[4 * g + 2] * inv, o0[4 * g + 3] * inv)};
        *(u32x2*)(orow + 32 + 8 * g) = (u32x2){cvt_pk(o1[4 * g] * inv, o1[4 * g + 1] * inv), cvt_pk(o1[4 * g + 2] * inv, o1[4 * g + 3] * inv)}; }
}

__device__ __forceinline__ void phase_attention(const Frame& F, const Params& p) {
    for (int L = (int)blockIdx.x; L < 2048; L += F.G) {
        const int level = L >> 8, idx = ((L & 255) + 37 * level) & 255, qb = 7 - level;
        if (idx < 96) { const int b = idx / 6, h = idx % 6;
            attn_unit<0, 6>(F, b, qb, fMQ(F) + h * 96, 576, fMK(F) + h * 64, 384, fKR(F), fMV(F) + h * 64, 384, fAO(F) + 640 + h * 64, nullptr, nullptr, 0);
        } else if (idx < 160) { const int j = idx - 96, b = j >> 2, h = j & 3;
            attn_unit<1, 4>(F, b, qb, fU(F) + U_SQ + h * 64, LDU, fU(F) + U_SK + h * 64, LDU, nullptr, fU(F) + U_SV + h * 64, LDU, fAO(F) + 384 + h * 64, fMASK(F), p.rel_bias, 6 + h);
        } else { const int j = idx - 160, b = j / 6, h = j % 6;
            attn_unit<2, 4>(F, b, qb, fU(F) + U_DQ + h * 64, LDU, fU(F) + U_DK + h * 64, LDU, nullptr, fU(F) + U_DV + h * 64, LDU, fAO(F) + h * 64, nullptr, p.rel_bias, h);
        }
    }
}
__device__ __forceinline__ void indexer_block(const Frame& F, const int b, const int qk) {
    LAS unsigned char* lds = F.lds;
    const int tid = F.tid, lane = F.lane, w = F.wave, q32 = lane & 31, hh = lane >> 5;
    const size_t tb = (size_t)b * SEQ; const int q0 = 32 * qk, ntile = qk + 1;
    float* scr = fSCR(F) + (size_t)blockIdx.x * (32 * 2048);
    __syncthreads();
#pragma unroll
    for (int i = 0; i < 4; ++i) { const int idx = tid + 512 * i, q = idx >> 6, c = idx & 63;
        *(LAS u32x4*)(lds + c * 512 + q * 16) = *(const u32x4*)(fU(F) + (tb + q0 + q) * LDU + U_IQ + 8 * c); }
    if (tid < 256) { const int q = tid >> 3, h8 = tid & 7; ((LAS float*)(lds + 32768))[h8 * 32 + q] = bf2f(fU(F)[(tb + q0 + q) * LDU + U_IW + h8]); }
    __syncthreads();
    const int qpos = q0 + q32;
#pragma unroll 1
    for (int ti = w; ti < ntile; ti += NWAVES) {
        const int key0 = 32 * ti;
        bf16x8 kf[4];
        { const bf16_t* kr = fU(F) + (tb + key0 + q32) * LDU + U_IK + 8 * hh;
#pragma unroll
          for (int ks = 0; ks < 4; ++ks) kf[ks] = *(const bf16x8*)(kr + 16 * ks); }
        f32x16 sc;
#pragma unroll
        for (int r = 0; r < 16; ++r) sc[r] = 0.f;
#pragma unroll 1
        for (int h8 = 0; h8 < 8; ++h8) {
            const float iwq = ((const LAS float*)(lds + 32768))[h8 * 32 + q32];
            f32x16 a;
#pragma unroll
            for (int r = 0; r < 16; ++r) a[r] = 0.f;
#pragma unroll
            for (int ks = 0; ks < 4; ++ks) { const bf16x8 qv = *(const LAS bf16x8*)(lds + (8 * h8 + 2 * ks + hh) * 512 + q32 * 16);
                a = __builtin_amdgcn_mfma_f32_32x32x16_bf16(kf[ks], qv, a, 0, 0, 0); }
#pragma unroll
            for (int r = 0; r < 16; ++r) sc[r] += iwq * fmaxf(a[r], 0.f);
        }
        if (ti == qk) {
#pragma unroll
            for (int r = 0; r < 16; ++r) { const int key = key0 + (r & 3) + 8 * (r >> 2) + 4 * hh; if (key > qpos) sc[r] = -INFINITY; } }
        float* o = scr + (size_t)q32 * 2048 + key0 + 4 * hh;
#pragma unroll
        for (int g = 0; g < 4; ++g) *(f32x4*)(o + 8 * g) = (f32x4){sc[4 * g], sc[4 * g + 1], sc[4 * g + 2], sc[4 * g + 3]};
    }
    VM_WAIT(); __syncthreads();
#pragma unroll 1
    for (int rr = 0; rr < 4; ++rr) {
        const int ql = w + 8 * rr, q = q0 + ql, n = q + 1;
        unsigned long long myw = 0ull;
        if (n <= 256) {
            if (lane < 32) { const int lo = 64 * lane; myw = (lo + 63 <= q) ? ~0ull : (lo <= q ? ((1ull << (q - lo + 1)) - 1ull) : 0ull); }
        } else {
            float x[32];
            const float* srow = scr + (size_t)ql * 2048 + lane;
#pragma unroll
            for (int j = 0; j < 32; ++j) { x[j] = -INFINITY; if (64 * j < n) { const float v = __builtin_nontemporal_load(srow + 64 * j); x[j] = (64 * j + lane <= q) ? v : -INFINITY; } }
            float mx = -INFINITY, mn = INFINITY;
#pragma unroll
            for (int j = 0; j < 32; ++j) { mx = fmaxf(mx, x[j]); mn = fminf(mn, x[j] == -INFINITY ? INFINITY : x[j]); }
#pragma unroll
            for (int o = 1; o < 64; o <<= 1) { mx = fmaxf(mx, __shfl_xor(mx, o)); mn = fminf(mn, __shfl_xor(mn, o)); }
            float lo = mn, hi = mx, thr = 0.f; bool exact = false;
            int c_hi = 0;
#pragma unroll
            for (int j = 0; j < 32; ++j) c_hi += __builtin_popcountll(__ballot(x[j] >= hi));
            if (c_hi < 256) {
#pragma unroll 1
                for (int it = 0; it < 200; ++it) {
                    const float mid = 0.5f * lo + 0.5f * hi;
                    if (!(mid > lo && mid < hi)) break;
                    int c = 0;
#pragma unroll
                    for (int j = 0; j < 32; ++j) c += __builtin_popcountll(__ballot(x[j] >= mid));
                    if (c == 256) { thr = mid; exact = true; break; }
                    if (c > 256) lo = mid; else { hi = mid; c_hi = c; }
                }
            } else { lo = hi; hi = INFINITY; c_hi = 0; }
            int need = 256 - c_hi;
#pragma unroll
            for (int j = 0; j < 32; ++j) {
                unsigned long long sel;
                if (exact) sel = __ballot(x[j] >= thr);
                else { const unsigned long long eq = __ballot(x[j] == lo); const int rank = __builtin_popcountll(eq & ((1ull << lane) - 1ull));
                    sel = __ballot(x[j] >= hi) | __ballot(x[j] == lo && rank < need); const int ne = __builtin_popcountll(eq); need = need > ne ? need - ne : 0; }
                if (lane == j) myw = sel;
            }
        }
        if (lane < 32) *(unsigned long long*)(fMASK(F) + (tb + q) * 64 + 2 * lane) = myw;
    }
}
__device__ __forceinline__ void phase_indexer(const Frame& F) {
    for (int L = (int)blockIdx.x; L < 512; L += F.G) { const int b = L >> 5, j = L & 31;
#pragma unroll 1
        for (int s = 0; s < 2; ++s) indexer_block(F, b, s ? j : 63 - j); }
}

__device__ __forceinline__ void ln_finish(const Frame& F, f32x4 (&v)[4], const float* g, const float* bta, float* of, bf16_t* ob) {
    float s = 0.f;
#pragma unroll
    for (int j = 0; j < 4; ++j) s += (v[j][0] + v[j][1]) + (v[j][2] + v[j][3]);
    const float mean = wave_sum(s) * (1.f / 1024.f); float s2 = 0.f;
#pragma unroll
    for (int j = 0; j < 4; ++j) { v[j] = v[j] - mean; s2 += (v[j][0] * v[j][0] + v[j][1] * v[j][1]) + (v[j][2] * v[j][2] + v[j][3] * v[j][3]); }
    const float rstd = 1.f / sqrtf(wave_sum(s2) * (1.f / 1024.f) + LN_EPS);
#pragma unroll
    for (int j = 0; j < 4; ++j) { const f32x4 gg = *(const f32x4*)(g + 4 * F.lane + 256 * j), bb = *(const f32x4*)(bta + 4 * F.lane + 256 * j);
        const f32x4 o = v[j] * rstd * gg + bb;
        *(f32x4*)(of + 4 * F.lane + 256 * j) = o;
        if (ob) *(u32x2*)(ob + 4 * F.lane + 256 * j) = (u32x2){cvt_pk(o[0], o[1]), cvt_pk(o[2], o[3])}; }
}
__device__ __forceinline__ void phase_ln1(const Frame& F, const Params& p, int l) {
    const int gw = F.vcu * NWAVES + F.wave, NGW = F.G * NWAVES;
    for (int m = gw; m < T; m += NGW) { float* row = fXF(F) + (size_t)m * 1024; f32x4 v[4];
#pragma unroll
        for (int j = 0; j < 4; ++j) v[j] = *(const f32x4*)(row + 4 * F.lane + 256 * j);
        ln_finish(F, v, p.ln1_g + l * 1024, p.ln1_b + l * 1024, row, fXB(F) + (size_t)m * 1024); }
}
__device__ __forceinline__ void phase_ln2(const Frame& F, const Params& p, int l) {
    const int gw = F.vcu * NWAVES + F.wave, NGW = F.G * NWAVES; const bool lastl = (l == NL - 1);
    for (int m = gw; m < T; m += NGW) { float* row = fXF(F) + (size_t)m * 1024; f32x4 v[4];
#pragma unroll
        for (int j = 0; j < 4; ++j) v[j] = *(const f32x4*)(row + 4 * F.lane + 256 * j);
#pragma unroll
        for (int k = 0; k < 8; ++k) { const bf16_t* y = fYB(F) + ((size_t)m * 8 + k) * 1024 + 4 * F.lane;
#pragma unroll
            for (int j = 0; j < 4; ++j) { const u32x2 u = *(const u32x2*)(y + 256 * j); v[j][0] += bf2f(u[0] & 0xffffu); v[j][1] += bf2f(u[0] >> 16); v[j][2] += bf2f(u[1] & 0xffffu); v[j][3] += bf2f(u[1] >> 16); } }
        ln_finish(F, v, p.ln2_g + l * 1024, p.ln2_b + l * 1024, lastl ? p.out + (size_t)m * 1024 : row, lastl ? nullptr : fXB(F) + (size_t)m * 1024); }
}

__device__ __forceinline__ void phase_route(const Frame& F, const Params& p, int l) {
    LAS int* lcnt = (LAS int*)(F.lds + LDS_TBL + 8192 + 1024); LAS int* lbase = lcnt + 64;
    const float* rb = p.router_b + l * 64;
    const int nth = F.G * NTHR, iters = (T + nth - 1) / nth;
    for (int it = 0; it < iters; ++it) {
        const int t = it * nth + F.vcu * NTHR + F.tid; const bool act = t < T;
        __syncthreads();
        if (F.tid < 64) lcnt[F.tid] = 0;
        __syncthreads();
        int ek[8], pk[8]; float gk[8];
        if (act) {
            float sel[64];
            const float* l0 = fLG(F) + (size_t)t * 64; const float* l1 = fLG(F) + ((size_t)T + t) * 64;
#pragma unroll
            for (int e4 = 0; e4 < 16; ++e4) { const f32x4 a = *(const f32x4*)(l0 + 4 * e4), c = *(const f32x4*)(l1 + 4 * e4), bb = *(const f32x4*)(rb + 4 * e4);
#pragma unroll
                for (int j = 0; j < 4; ++j) sel[4 * e4 + j] = 1.0f / (1.0f + __expf(-(a[j] + c[j]))) + bb[j]; }
            float gs = 0.f;
#pragma unroll
            for (int k = 0; k < 8; ++k) { float best = -INFINITY; int bi = 0;
#pragma unroll
                for (int e = 0; e < 64; ++e) { const bool gt = sel[e] > best; best = gt ? sel[e] : best; bi = gt ? e : bi; }
#pragma unroll
                for (int e = 0; e < 64; ++e) sel[e] = (e == bi) ? -INFINITY : sel[e];
                ek[k] = bi; gk[k] = best - rb[bi]; gs += gk[k]; }
            const float sc = ROUTED_SCALE / gs;
#pragma unroll
            for (int k = 0; k < 8; ++k) { gk[k] *= sc; pk[k] = __hip_atomic_fetch_add(lcnt + ek[k], 1, __ATOMIC_RELAXED, __HIP_MEMORY_SCOPE_WORKGROUP); }
        }
        __syncthreads();
        if (F.tid < 64) { const int c = lcnt[F.tid]; lbase[F.tid] = c ? (int)__hip_atomic_fetch_add(F.ctl + CW_CNT + l * 64 + F.tid, (unsigned)c, __ATOMIC_RELAXED, __HIP_MEMORY_SCOPE_AGENT) : 0; }
        __syncthreads();
        if (act) {
#pragma unroll
            for (int k = 0; k < 8; ++k) { fLST(F)[(size_t)ek[k] * T + lbase[ek[k]] + pk[k]] = (unsigned)(t * 8 + k); fGATE(F)[(size_t)t * 8 + k] = gk[k]; } }
    }
}
__device__ __forceinline__ void frame_init(Frame& F, const Params& p, unsigned char* lds) {
    F.lds = (LAS unsigned char*)lds; F.MISC = (volatile LAS unsigned*)(F.lds + LDS_MISC);
    F.tid = threadIdx.x; F.lane = F.tid & 63; F.wave = __builtin_amdgcn_readfirstlane(F.tid >> 6);
    F.G = gridDim.x; { const int bx = blockIdx.x; F.vcu = (F.G % 8 == 0) ? (bx % 8) * (F.G / 8) + bx / 8 : bx; }
    F.ws = p.ws; F.ctl = (unsigned*)(p.ws + WS_CTL);
}

constexpr int NPHASE = 1 + 10 * NL;
__global__ void __launch_bounds__(NTHR, 2) mega(Params p) {
    extern __shared__ __attribute__((aligned(16))) unsigned char lds_raw[];
    Frame F; frame_init(F, p, lds_raw);
    if (F.tid < 64) F.MISC[F.tid] = 0u;
    __syncthreads();
    const int lo = p.ph_lo, hi = p.ph_hi;
    XcdBarrier bar; bar.bar = F.ctl + CW_BAR; bar.x = 0; bar.st = F.MISC + 8;
    if (hi - lo > 1) bar = xcd_barrier_post(F.ctl + CW_BAR, F.MISC + 8);
#define IN(k) (lo <= (k) && (k) < hi)
#define SEAM(k) do { if (IN(k) && IN((k) + 1)) xcd_barrier(bar); } while (0)
    if (IN(0)) { const Frame Fp = phase_frame(F); phase_x_to_xb(Fp, p.x); phase_rope_table(Fp, p.pos); convert_layer(Fp, p, 0); }
    SEAM(0);
    for (int l = 0; l < NL; ++l) {
        const int pb = 1 + 10 * l;
        if (IN(pb + 0)) phase_inproj(phase_frame(F));
        SEAM(pb + 0);
        if (IN(pb + 1)) { phase_mla_up(phase_frame(F), p); phase_indexer(phase_frame(F)); }
        SEAM(pb + 1);
        if (IN(pb + 2)) phase_attention(phase_frame(F), p);
        SEAM(pb + 2);
        if (IN(pb + 3)) { const Frame Fp = phase_frame(F); phase_outproj(Fp, l == 0 ? p.x : fXF(Fp)); }
        SEAM(pb + 3);
        if (IN(pb + 4)) phase_ln1(phase_frame(F), p, l);
        SEAM(pb + 4);
        if (IN(pb + 5)) phase_router_sharedg1(phase_frame(F));
        SEAM(pb + 5);
        if (IN(pb + 6)) { phase_route(phase_frame(F), p, l); phase_shared_g2(phase_frame(F)); }
        SEAM(pb + 6);
        if (IN(pb + 7)) phase_moe_g1(phase_frame(F), l);
        SEAM(pb + 7);
        if (IN(pb + 8)) phase_moe_g2(phase_frame(F), l);
        SEAM(pb + 8);
        if (IN(pb + 9)) { phase_ln2(phase_frame(F), p, l); if (l + 1 < NL) convert_layer(phase_frame(F), p, l + 1); }
        SEAM(pb + 9);
    }
#undef IN
#undef SEAM
}
#ifndef DBG
#define DBG 0
#endif
#if DBG
__device__ __forceinline__ unsigned dhash(unsigned x) { x ^= x >> 16; x *= 0x7feb352du; x ^= x >> 15; x *= 0x846ca68bu; x ^= x >> 16; return x; }
__device__ __forceinline__ float bfr(float v) { return bf2f(f2bf(v)); }
__device__ double blk_sum(double v, double* sh) {
    sh[threadIdx.x] = v; __syncthreads();
    for (int o = 128; o > 0; o >>= 1) { if ((int)threadIdx.x < o) sh[threadIdx.x] += sh[threadIdx.x + o]; __syncthreads(); }
    const double r = sh[0]; __syncthreads(); return r;
}
__device__ void dflag(unsigned* ctl, int id, float got, float ref) { atomicOr(&ctl[CW_FLAG + id], 1u); atomicMax(&ctl[CW_FLAG + 32 + id], __float_as_uint(fabsf(got - ref))); }
__device__ bool dbad(float got, float ref, float rt, float at) { return !(fabsf(got - ref) <= at + rt * fabsf(ref)); }
#define DF Frame F; F.ws = p.ws; F.ctl = (unsigned*)p.ws;

__global__ void __launch_bounds__(256) chk_u(Params p) { DF __shared__ double sh[256];
    const unsigned hsh = dhash(blockIdx.x * 2654435761u + 1u); const int t = hsh % T; const int col = (blockIdx.x < 8) ? 2976 + blockIdx.x : (dhash(hsh) % 2976);
    int n = -1; if (col < 2504) n = col; else if (col >= 2560 && col < 2976) n = col - 56;
    double s = 0; if (n >= 0) { const float sc = (n < 384 || (n >= 1152 && n < 1408)) ? QSCALE : 1.f; for (int k = threadIdx.x; k < 1024; k += 256) s += (double)bf2f(fXB(F)[(size_t)t * 1024 + k]) * bfr(p.w_in[(size_t)k * IN_W + n] * sc); }
    s = blk_sum(s, sh); if (threadIdx.x == 0) { const float got = bf2f(fU(F)[(size_t)t * LDU + col]); if (dbad(got, (float)s, 0.02f, 0.02f)) dflag(F.ctl, 1, got, (float)s); } }
__global__ void __launch_bounds__(256) chk_mq(Params p) { DF __shared__ double sh[256];
    const unsigned hsh = dhash(blockIdx.x * 2654435761u + 2u); const int t = hsh % T, c = dhash(hsh) % 576, w = c % 96;
    const int cp = w >= 80 ? c - 16 : (w >= 64 ? c + 16 : c);
    double a = 0, b = 0, ss = 0; { const int k = threadIdx.x; const float x = bf2f(fU(F)[(size_t)t * LDU + U_CQ + k]); ss = (double)x * x;
        a = (double)x * bfr(p.w_uq[(size_t)k * 576 + c] * (p.q_norm[k] * MLA_QSCALE)); b = (double)x * bfr(p.w_uq[(size_t)k * 576 + cp] * (p.q_norm[k] * MLA_QSCALE)); }
    a = blk_sum(a, sh); b = blk_sum(b, sh); ss = blk_sum(ss, sh);
    if (threadIdx.x == 0) { const double r = 1.0 / sqrt(ss / 256.0 + 1e-6); double v = a * r;
        if (w >= 64) { const int i = (w - 64) & 15; const double ang = (double)p.pos[t] * pow(10000.0, -(double)i / 16.0); v = w < 80 ? a * r * cos(ang) - b * r * sin(ang) : a * r * cos(ang) + b * r * sin(ang); }
        const float got = bf2f(fMQ(F)[(size_t)t * 576 + c]); if (dbad(got, (float)v, 0.03f, 0.02f)) dflag(F.ctl, 2, got, (float)v); } }
__global__ void __launch_bounds__(256) chk_kv(Params p) { DF __shared__ double sh[256];
    const unsigned hsh = dhash(blockIdx.x * 2654435761u + 3u); const int t = hsh % T, which = blockIdx.x % 3, c = dhash(hsh) % 384, h = c >> 6, d = c & 63;
    if (which < 2) { double a = 0, ss = 0; if (threadIdx.x < 128) { const int k = threadIdx.x; const float x = bf2f(fU(F)[(size_t)t * LDU + U_CKV + k]); ss = (double)x * x; a = (double)x * bfr(p.w_ukv[(size_t)k * 768 + h * 128 + which * 64 + d] * p.kv_norm[k]); }
        a = blk_sum(a, sh); ss = blk_sum(ss, sh);
        if (threadIdx.x == 0) { const float ref = (float)(a / sqrt(ss / 128.0 + 1e-6)); const float got = bf2f((which ? fMV(F) : fMK(F))[(size_t)t * 384 + c]); if (dbad(got, ref, 0.03f, 0.02f)) dflag(F.ctl, 3, got, ref); } }
    else if (threadIdx.x == 0) { const int j = c & 15, hi = (c >> 4) & 1; const double x1 = bf2f(fU(F)[(size_t)t * LDU + U_KR + j]), x2 = bf2f(fU(F)[(size_t)t * LDU + U_KR + 16 + j]);
        const double ang = (double)p.pos[t] * pow(10000.0, -(double)j / 16.0); const float ref = (float)(hi ? x2 * cos(ang) + x1 * sin(ang) : x1 * cos(ang) - x2 * sin(ang));
        const float got = bf2f(fKR(F)[(size_t)t * 32 + hi * 16 + j]); if (dbad(got, ref, 0.02f, 0.02f)) dflag(F.ctl, 3, got, ref); } }
__global__ void __launch_bounds__(256) chk_mask(Params p) { DF __shared__ float sc[2048]; __shared__ float iq[512]; __shared__ float iw[8]; __shared__ int mism;
    const unsigned hsh = dhash(blockIdx.x * 2654435761u + 4u); const int b = hsh % NB; int q = dhash(hsh) % SEQ; if (blockIdx.x < 4) q = 254 + blockIdx.x; if (blockIdx.x == 4) q = 2047; if (blockIdx.x == 5) q = 3;
    const size_t tb = (size_t)b * SEQ;
    for (int i = threadIdx.x; i < 512; i += 256) iq[i] = bf2f(fU(F)[(tb + q) * LDU + U_IQ + i]); if (threadIdx.x < 8) iw[threadIdx.x] = bf2f(fU(F)[(tb + q) * LDU + U_IW + threadIdx.x]); if (threadIdx.x == 0) mism = 0;
    __syncthreads();
    for (int s = threadIdx.x; s < SEQ; s += 256) { float v = -INFINITY; if (s <= q) { v = 0.f; _Pragma("unroll 1") for (int h = 0; h < 8; ++h) { float d = 0.f; _Pragma("unroll 2") for (int k = 0; k < 64; ++k) d += iq[h * 64 + k] * bf2f(fU(F)[(tb + s) * LDU + U_IK + k]); v += iw[h] * fmaxf(d, 0.f); } } sc[s] = v; }
    __syncthreads();
    for (int s = threadIdx.x; s < SEQ; s += 256) { bool want = false; if (s <= q) { if (q + 1 <= 256) want = true; else { int rank = 0; const float v = sc[s]; _Pragma("unroll 4") for (int j = 0; j <= q; ++j) rank += (sc[j] > v || (sc[j] == v && j < s)) ? 1 : 0; want = rank < 256; } }
        const bool got = (fMASK(F)[(tb + q) * 64 + (s >> 5)] >> (s & 31)) & 1u; if (got != want) atomicAdd(&mism, 1); }
    __syncthreads(); if (threadIdx.x == 0 && mism > 6) dflag(F.ctl, 4, (float)mism, 0.f); }
__global__ void __launch_bounds__(256) chk_ao(Params p) { DF __shared__ double sh[256]; __shared__ float lg[2048]; __shared__ float qv[96];
    const unsigned hsh = dhash(blockIdx.x * 2654435761u + 5u); const int b = hsh % NB; int q = dhash(hsh) % SEQ; if (blockIdx.x < 6) q = (blockIdx.x & 1) ? 2047 : 700; const int mode = blockIdx.x % 3;
    const size_t tb = (size_t)b * SEQ; const unsigned h2 = dhash(hsh + 77u);
    int h, d, col; if (mode == 0) { h = h2 % 6; d = (h2 >> 8) & 63; col = 640 + h * 64 + d; } else if (mode == 1) { h = h2 % 4; d = (h2 >> 8) & 63; col = 384 + h * 64 + d; } else { h = h2 % 6; d = (h2 >> 8) & 63; col = h * 64 + d; }
    if (threadIdx.x < 96) { float v = 0.f; if (mode == 0) v = bf2f(fMQ(F)[(tb + q) * 576 + h * 96 + threadIdx.x]); else if (threadIdx.x < 64) v = bf2f(fU(F)[(tb + q) * LDU + (mode == 1 ? U_SQ : U_DQ) + h * 64 + threadIdx.x]); qv[threadIdx.x] = v; }
    __syncthreads();
    float mx = -INFINITY;
    for (int s = threadIdx.x; s < SEQ; s += 256) { float v = -INFINITY;
        if (s <= q) { const int dist = q - s; float dot = 0.f;
            if (mode == 0) { _Pragma("unroll 2") for (int k = 0; k < 64; ++k) dot += qv[k] * bf2f(fMK(F)[(tb + s) * 384 + h * 64 + k]); _Pragma("unroll 2") for (int k = 0; k < 32; ++k) dot += qv[64 + k] * bf2f(fKR(F)[(tb + s) * 32 + k]); v = dot; }
            else if (mode == 1) { if ((fMASK(F)[(tb + q) * 64 + (s >> 5)] >> (s & 31)) & 1u) { _Pragma("unroll 2") for (int k = 0; k < 64; ++k) dot += qv[k] * bf2f(fU(F)[(tb + s) * LDU + U_SK + h * 64 + k]); v = dot + t5_dist_bias(p.rel_bias, 6 + h, dist) * LOG2E; } }
            else { int mlt = 0; if (dist <= 128) ++mlt; if (dist % 4 == 0 && dist / 4 <= 128) ++mlt; if (dist % 16 == 0 && dist / 16 <= 128) ++mlt;
                if (mlt) { _Pragma("unroll 2") for (int k = 0; k < 64; ++k) dot += qv[k] * bf2f(fU(F)[(tb + s) * LDU + U_DK + h * 64 + k]); v = dot + t5_dist_bias(p.rel_bias, h, dist) * LOG2E + log2f((float)mlt); } } }
        lg[s] = v; mx = fmaxf(mx, v); }
    sh[threadIdx.x] = mx; __syncthreads(); for (int o = 128; o > 0; o >>= 1) { if ((int)threadIdx.x < o) sh[threadIdx.x] = fmax(sh[threadIdx.x], sh[threadIdx.x + o]); __syncthreads(); } const float M = (float)sh[0]; __syncthreads();
    double num = 0, den = 0;
    for (int s = threadIdx.x; s < SEQ; s += 256) if (lg[s] > -INFINITY) { const double pw = exp2((double)(lg[s] - M));
        const float vv = mode == 0 ? bf2f(fMV(F)[(tb + s) * 384 + h * 64 + d]) : bf2f(fU(F)[(tb + s) * LDU + (mode == 1 ? U_SV : U_DV) + h * 64 + d]); num += pw * vv; den += pw; }
    num = blk_sum(num, sh); den = blk_sum(den, sh);
    if (threadIdx.x == 0) { const float ref = (float)(num / den), got = bf2f(fAO(F)[(tb + q) * 1024 + col]); if (dbad(got, ref, 0.03f, 0.01f)) dflag(F.ctl, 5 + mode, got, ref); } }
__global__ void __launch_bounds__(256) chk_y1(Params p) { DF __shared__ double sh[256];
    const unsigned hsh = dhash(blockIdx.x * 2654435761u + 8u); const int t = hsh % T, c = dhash(hsh) % 1024;
    double s = 0; for (int k = threadIdx.x; k < 1024; k += 256) s += (double)bf2f(fAO(F)[(size_t)t * 1024 + k]) * bfr(p.w_out[(size_t)k * 1024 + c]);
    s = blk_sum(s, sh); if (threadIdx.x == 0) { const float ref = (float)(s + (double)DN_ALPHA * p.x[(size_t)t * 1024 + c]), got = fXF(F)[(size_t)t * 1024 + c]; if (dbad(got, ref, 0.01f, 0.01f)) dflag(F.ctl, 8, got, ref); } }
__global__ void __launch_bounds__(256) chk_ln_pre(Params p, float* side, const float* g, const float* bt, int with_yb) { DF __shared__ double sh[256];
    const int t = dhash(blockIdx.x * 2654435761u + 9u) % T; double v[4]; double s = 0;
    for (int j = 0; j < 4; ++j) { const int c = threadIdx.x + 256 * j; double x = fXF(F)[(size_t)t * 1024 + c]; if (with_yb) for (int k = 0; k < 8; ++k) x += bf2f(fYB(F)[((size_t)t * 8 + k) * 1024 + c]); v[j] = x; s += x; }
    const double mean = blk_sum(s, sh) / 1024.0; double s2 = 0; for (int j = 0; j < 4; ++j) s2 += (v[j] - mean) * (v[j] - mean);
    const double rstd = 1.0 / sqrt(blk_sum(s2, sh) / 1024.0 + 1e-5);
    for (int j = 0; j < 4; ++j) { const int c = threadIdx.x + 256 * j; side[(size_t)blockIdx.x * 1024 + c] = (float)((v[j] - mean) * rstd * g[c] + bt[c]); } }
__global__ void __launch_bounds__(256) chk_ln_post(Params p, const float* side, const float* got_base, int id, int chk_xb) { DF
    const int t = dhash(blockIdx.x * 2654435761u + 9u) % T;
    for (int j = 0; j < 4; ++j) { const int c = threadIdx.x + 256 * j; const float ref = side[(size_t)blockIdx.x * 1024 + c], got = got_base[(size_t)t * 1024 + c];
        if (dbad(got, ref, 1e-3f, 1e-3f)) dflag(F.ctl, id, got, ref);
        if (chk_xb) { const float gb = bf2f(fXB(F)[(size_t)t * 1024 + c]); if (dbad(gb, ref, 0.01f, 0.01f)) dflag(F.ctl, id, gb, ref); } } }
__global__ void __launch_bounds__(256) chk_lg(Params p) { DF __shared__ double sh[256];
    const unsigned hsh = dhash(blockIdx.x * 2654435761u + 11u); const int t = hsh % T;
    if (blockIdx.x & 1) { const int e = dhash(hsh) % 64; double s = 0; for (int k = threadIdx.x; k < 1024; k += 256) s += (double)bf2f(fXB(F)[(size_t)t * 1024 + k]) * bfr(p.router_w[(size_t)k * 64 + e]);
        s = blk_sum(s, sh); if (threadIdx.x == 0) { const float got = fLG(F)[(size_t)t * 64 + e] + fLG(F)[((size_t)T + t) * 64 + e]; if (dbad(got, (float)s, 0.01f, 0.01f)) dflag(F.ctl, 11, got, (float)s); } }
    else { const int f = dhash(hsh) % 256; double a = 0, b = 0; for (int k = threadIdx.x; k < 1024; k += 256) { const double x = bf2f(fXB(F)[(size_t)t * 1024 + k]); a += x * bfr(p.sw1[(size_t)k * 256 + f]); b += x * bfr(p.sw3[(size_t)k * 256 + f]); }
        a = blk_sum(a, sh); b = blk_sum(b, sh); if (threadIdx.x == 0) { const float ref = (float)(a / (1.0 + exp(-a)) * b), got = bf2f(fH(F)[((size_t)T * 8 + t) * 256 + f]); if (dbad(got, ref, 0.03f, 0.01f)) dflag(F.ctl, 12, got, ref); } } }
__global__ void __launch_bounds__(256) chk_route(Params p) { DF __shared__ float sel[64]; __shared__ float scv[64]; __shared__ int ek[8]; __shared__ float gk[8]; __shared__ int found[8];
    const int t = dhash(blockIdx.x * 2654435761u + 13u) % T;
    if (threadIdx.x < 64) { const float lgv = fLG(F)[(size_t)t * 64 + threadIdx.x] + fLG(F)[((size_t)T + t) * 64 + threadIdx.x]; const float s = 1.f / (1.f + expf(-lgv)); scv[threadIdx.x] = s; sel[threadIdx.x] = s + p.router_b[threadIdx.x]; }
    if (threadIdx.x < 8) found[threadIdx.x] = 0;
    __syncthreads();
    if (threadIdx.x == 0) { float gs = 0.f; for (int k = 0; k < 8; ++k) { int bi = 0; float best = -INFINITY; for (int e = 0; e < 64; ++e) if (sel[e] > best) { best = sel[e]; bi = e; } sel[bi] = -INFINITY; ek[k] = bi; gk[k] = scv[bi]; gs += scv[bi]; }
        for (int k = 0; k < 8; ++k) gk[k] = gk[k] / gs * ROUTED_SCALE;
        if (blockIdx.x == 0) { unsigned tot = 0; for (int e = 0; e < 64; ++e) tot += F.ctl[CW_CNT + e]; if (tot != (unsigned)T * 8u) dflag(F.ctl, 13, (float)tot, (float)(T * 8)); } }
    __syncthreads();
    for (int k = 0; k < 8; ++k) { const int e = ek[k]; const int n = (int)F.ctl[CW_CNT + e]; for (int i = threadIdx.x; i < n; i += 256) if (fLST(F)[(size_t)e * T + i] == (unsigned)(t * 8 + k)) atomicAdd(&found[k], 1); }
    __syncthreads();
    if (threadIdx.x < 8) { if (found[threadIdx.x] != 1) dflag(F.ctl, 14, (float)found[threadIdx.x], 1.f); const float got = fGATE(F)[(size_t)t * 8 + threadIdx.x]; if (dbad(got, gk[threadIdx.x], 2e-3f, 1e-4f)) dflag(F.ctl, 15, got, gk[threadIdx.x]); } }
__global__ void __launch_bounds__(256) chk_z0(Params p) { DF __shared__ double sh[256];
    const unsigned hsh = dhash(blockIdx.x * 2654435761u + 16u); const int t = hsh % T, c = dhash(hsh) % 1024;
    double s = 0; { const int f = threadIdx.x; s = (double)bf2f(fH(F)[((size_t)T * 8 + t) * 256 + f]) * bfr(p.sw2[(size_t)f * 1024 + c]); }
    s = blk_sum(s, sh); if (threadIdx.x == 0) { const float ref = (float)(s + (double)DN_ALPHA * bf2f(fXB(F)[(size_t)t * 1024 + c])), got = fXF(F)[(size_t)t * 1024 + c]; if (dbad(got, ref, 0.03f, 0.03f)) dflag(F.ctl, 16, got, ref); } }
__global__ void __launch_bounds__(256) chk_moe(Params p, int stage) { DF __shared__ double sh[256];
    const unsigned hsh = dhash(blockIdx.x * 2654435761u + 17u + stage); const int e = hsh % 64; const int n = (int)F.ctl[CW_CNT + e]; if (n == 0) return;
    const int i = (blockIdx.x < 8) ? ((blockIdx.x & 1) ? n - 1 : 0) : dhash(hsh) % n; const unsigned aid = fLST(F)[(size_t)e * T + i]; const int t = aid >> 3;
    if (stage == 0) { const int f = dhash(hsh + 5u) % 256; double a = 0, b = 0; const float* w1 = p.w1 + (size_t)e * 1024 * 256; const float* w3 = p.w3 + (size_t)e * 1024 * 256;
        for (int k = threadIdx.x; k < 1024; k += 256) { const double x = bf2f(fXB(F)[(size_t)t * 1024 + k]); a += x * bfr(w1[(size_t)k * 256 + f]); b += x * bfr(w3[(size_t)k * 256 + f]); }
        a = blk_sum(a, sh); b = blk_sum(b, sh); if (threadIdx.x == 0) { const float ref = (float)(a / (1.0 + exp(-a)) * b), got = bf2f(fH(F)[(size_t)aid * 256 + f]); if (dbad(got, ref, 0.03f, 0.01f)) dflag(F.ctl, 17, got, ref); } }
    else { const int c = dhash(hsh + 5u) % 1024; const float* w2 = p.w2 + (size_t)e * 256 * 1024; double s = (double)bf2f(fH(F)[(size_t)aid * 256 + threadIdx.x]) * bfr(w2[(size_t)threadIdx.x * 1024 + c]);
        s = blk_sum(s, sh); if (threadIdx.x == 0) { const float ref = (float)(s * fGATE(F)[aid]), got = bf2f(fYB(F)[(size_t)aid * 1024 + c]); if (dbad(got, ref, 0.03f, 0.005f)) dflag(F.ctl, 18, got, ref); } } }
__global__ void __launch_bounds__(256) chk_report(Params p, int zero_if_ok) { DF __shared__ int code;
    if (threadIdx.x == 0) { code = 0; for (int i = 31; i >= 1; --i) if (F.ctl[CW_FLAG + i]) code = i; if (F.ctl[CW_BAR + XB_TMO]) code = 30; } __syncthreads();
    if (code == 0 && !zero_if_ok) return; const float v = sqrtf((float)code);
    for (size_t i = (size_t)blockIdx.x * 256 + threadIdx.x; i < (size_t)T * 1024; i += (size_t)gridDim.x * 256) p.out[i] = v; }

#ifndef DBG_STOP
#define DBG_STOP 41
#endif
static void dbg_run(Params p, int grid, hipStream_t st) {
    float* side = (float*)(p.ws + WS_R + R_SCR);
    float* side2 = (float*)(p.ws + WS_H);
    for (int k = 0; k < NPHASE && k < DBG_STOP; ++k) {
        const int l = (k - 1) / 10, ph = (k - 1) % 10;
        if (k >= 1 && l == 0 && ph == 4) chk_ln_pre<<<64, 256, 0, st>>>(p, side, p.ln1_g, p.ln1_b, 0);
        if (k >= 1 && l == 0 && ph == 9) chk_ln_pre<<<64, 256, 0, st>>>(p, side2, p.ln2_g, p.ln2_b, 1);
        p.ph_lo = k; p.ph_hi = k + 1; mega<<<dim3(grid), dim3(NTHR), LDS_BYTES, st>>>(p);
        if (k < 1 || l != 0) continue;
        if (ph == 0) chk_u<<<256, 256, 0, st>>>(p);
        if (ph == 1) { chk_mq<<<256, 256, 0, st>>>(p); chk_kv<<<255, 256, 0, st>>>(p); chk_mask<<<48, 256, 0, st>>>(p); }
        if (ph == 2) chk_ao<<<96, 256, 0, st>>>(p);
        if (ph == 3) chk_y1<<<256, 256, 0, st>>>(p);
        if (ph == 4) chk_ln_post<<<64, 256, 0, st>>>(p, side, (const float*)(p.ws + WS_XF), 9, 1);
        if (ph == 5) chk_lg<<<256, 256, 0, st>>>(p);
        if (ph == 6) { chk_route<<<64, 256, 0, st>>>(p); chk_z0<<<256, 256, 0, st>>>(p); }
        if (ph == 7) chk_moe<<<256, 256, 0, st>>>(p, 0);
        if (ph == 8) chk_moe<<<256, 256, 0, st>>>(p, 1);
        if (ph == 9) chk_ln_post<<<64, 256, 0, st>>>(p, side2, (const float*)(p.ws + WS_XF), 19, 1);
    }
    chk_report<<<1024, 256, 0, st>>>(p, DBG_STOP < NPHASE ? 1 : 0);
}
#endif
extern "C" void kernel_launch(void* const* d_in, const int* in_sizes, int n_in, void* d_out, int out_size, void* d_ws, size_t ws_size, hipStream_t stream) {
    static int grid = 0;
    if (grid == 0) {
        if (n_in != 21 || out_size != T * DM || ws_size < WS_END) { fprintf(stderr, "kernel_launch: unexpected problem (n_in %d, out %d, ws %zu < %zu); nothing launched\n", n_in, out_size, ws_size, (size_t)WS_END); grid = -1; return; }
        int dev = 0, cus = 0, per_cu = 0;
        if (hipGetDevice(&dev) != hipSuccess || hipDeviceGetAttribute(&cus, hipDeviceAttributeMultiprocessorCount, dev) != hipSuccess) { grid = -1; return; }
        if (hipFuncSetAttribute((const void*)mega, hipFuncAttributeMaxDynamicSharedMemorySize, LDS_BYTES) != hipSuccess) { fprintf(stderr, "kernel_launch: hipFuncSetAttribute failed\n"); grid = -1; return; }
        if (hipOccupancyMaxActiveBlocksPerMultiprocessor(&per_cu, (const void*)mega, NTHR, LDS_BYTES) != hipSuccess || per_cu < 1) { fprintf(stderr, "kernel_launch: occupancy query says %d\n", per_cu); (void)hipGetLastError(); per_cu = 1; }
        grid = cus > 256 ? 256 : cus;
    }
    if (grid < 0) return;
    (void)hipMemsetAsync((char*)d_ws + WS_CTL, 0, CTL_BYTES, stream);
    Params p{};
    p.x = (const float*)d_in[0]; p.pos = (const int*)d_in[1]; p.w_in = (const float*)d_in[2]; p.q_norm = (const float*)d_in[3]; p.w_uq = (const float*)d_in[4];
    p.kv_norm = (const float*)d_in[5]; p.w_ukv = (const float*)d_in[6]; p.w_out = (const float*)d_in[7]; p.ln1_g = (const float*)d_in[8]; p.ln1_b = (const float*)d_in[9];
    p.router_w = (const float*)d_in[10]; p.router_b = (const float*)d_in[11]; p.w1 = (const float*)d_in[12]; p.w3 = (const float*)d_in[13]; p.w2 = (const float*)d_in[14];
    p.sw1 = (const float*)d_in[15]; p.sw3 = (const float*)d_in[16]; p.sw2 = (const float*)d_in[17]; p.ln2_g = (const float*)d_in[18]; p.ln2_b = (const float*)d_in[19]; p.rel_bias = (const float*)d_in[20];
    p.out = (float*)d_out; p.ws = (unsigned char*)d_ws;
#if DBG
    dbg_run(p, grid, stream);
#elif defined(MULTI_LAUNCH)
    for (int k = 0; k < NPHASE; ++k) { p.ph_lo = k; p.ph_hi = k + 1; mega<<<dim3(grid), dim3(NTHR), LDS_BYTES, stream>>>(p); }
#else
    p.ph_lo = 0; p.ph_hi = NPHASE;
    mega<<<dim3(grid), dim3(NTHR), LDS_BYTES, stream>>>(p);
#endif
}
```

```cpp
#include <hip/hip_runtime.h>
#include <cstdio>
#include <cstdint>

#define LAS __attribute__((address_space(3)))
typedef unsigned short bf16_t;
typedef short bf16x8 __attribute__((ext_vector_type(8)));
typedef short s16x4 __attribute__((ext_vector_type(4)));
typedef float f32x2 __attribute__((ext_vector_type(2)));
typedef float f32x4 __attribute__((ext_vector_type(4)));
typedef float f32x16 __attribute__((ext_vector_type(16)));
typedef unsigned u32x4 __attribute__((ext_vector_type(4)));
typedef unsigned u32x2 __attribute__((ext_vector_type(2)));
typedef __bf16 bf16x2_t __attribute__((ext_vector_type(2)));

constexpr int NB = 16, SEQ = 2048, T = NB * SEQ, DM = 1024, NL = 4;
constexpr int IN_W = 2920, LDU = 3072;
constexpr int U_DQ = 0, U_DK = 384, U_DV = 768, U_SQ = 1152, U_SK = 1408, U_SV = 1664, U_IQ = 1920, U_IK = 2432, U_IW = 2496, U_CQ = 2560, U_CKV = 2816, U_KR = 2944;
constexpr int NE = 64, FF = 256;
constexpr float LOG2E = 1.4426950408889634f;
constexpr float QSCALE = 0.125f * LOG2E;
constexpr float MLA_QSCALE = 0.10206207261596575f * LOG2E;
constexpr float DN_ALPHA = 1.6817928305074290f;
constexpr float LN_EPS = 1e-5f, RMS_EPS = 1e-6f;
constexpr float ROUTED_SCALE = 2.5f;

constexpr size_t MiB = (size_t)1 << 20;
constexpr size_t WS_CTL = 0, CTL_BYTES = 1 * MiB;
constexpr size_t WS_DTAB = 512 * 1024;
constexpr size_t WS_W = 1 * MiB;
constexpr size_t W_IN = 0, W_UQ = W_IN + (size_t)3072 * 1024 * 2, W_UKV = W_UQ + (size_t)768 * 256 * 2, W_OUT = W_UKV + (size_t)768 * 256 * 2,
                 W_R = W_OUT + (size_t)1024 * 1024 * 2, W_13 = W_R + (size_t)256 * 1024 * 2, W_2 = W_13 + (size_t)65 * 512 * 1024 * 2, W_END = W_2 + (size_t)65 * 1024 * 256 * 2;
static_assert(W_END <= 108 * MiB, "weights region");
constexpr size_t WS_XF = 109 * MiB;
constexpr size_t WS_XB = 237 * MiB;
constexpr size_t WS_H = 301 * MiB;
constexpr size_t WS_LST = 445 * MiB;
constexpr size_t WS_GATE = 453 * MiB;
constexpr size_t WS_ROPE = 454 * MiB;
constexpr size_t WS_R = 458 * MiB;
constexpr size_t R_U = 0, R_MQ = 192 * MiB, R_MK = 228 * MiB, R_MV = 252 * MiB, R_KR = 276 * MiB, R_AO = 278 * MiB, R_MASK = 342 * MiB, R_SCR = 350 * MiB, R_LG = 414 * MiB;
constexpr size_t WS_END = 970 * MiB;
constexpr int CW_TMO = 0, CW_FLAG = 16  , CW_BAR = 4096, CW_CNT = 8192  , CW_Q = 16384  ;

__device__ __forceinline__ unsigned f2bf(float f) { unsigned u = __builtin_bit_cast(unsigned, f); return (u + 0x7fffu + ((u >> 16) & 1u)) >> 16; }
__device__ __forceinline__ float bf2f(unsigned b) { return __builtin_bit_cast(float, b << 16); }
__device__ __forceinline__ unsigned cvt_pk(float lo, float hi) { f32x2 v = {lo, hi}; bf16x2_t b = __builtin_convertvector(v, bf16x2_t); return __builtin_bit_cast(unsigned, b); }
#define LDS_WAIT() asm volatile("s_waitcnt lgkmcnt(0)" ::: "memory")
#define VM_WAIT() asm volatile("s_waitcnt vmcnt(0)" ::: "memory")
__device__ __forceinline__ float wave_sum(float v) {
#pragma unroll
    for (int o = 1; o < 64; o <<= 1) v += __shfl_xor(v, o);
    return v;
}

#define XB_TMO      128
#define XB_XCNT(j)  (256  + 64 * (j))
#define XB_XSUB(j)  (1280 + 64 * (j))
#define XB_XGEN(j)  (2304 + 64 * (j))
#define XB_TOP      3328
#define XB_TOPGEN   3392
#define XCD_BAR_WORDS 3456
#define XB_SPIN_CAP (1u << 18)
__device__ __forceinline__ unsigned xb_ld(unsigned* p)              { return __hip_atomic_load(p, __ATOMIC_RELAXED, __HIP_MEMORY_SCOPE_AGENT); }
__device__ __forceinline__ unsigned xb_add(unsigned* p, unsigned v) { return __hip_atomic_fetch_add(p, v, __ATOMIC_RELAXED, __HIP_MEMORY_SCOPE_AGENT); }
__device__ __forceinline__ unsigned xb_xcc_id() { return (unsigned)__builtin_amdgcn_s_getreg((3 << 11) | 20) & 0xFu; }
#define XB_SPIN(cond, bar) do { unsigned _sp = 0; while (cond) { __builtin_amdgcn_s_sleep(1); \
    if ((++_sp & 255u) == 0u) { if (xb_ld(&(bar)[XB_TMO])) break; if (_sp > XB_SPIN_CAP) { atomicAdd(&(bar)[XB_TMO], 1u); break; } } } } while (0)
struct XcdBarrier { unsigned* bar; unsigned x; volatile LAS unsigned* st; };
__device__ __forceinline__ XcdBarrier xcd_barrier_post(unsigned* bar, volatile LAS unsigned* st) {
    XcdBarrier b; b.bar = bar; b.x = xb_xcc_id(); b.st = st;
    if (threadIdx.x == 0) (void)xb_add(&bar[XB_XCNT(b.x)], 1u);
    return b;
}
__device__ __forceinline__ void xcd_barrier_complete(unsigned* bar, unsigned x, unsigned& nloc, unsigned& nx) {
    const unsigned G = gridDim.x * gridDim.y * gridDim.z;
    unsigned sum, cnt, mine, sp = 0u;
    for (;;) {
        sum = 0u; cnt = 0u; mine = 0u;
#pragma unroll
        for (unsigned j = 0; j < 16; ++j) { const unsigned c = xb_ld(&bar[XB_XCNT(j)]); sum += c; cnt += (c > 0u) ? 1u : 0u; mine = (j == x) ? c : mine; }
        if (sum == G) break;
        __builtin_amdgcn_s_sleep(1);
        if ((++sp & 255u) == 0u) { if (xb_ld(&bar[XB_TMO])) break; if (sp > XB_SPIN_CAP) { atomicAdd(&bar[XB_TMO], 1u); break; } }
    }
    nloc = mine > 0u ? mine : 1u; nx = cnt > 0u ? cnt : 1u;
}
__device__ __forceinline__ void xcd_barrier(const XcdBarrier& b) {
    asm volatile("s_waitcnt vmcnt(0)" ::: "memory");
    __syncthreads();
    if (threadIdx.x == 0) {
        unsigned* bar = b.bar;
        __builtin_amdgcn_s_waitcnt(0);
        unsigned nloc = b.st[0], nx = b.st[1];
        if (nloc == 0u) { xcd_barrier_complete(bar, b.x, nloc, nx); b.st[0] = nloc; b.st[1] = nx; }
        const unsigned old = xb_add(&bar[XB_XSUB(b.x)], 1u);
        const unsigned gen = old / nloc;
        if (old + 1u == (gen + 1u) * nloc) {
            __builtin_amdgcn_fence(__ATOMIC_RELEASE, "agent");
            asm volatile("s_waitcnt vmcnt(0)" ::: "memory");
            const unsigned og = xb_add(&bar[XB_TOP], 1u);
            const unsigned tg = og / nx;
            if (og + 1u == (tg + 1u) * nx) xb_add(&bar[XB_TOPGEN], 1u);
            else XB_SPIN(xb_ld(&bar[XB_TOPGEN]) == tg, bar);
            __builtin_amdgcn_fence(__ATOMIC_ACQUIRE, "agent");
            xb_add(&bar[XB_XGEN(b.x)], 1u);
            asm volatile("s_waitcnt vmcnt(0)" ::: "memory");
        } else {
            XB_SPIN(xb_ld(&bar[XB_XGEN(b.x)]) == gen, bar);
            __builtin_amdgcn_fence(__ATOMIC_ACQUIRE, "agent");
            asm volatile("s_waitcnt vmcnt(0)" ::: "memory");
        }
    }
    __syncthreads();
}

namespace pg8 {
constexpr int BM = 256, BK = 64, HALF = 128, HTB = HALF * BK * 2, STAGE_BYTES = 8 * HTB, NXCD = 8, WGM = 4;
__device__ __forceinline__ int lds_byte(int r, int c) { const int st = (r >> 4) * 2 + (c >> 5), rr = r & 15, cc = c & 31, ob = rr * 64 + cc * 2; return st * 1024 + (ob ^ (((ob >> 9) & 1) << 5)); }
__device__ __forceinline__ void stage_rc(int b, int& R, int& C) { const int st = b / 1024, sb = b % 1024, swz = sb ^ (((sb >> 9) & 1) << 5); R = (st >> 1) * 16 + swz / 64; C = (st & 1) * 32 + (swz % 64) / 2; }
__device__ __forceinline__ int perm32(int rho) { const int n = rho >> 4, i = rho & 15; return 8 * (i >> 2) + 4 * n + (i & 3); }
struct Unit { int pm, pn, e, seq; };

__device__ __forceinline__ int xcd_remap(int L, int nwg) { const int q = nwg / NXCD, r = nwg % NXCD, xcd = L % NXCD, off = L / NXCD; return (xcd < r ? xcd * (q + 1) : r * (q + 1) + (xcd - r) * q) + off; }

struct DenseOrder {
    int nM, nN, nwg, G, c; unsigned lda, acol; const char* Bt; unsigned ldb;
    __device__ void init(int M, int N, int G_, int c_, unsigned lda_, unsigned acol_, const void* Bt_, unsigned ldb_) { nM = M / BM; nN = N / BM; nwg = nM * nN; G = G_; c = c_; lda = lda_; acol = acol_; Bt = (const char*)Bt_; ldb = ldb_; }
    __device__ __forceinline__ bool next(int i, Unit& u) const {
        const long L = (long)i * G + c; if (L >= nwg) return false;
        const int wgid = xcd_remap((int)L, nwg);
        const int nig = WGM * nN, gid = wgid / nig, fm = gid * WGM, gsz = (nM - fm) < WGM ? (nM - fm) : WGM;
        u.pm = fm + ((wgid % nig) % gsz); u.pn = (wgid % nig) / gsz; u.e = 0; u.seq = i; return true;
    }
    __device__ __forceinline__ void a_voff(const Unit& u, int tid, unsigned (&v)[2][2]) const {
#pragma unroll
        for (int i = 0; i < 2; ++i) { int R, C; stage_rc(tid * 16 + i * 8192, R, C);
#pragma unroll
            for (int h = 0; h < 2; ++h) v[h][i] = ((unsigned)(u.pm * BM + h * HALF + R) * lda + acol + (unsigned)C) * 2u; }
    }
    __device__ __forceinline__ const char* b_base(const Unit& u) const { return Bt + (size_t)u.pn * BM * ldb * 2; }
};

template <class Epi, class Sched>
__device__ __forceinline__ void gemm_phase(LAS unsigned char* lds, LAS unsigned char* vslot  , const char* Abase, const int K, const unsigned ldb, const Sched& S, const Epi& E) {
    int tid = threadIdx.x; asm volatile("" : "+v"(tid));
    const int wid = __builtin_amdgcn_readfirstlane(tid >> 6), wr = wid >> 2, wc = wid & 3;
    const int nt = K / BK;
    unsigned voffB[2];
#pragma unroll
    for (int i = 0; i < 2; ++i) { int R, C; stage_rc(tid * 16 + i * 8192, R, C); const int Rb = (Epi::PERM == 2) ? (((R >> 5) & 3) * 64 + perm32(R & 31)) : (Epi::PERM ? ((R & ~31) + perm32(R & 31)) : R); voffB[i] = ((unsigned)Rb * ldb + (unsigned)C) * 2u; }
    const size_t kstep = (size_t)(BK * 2);
    const size_t hstepB = (size_t)(Epi::PERM == 2 ? 32 : HALF) * ldb * 2;
    const unsigned ldsw = (unsigned)wid * 1024u;
    const int aoff = lds_byte(wr * 64 + (tid & 15), ((tid & 63) >> 4) * 8), boff = lds_byte(wc * 32 + (tid & 15), ((tid & 63) >> 4) * 8);
#define PG8_SA(b, h) (((b) * 2 + (h)) * HTB)
#define PG8_SB(b, h) ((4 + (b) * 2 + (h)) * HTB)
#define PG8_STAGE(bufoff, gbase, voff) do { _Pragma("unroll") for (int _i = 0; _i < 2; ++_i) \
        __builtin_amdgcn_global_load_lds((const unsigned*)((const char*)(gbase) + (voff)[_i]), (LAS unsigned*)(lds + (bufoff) + ldsw + _i * 8192), 16, 0, 0); } while (0)
#define PG8_LDA(dst, b, h) do { _Pragma("unroll") for (int m = 0; m < 4; ++m) _Pragma("unroll") for (int k = 0; k < 2; ++k) dst[m][k] = *(const LAS bf16x8*)(lds + PG8_SA(b, h) + aoff + m * 2048 + k * 1024); } while (0)
#define PG8_LDB(dst, b, h) do { _Pragma("unroll") for (int n = 0; n < 2; ++n) _Pragma("unroll") for (int k = 0; k < 2; ++k) dst[n][k] = *(const LAS bf16x8*)(lds + PG8_SB(b, h) + boff + n * 2048 + k * 1024); } while (0)
#define PG8_MMA(ai, bj, At, Bt) do { __builtin_amdgcn_s_setprio(1); _Pragma("unroll") for (int m = 0; m < 4; ++m) _Pragma("unroll") for (int n = 0; n < 2; ++n) _Pragma("unroll") for (int k = 0; k < 2; ++k) \
        acc[ai][bj][m][n] = __builtin_amdgcn_mfma_f32_16x16x32_bf16(Bt[n][k], At[m][k], acc[ai][bj][m][n], 0, 0, 0); __builtin_amdgcn_s_setprio(0); } while (0)
#define PG8_WAIT_V(n) asm volatile("s_waitcnt vmcnt(" #n ")" ::: "memory")
#define PG8_WAIT_L(n) asm volatile("s_waitcnt lgkmcnt(" #n ")" ::: "memory")
#define PG8_BAR __builtin_amdgcn_s_barrier()
#define PG8_SCHED __builtin_amdgcn_sched_barrier(0)
    Unit cur, nxt; int ui = 0;
    if (!S.next(0, cur)) return;
    f32x4 acc[2][2][4][2];
#pragma unroll
    for (int a = 0; a < 2; ++a)
#pragma unroll
        for (int b = 0; b < 2; ++b)
#pragma unroll
            for (int m = 0; m < 4; ++m)
#pragma unroll
                for (int n = 0; n < 2; ++n) acc[a][b][m][n] = (f32x4){0.f, 0.f, 0.f, 0.f};
    bf16x8 At[4][2], B0[2][2], B1[2][2];
    unsigned vc[2][2];
    S.a_voff(cur, tid, vc);
    const char* cB = S.b_base(cur);
    PG8_STAGE(PG8_SB(0, 0), cB, voffB); PG8_STAGE(PG8_SB(0, 1), cB + hstepB, voffB); PG8_STAGE(PG8_SA(0, 0), Abase, vc[0]); PG8_STAGE(PG8_SA(0, 1), Abase, vc[1]);
    if (wr == 1) PG8_BAR;
    PG8_WAIT_V(2); PG8_BAR;
    PG8_STAGE(PG8_SB(1, 0), cB + kstep, voffB); PG8_STAGE(PG8_SA(1, 0), Abase + kstep, vc[0]); PG8_STAGE(PG8_SB(1, 1), cB + hstepB + kstep, voffB);
    PG8_WAIT_V(6); PG8_BAR;
    for (;;) {
        const bool has_next = S.next(ui + 1, nxt);
        const char* nB = has_next ? S.b_base(nxt) : cB;
        if (has_next) { unsigned vn[2][2]; int tz = threadIdx.x; asm volatile("" : "+v"(tz)); S.a_voff(nxt, tz, vn); *(LAS u32x4*)(vslot + tz * 16) = (u32x4){vn[0][0], vn[0][1], vn[1][0], vn[1][1]}; }
#pragma unroll 1
        for (int t = 0; t < nt; t += 2) {
            const bool last = (t == nt - 2);
            const char* a1 = Abase + (size_t)(t + 1) * kstep;
            const char* a2 = last ? Abase : Abase + (size_t)(t + 2) * kstep; const char* b2 = last ? nB : cB + (size_t)(t + 2) * kstep;
            const char* a3 = a2 + kstep; const char* b3 = b2 + kstep;
            u32x4 vnx = (u32x4){vc[0][0], vc[0][1], vc[1][0], vc[1][1]};
            if (last && has_next) vnx = *(const LAS u32x4*)(vslot + tid * 16);
            PG8_LDB(B0, 0, 0); PG8_LDB(B1, 0, 1); PG8_SCHED; PG8_LDA(At, 0, 0); PG8_STAGE(PG8_SA(1, 1), a1, vc[1]);
            vc[0][0] = vnx[0]; vc[0][1] = vnx[1]; vc[1][0] = vnx[2]; vc[1][1] = vnx[3];
            PG8_WAIT_V(8); PG8_WAIT_L(0); PG8_BAR; PG8_MMA(0, 0, At, B0); PG8_MMA(0, 1, At, B1); PG8_BAR; PG8_SCHED;
            PG8_LDA(At, 0, 1); PG8_STAGE(PG8_SB(0, 0), b2, voffB); PG8_STAGE(PG8_SB(0, 1), b2 + hstepB, voffB); PG8_STAGE(PG8_SA(0, 0), a2, vc[0]);
            PG8_WAIT_V(8); PG8_WAIT_L(0); PG8_BAR; PG8_MMA(1, 0, At, B0); PG8_MMA(1, 1, At, B1); PG8_BAR; PG8_SCHED;
            PG8_LDB(B0, 1, 0); PG8_LDB(B1, 1, 1); PG8_SCHED; PG8_LDA(At, 1, 0); PG8_STAGE(PG8_SA(0, 1), a2, vc[1]);
            PG8_WAIT_V(8); PG8_WAIT_L(0); PG8_BAR; PG8_MMA(0, 0, At, B0); PG8_MMA(0, 1, At, B1); PG8_BAR; PG8_SCHED;
            PG8_LDA(At, 1, 1); PG8_STAGE(PG8_SB(1, 0), b3, voffB); PG8_STAGE(PG8_SB(1, 1), b3 + hstepB, voffB); PG8_STAGE(PG8_SA(1, 0), a3, vc[0]);
            PG8_WAIT_V(8); PG8_WAIT_L(0); PG8_BAR; PG8_MMA(1, 0, At, B0); PG8_MMA(1, 1, At, B1); PG8_BAR; PG8_SCHED;
        }
        if (wr == 0) PG8_BAR;
        { int tz = threadIdx.x; asm volatile("" : "+v"(tz)); const int ln = tz & 63; E(acc, cur, wr, wc, ln & 15, ln >> 4); }
        if (!has_next) break;
#pragma unroll
        for (int a = 0; a < 2; ++a)
#pragma unroll
            for (int b = 0; b < 2; ++b)
#pragma unroll
                for (int m = 0; m < 4; ++m)
#pragma unroll
                    for (int n = 0; n < 2; ++n) acc[a][b][m][n] = (f32x4){0.f, 0.f, 0.f, 0.f};
        cur = nxt; cB = nB; ++ui;
        if (wr == 1) PG8_BAR;
    }
    PG8_WAIT_V(0);
    PG8_BAR;
#undef PG8_SA
#undef PG8_SB
#undef PG8_STAGE
#undef PG8_LDA
#undef PG8_LDB
#undef PG8_MMA
#undef PG8_WAIT_V
#undef PG8_WAIT_L
#undef PG8_BAR
#undef PG8_SCHED
}
}
constexpr int NWAVES = 8, NTHR = 512;
constexpr int LDS_RING = 131072;
constexpr int LDS_TBL = LDS_RING;
constexpr int LDS_VOFF = LDS_TBL + 22528;
constexpr int LDS_MISC = LDS_VOFF + 8192;
constexpr int LDS_BYTES = 162304;

struct Params {
    const float* x; const int* pos; const float* w_in; const float* q_norm; const float* w_uq; const float* kv_norm; const float* w_ukv; const float* w_out;
    const float* ln1_g; const float* ln1_b; const float* router_w; const float* router_b; const float* w1; const float* w3; const float* w2;
    const float* sw1; const float* sw3; const float* sw2; const float* ln2_g; const float* ln2_b; const float* rel_bias;
    float* out; unsigned char* ws;
    int ph_lo, ph_hi;
};

struct Frame {
    LAS unsigned char* lds; volatile LAS unsigned* MISC; unsigned* ctl;
    int tid, lane, wave, G, vcu;
    unsigned char* ws;
};
#define FP(name, type, off) __device__ __forceinline__ type* name(const Frame& F) { return (type*)(F.ws + (off)); }
FP(fWin, bf16_t, WS_W + W_IN) FP(fWuq, bf16_t, WS_W + W_UQ) FP(fWukv, bf16_t, WS_W + W_UKV) FP(fWout, bf16_t, WS_W + W_OUT) FP(fWr, bf16_t, WS_W + W_R) FP(fW13, bf16_t, WS_W + W_13) FP(fW2, bf16_t, WS_W + W_2)
FP(fSH, bf16_t, WS_XF) FP(fXB, bf16_t, WS_XB) FP(fH, bf16_t, WS_H) FP(fLST, unsigned, WS_LST) FP(fPK, unsigned, WS_GATE) FP(fGS, float, WS_XF + 64 * MiB) FP(fROPE, float, WS_ROPE) FP(fDTAB, float, WS_DTAB)
FP(fU, bf16_t, WS_R + R_U) FP(fMQ, bf16_t, WS_R + R_MQ) FP(fMK, bf16_t, WS_R + R_MK) FP(fMV, bf16_t, WS_R + R_MV) FP(fKR, bf16_t, WS_R + R_KR) FP(fAO, bf16_t, WS_R + R_AO)
FP(fMASK, unsigned, WS_R + R_MASK) FP(fSCR, float, WS_R + R_SCR) FP(fLG, float, WS_R + R_LG) FP(fYB, unsigned char, WS_R)
__device__ __forceinline__ Frame phase_frame(const Frame& F0) { Frame F = F0; int tz = threadIdx.x; asm volatile("" : "+v"(tz)); F.tid = tz; F.lane = tz & 63; return F; }

struct MapIn  { __device__ int row(int n) const { return n < 2504 ? n : n + 56; }   __device__ float sc(int k, int n) const { return (n < 384 || (n >= 1152 && n < 1408)) ? QSCALE : 1.0f; } };
struct MapUq  { const float* g; __device__ int row(int n) const { return n; }         __device__ float sc(int k, int n) const { return g[k] * MLA_QSCALE; } };
struct MapUkv { const float* g; __device__ int row(int n) const { const int h = n >> 7, c = n & 127; return c < 64 ? h * 64 + c : 384 + h * 64 + (c - 64); } __device__ float sc(int k, int n) const { return g[k]; } };
struct MapId  { __device__ int row(int n) const { return n; }                         __device__ float sc(int k, int n) const { return 1.0f; } };
struct MapW13 { int add; __device__ int row(int f) const { return 32 * (f >> 4) + (f & 15) + add; } __device__ float sc(int k, int n) const { return 1.0f; } };

template <class MAP>
__device__ __forceinline__ void tr_item(const float* W, int N, int kb, int nb, bf16_t* WT, int ldk, const MAP map, LAS float* scr, int lane) {
    const int k0 = 64 * kb, n0 = 32 * nb;
    const int nq = n0 + 4 * (lane & 7); const bool ok = nq < N;
    f32x4 w4[8];
#pragma unroll
    for (int i = 0; i < 8; ++i) { const int kk = 8 * i + (lane >> 3); w4[i] = ok ? __builtin_nontemporal_load((const f32x4*)(W + (size_t)(k0 + kk) * N + nq)) : (f32x4){0.f, 0.f, 0.f, 0.f}; }
#pragma unroll
    for (int i = 0; i < 8; ++i) { const int kk = 8 * i + (lane >> 3);
#pragma unroll
        for (int j = 0; j < 4; ++j) scr[kk * 33 + 4 * (lane & 7) + j] = w4[i][j] * map.sc(k0 + kk, nq + j); }
    LDS_WAIT(); asm volatile("" ::: "memory");
    const int c = lane & 7;
#pragma unroll
    for (int j = 0; j < 4; ++j) { const int n = (lane >> 3) + 8 * j; const LAS float* s = scr + (8 * c) * 33 + n;
        u32x4 o; o.x = cvt_pk(s[0 * 33], s[1 * 33]); o.y = cvt_pk(s[2 * 33], s[3 * 33]); o.z = cvt_pk(s[4 * 33], s[5 * 33]); o.w = cvt_pk(s[6 * 33], s[7 * 33]);
        if (n0 + n < N) *(u32x4*)(WT + (size_t)map.row(n0 + n) * ldk + k0 + 8 * c) = o; }
    LDS_WAIT(); asm volatile("" ::: "memory");
}

__device__ __forceinline__ void zero_rows(bf16_t* base, int row0, int nrows, int ldk, int k0, int kn, int gt, int ngt) {
    const int per = kn / 8; const int total = nrows * per;
    for (int i = gt; i < total; i += ngt) { const int r = i / per, c = i % per; *(u32x4*)(base + (size_t)(row0 + r) * ldk + k0 + 8 * c) = (u32x4){0u, 0u, 0u, 0u}; }
}

__device__ __forceinline__ void convert_small(const Frame& F, const Params& p, int l) {
    LAS float* scr = (LAS float*)(F.lds + F.wave * 16384);
    const int gw = F.vcu * NWAVES + F.wave, NGW = F.G * NWAVES;
    constexpr int I_IN = 16 * 92, I_UQ = 4 * 18, I_UKV = 2 * 24, I_OUT = 16 * 32, I_R = 16 * 2;
    constexpr int NIT = I_IN + I_UQ + I_UKV + I_OUT + I_R;
    const float* w_in = p.w_in + (size_t)l * 1024 * IN_W;
    const float* w_uq = p.w_uq + (size_t)l * 256 * 576; const float* w_ukv = p.w_ukv + (size_t)l * 128 * 768;
    const float* w_out = p.w_out + (size_t)l * 1024 * 1024; const float* rw = p.router_w + (size_t)l * 1024 * 64;
    for (int it = gw; it < NIT; it += NGW) {
        int r = it;
        if (r < I_IN) { tr_item(w_in, IN_W, r / 92, r % 92, fWin(F), 1024, MapIn{}, scr, F.lane); continue; } r -= I_IN;
        if (r < I_UQ) { tr_item(w_uq, 576, r / 18, r % 18, fWuq(F), 256, MapUq{p.q_norm + l * 256}, scr, F.lane); continue; } r -= I_UQ;
        if (r < I_UKV) { tr_item(w_ukv, 768, r / 24, r % 24, fWukv(F), 256, MapUkv{p.kv_norm + l * 128}, scr, F.lane); continue; } r -= I_UKV;
        if (r < I_OUT) { tr_item(w_out, 1024, r / 32, r % 32, fWout(F), 1024, MapId{}, scr, F.lane); continue; } r -= I_OUT;
        tr_item(rw, 64, r / 2, r % 2, fWr(F), 1024, MapId{}, scr, F.lane);
    }
    const int gt = F.vcu * NTHR + F.tid, ngt = F.G * NTHR;
    zero_rows(fWin(F), 2504, 56, 1024, 0, 1024, gt, ngt); zero_rows(fWin(F), 2976, 96, 1024, 0, 1024, gt, ngt);
    zero_rows(fWuq(F), 576, 192, 256, 0, 256, gt, ngt);
    zero_rows(fWukv(F), 0, 768, 256, 128, 128, gt, ngt);
    zero_rows(fWr(F), 64, 192, 1024, 0, 1024, gt, ngt);
}
__device__ __forceinline__ void convert_experts(const Frame& F, const Params& p, int l, int k0, int k1, int scr_off) {
    LAS float* scr = (LAS float*)(F.lds + scr_off + F.wave * 8448);
    const int gw = F.vcu * NWAVES + F.wave, NGW = F.G * NWAVES;
    constexpr int I_E1 = 16 * 8, I_E2 = 4 * 32, I_EXP = 2 * I_E1 + I_E2, NIT = 65 * I_EXP;
    for (int k = k0; k < k1; ++k) { const int it = gw + k * NGW; if (it >= NIT) break;
        const int e = it / I_EXP; int r = it - e * I_EXP;
        const float *s1, *s3, *s2;
        if (e < 64) { s1 = p.w1 + ((size_t)l * 64 + e) * 1024 * 256; s3 = p.w3 + ((size_t)l * 64 + e) * 1024 * 256; s2 = p.w2 + ((size_t)l * 64 + e) * 256 * 1024; }
        else { s1 = p.sw1 + (size_t)l * 1024 * 256; s3 = p.sw3 + (size_t)l * 1024 * 256; s2 = p.sw2 + (size_t)l * 256 * 1024; }
        bf16_t* d13 = fW13(F) + (size_t)e * 512 * 1024; bf16_t* d2 = fW2(F) + (size_t)e * 1024 * 256;
        if (r < I_E1) { tr_item(s1, 256, r / 8, r % 8, d13, 1024, MapW13{0}, scr, F.lane); continue; } r -= I_E1;
        if (r < I_E1) { tr_item(s3, 256, r / 8, r % 8, d13, 1024, MapW13{16}, scr, F.lane); continue; } r -= I_E1;
        tr_item(s2, 1024, r / 32, r % 32, d2, 256, MapId{}, scr, F.lane);
    }
}

typedef f32x4 Acc[2][2][4][2];
#define EPI_ROWS(ai, m) for (int ai = 0; ai < 2; ++ai) for (int m = 0; m < 4; ++m)

struct EpiU {
    static constexpr int PERM = 2; bf16_t* U;
    __device__ __forceinline__ void operator()(const Acc& acc, const pg8::Unit& u, int wr, int wc, int fr, int fq) const {
#pragma unroll
        EPI_ROWS(ai, m) { bf16_t* rowp = U + (size_t)(u.pm * 256 + ai * 128 + wr * 64 + m * 16 + fr) * LDU + u.pn * 256 + wc * 64 + 8 * fq;
#pragma unroll
            for (int bj = 0; bj < 2; ++bj) { const f32x4 a = acc[ai][bj][m][0], b = acc[ai][bj][m][1];
                *(u32x4*)(rowp + bj * 32) = (u32x4){cvt_pk(a[0], a[1]), cvt_pk(a[2], a[3]), cvt_pk(b[0], b[1]), cvt_pk(b[2], b[3])}; } }
    }
};
struct EpiQup {
    static constexpr int PERM = 0; bf16_t* MQ; const LAS float* tbl; const float* rope;
    __device__ __forceinline__ void operator()(const Acc& acc, const pg8::Unit& u, int wr, int wc, int fr, int fq) const {
#pragma unroll
        EPI_ROWS(ai, m) { const int rl = ai * 128 + wr * 64 + m * 16 + fr, row = u.pm * 256 + rl; const float rs = tbl[u.seq * 256 + rl];
#pragma unroll
            for (int bj = 0; bj < 2; ++bj) { const int c0 = u.pn * 256 + bj * 128 + wc * 32; f32x4 a = acc[ai][bj][m][0] * rs, b = acc[ai][bj][m][1] * rs;
                if (((c0 >> 5) % 3) == 2) {
                    const f32x4 cs = *(const f32x4*)(rope + (size_t)row * 32 + 4 * fq), sn = *(const f32x4*)(rope + (size_t)row * 32 + 16 + 4 * fq);
                    const f32x4 x1 = a, x2 = b; a = x1 * cs - x2 * sn; b = x2 * cs + x1 * sn; }
                if (c0 < 576) { bf16_t* o = MQ + (size_t)row * 576 + c0 + 4 * fq; *(u32x2*)o = (u32x2){cvt_pk(a[0], a[1]), cvt_pk(a[2], a[3])}; *(u32x2*)(o + 16) = (u32x2){cvt_pk(b[0], b[1]), cvt_pk(b[2], b[3])}; } }
            asm volatile("" ::: "memory"); }
    }
};
struct EpiKVup {
    static constexpr int PERM = 1; bf16_t* MK; bf16_t* MV; const LAS float* tbl;
    __device__ __forceinline__ void operator()(const Acc& acc, const pg8::Unit& u, int wr, int wc, int fr, int fq) const {
#pragma unroll
        EPI_ROWS(ai, m) { const int rl = ai * 128 + wr * 64 + m * 16 + fr, row = u.pm * 256 + rl; const float rs = tbl[u.seq * 256 + rl];
#pragma unroll
            for (int bj = 0; bj < 2; ++bj) { const int c = u.pn * 256 + bj * 128 + wc * 32 + 8 * fq; const f32x4 a = acc[ai][bj][m][0] * rs, b = acc[ai][bj][m][1] * rs;
                bf16_t* o = c < 384 ? MK + (size_t)row * 384 + c : MV + (size_t)row * 384 + (c - 384);
                *(u32x4*)o = (u32x4){cvt_pk(a[0], a[1]), cvt_pk(a[2], a[3]), cvt_pk(b[0], b[1]), cvt_pk(b[2], b[3])}; } }
    }
};
struct EpiResB {
    static constexpr int PERM = 2; bf16_t* X;
    __device__ __forceinline__ void operator()(const Acc& acc, const pg8::Unit& u, int wr, int wc, int fr, int fq) const {
        u32x4 r[2][4][2];
#pragma unroll
        EPI_ROWS(ai, m) { const bf16_t* rowp = X + (size_t)(u.pm * 256 + ai * 128 + wr * 64 + m * 16 + fr) * 1024 + u.pn * 256 + wc * 64 + 8 * fq;
            r[ai][m][0] = *(const u32x4*)rowp; r[ai][m][1] = *(const u32x4*)(rowp + 32); }
#pragma unroll
        EPI_ROWS(ai, m) { bf16_t* rowp = X + (size_t)(u.pm * 256 + ai * 128 + wr * 64 + m * 16 + fr) * 1024 + u.pn * 256 + wc * 64 + 8 * fq;
#pragma unroll
            for (int bj = 0; bj < 2; ++bj) { const f32x4 a = acc[ai][bj][m][0], b = acc[ai][bj][m][1]; const u32x4 q = r[ai][m][bj];
                *(u32x4*)(rowp + bj * 32) = (u32x4){cvt_pk(DN_ALPHA * bf2f(q[0] & 0xffffu) + a[0], DN_ALPHA * bf2f(q[0] >> 16) + a[1]), cvt_pk(DN_ALPHA * bf2f(q[1] & 0xffffu) + a[2], DN_ALPHA * bf2f(q[1] >> 16) + a[3]),
                                                       cvt_pk(DN_ALPHA * bf2f(q[2] & 0xffffu) + b[0], DN_ALPHA * bf2f(q[2] >> 16) + b[1]), cvt_pk(DN_ALPHA * bf2f(q[3] & 0xffffu) + b[2], DN_ALPHA * bf2f(q[3] >> 16) + b[3])}; } }
    }
};
struct EpiSH {
    static constexpr int PERM = 2; bf16_t* SH;
    __device__ __forceinline__ void operator()(const Acc& acc, const pg8::Unit& u, int wr, int wc, int fr, int fq) const {
#pragma unroll
        EPI_ROWS(ai, m) { bf16_t* rowp = SH + (size_t)(u.pm * 256 + ai * 128 + wr * 64 + m * 16 + fr) * 1024 + u.pn * 256 + wc * 64 + 8 * fq;
#pragma unroll
            for (int bj = 0; bj < 2; ++bj) { const f32x4 a = acc[ai][bj][m][0], b = acc[ai][bj][m][1];
                *(u32x4*)(rowp + bj * 32) = (u32x4){cvt_pk(a[0], a[1]), cvt_pk(a[2], a[3]), cvt_pk(b[0], b[1]), cvt_pk(b[2], b[3])}; } }
    }
};
struct EpiLogit {
    static constexpr int PERM = 0; float* LG;
    __device__ __forceinline__ void operator()(const Acc& acc, const pg8::Unit& u, int wr, int wc, int fr, int fq) const {
        if (wc >= 2) return;
#pragma unroll
        EPI_ROWS(ai, m) { float* o = LG + ((size_t)u.pn * T + (u.pm * 256 + ai * 128 + wr * 64 + m * 16 + fr)) * 64 + wc * 32 + 4 * fq;
            *(f32x4*)o = acc[ai][0][m][0]; *(f32x4*)(o + 16) = acc[ai][0][m][1]; }
    }
};
__device__ __forceinline__ float silu_f(float v) { return v / (1.0f + __expf(-v)); }
struct EpiG1 {
    static constexpr int PERM = 0; bf16_t* H; const float* GS; const LAS int* cnt; int shared_base; const LAS int* cb;
    __device__ __forceinline__ void operator()(const Acc& acc, const pg8::Unit& u, int wr, int wc, int fr, int fq) const {
        float g[2][4]; const int n = GS ? cnt[u.e] : 0x7fffffff;
#pragma unroll
        EPI_ROWS(ai, m) { const int idx = u.pm * 256 + ai * 128 + wr * 64 + m * 16 + fr; g[ai][m] = GS ? (idx < n ? GS[(size_t)u.e * T + idx] : 0.f) : 1.0f; }
#pragma unroll
        EPI_ROWS(ai, m) { const int idx = u.pm * 256 + ai * 128 + wr * 64 + m * 16 + fr; const float gg = g[ai][m];
            const f32x4 a0 = acc[ai][0][m][0], b0 = acc[ai][0][m][1] * gg, a1 = acc[ai][1][m][0], b1 = acc[ai][1][m][1] * gg;
            const auto lo = __builtin_amdgcn_permlane16_swap(cvt_pk(silu_f(a0[0]) * b0[0], silu_f(a0[1]) * b0[1]), cvt_pk(silu_f(a1[0]) * b1[0], silu_f(a1[1]) * b1[1]), false, false);
            const auto hi = __builtin_amdgcn_permlane16_swap(cvt_pk(silu_f(a0[2]) * b0[2], silu_f(a0[3]) * b0[3]), cvt_pk(silu_f(a1[2]) * b1[2], silu_f(a1[3]) * b1[3]), false, false);
            if (idx >= n) continue;
            const size_t hr = GS ? (size_t)(cb[u.e] + idx) : (size_t)(shared_base + idx);
            bf16_t* o = H + hr * 256 + u.pn * 128 + wc * 16 + 4 * (fq & ~1) + (fq & 1) * 64;
            *(u32x4*)o = (u32x4){lo[0], hi[0], lo[1], hi[1]}; }
    }
};
constexpr float YB_SCALE = 64.0f;
__device__ __forceinline__ unsigned pk_fp8x4(float a, float b, float c, float d) {
    a = __builtin_amdgcn_fmed3f(a, -448.f, 448.f); b = __builtin_amdgcn_fmed3f(b, -448.f, 448.f); c = __builtin_amdgcn_fmed3f(c, -448.f, 448.f); d = __builtin_amdgcn_fmed3f(d, -448.f, 448.f);
    int p = __builtin_amdgcn_cvt_pk_fp8_f32(a, b, 0, false); p = __builtin_amdgcn_cvt_pk_fp8_f32(c, d, p, true); return (unsigned)p; }
struct EpiG2 {
    static constexpr int PERM = 1; unsigned char* YB; const LAS int* cnt; const LAS int* cb;
    __device__ __forceinline__ void operator()(const Acc& acc, const pg8::Unit& u, int wr, int wc, int fr, int fq) const {
        const int n = cnt[u.e];
#pragma unroll
        EPI_ROWS(ai, m) { const int idx = u.pm * 256 + ai * 128 + wr * 64 + m * 16 + fr;
            const f32x4 a0 = acc[ai][0][m][0] * YB_SCALE, b0 = acc[ai][0][m][1] * YB_SCALE, a1 = acc[ai][1][m][0] * YB_SCALE, b1 = acc[ai][1][m][1] * YB_SCALE;
            const auto lo = __builtin_amdgcn_permlane16_swap(pk_fp8x4(a0[0], a0[1], a0[2], a0[3]), pk_fp8x4(a1[0], a1[1], a1[2], a1[3]), false, false);
            const auto hi = __builtin_amdgcn_permlane16_swap(pk_fp8x4(b0[0], b0[1], b0[2], b0[3]), pk_fp8x4(b1[0], b1[1], b1[2], b1[3]), false, false);
            if (idx >= n) continue;
            unsigned char* o = YB + (size_t)(cb[u.e] + idx) * 1024 + u.pn * 256 + wc * 32 + 8 * (fq & ~1) + (fq & 1) * 128;
            *(u32x4*)o = (u32x4){lo[0], hi[0], lo[1], hi[1]}; }
    }
};

struct MoeOrder {
    const LAS int* cnt; const LAS int* ubase;
    int npn, total, G, c; const unsigned* LST; int shift  ; unsigned lda; const LAS int* cb; const char* Bt; size_t bexp  ; unsigned ldb;
    __device__ __forceinline__ bool next(int i, pg8::Unit& u) const {
        const long L = (long)i * G + c; if (L >= total) return false;
        const int w = pg8::xcd_remap((int)L, total);
        int lo = 0, hi = 64;
        while (hi - lo > 1) { const int mid = (lo + hi) >> 1; if (ubase[mid] <= w) lo = mid; else hi = mid; }
        const int loc = w - ubase[lo]; u.e = lo; u.pn = loc % npn; u.pm = loc / npn; u.seq = i; return true;
    }
    __device__ __forceinline__ void a_voff(const pg8::Unit& u, int tid, unsigned (&v)[2][2]) const {
        const int n = cnt[u.e];
#pragma unroll
        for (int i = 0; i < 2; ++i) { int R, C; pg8::stage_rc(tid * 16 + i * 8192, R, C);
#pragma unroll
            for (int h = 0; h < 2; ++h) { int idx = u.pm * 256 + h * 128 + R; idx = idx < n ? idx : 0;
                if (shift < 0) { v[h][i] = ((unsigned)(cb[u.e] + idx) * lda + (unsigned)C) * 2u; }
                else { const unsigned ent = LST[(size_t)u.e * T + idx];
                    v[h][i] = ((ent >> shift) * lda + (unsigned)C) * 2u; } } }
    }
    __device__ __forceinline__ const char* b_base(const pg8::Unit& u) const { return Bt + (size_t)u.e * bexp + (size_t)u.pn * 256 * ldb * 2; }
};
struct RouterOrder {
    int G, c; const char* Bt;
    __device__ __forceinline__ bool next(int i, pg8::Unit& u) const { const long L = (long)i * G + c; if (L >= 256) return false; u.pm = (int)L >> 1; u.pn = (int)L & 1; u.e = 0; u.seq = i; return true; }
    __device__ __forceinline__ void a_voff(const pg8::Unit& u, int tid, unsigned (&v)[2][2]) const {
#pragma unroll
        for (int i = 0; i < 2; ++i) { int R, C; pg8::stage_rc(tid * 16 + i * 8192, R, C);
#pragma unroll
            for (int h = 0; h < 2; ++h) v[h][i] = ((unsigned)(u.pm * 256 + h * 128 + R) * 1024u + (unsigned)(u.pn * 512 + C)) * 2u; }
    }
    __device__ __forceinline__ const char* b_base(const pg8::Unit& u) const { return Bt + (size_t)u.pn * 512 * 2; }
};

__device__ __forceinline__ void phase_x_to_xb(const Frame& F, const float* x) {
    const size_t n8 = (size_t)T * 1024 / 8;
    for (size_t i = (size_t)F.vcu * NTHR + F.tid; i < n8; i += (size_t)F.G * NTHR) {
        const f32x4 a = __builtin_nontemporal_load((const f32x4*)(x + i * 8)), b = __builtin_nontemporal_load((const f32x4*)(x + i * 8 + 4));
        *(u32x4*)(fXB(F) + i * 8) = (u32x4){cvt_pk(a[0], a[1]), cvt_pk(a[2], a[3]), cvt_pk(b[0], b[1]), cvt_pk(b[2], b[3])};
    }
}

__device__ __forceinline__ void phase_rope_table(const Frame& F, const int* pos) {
    for (int i = F.vcu * NTHR + F.tid; i < T * 16; i += F.G * NTHR) { const int t = i >> 4, j = i & 15;
        const double inv = exp2(-(double)j * (13.287712379549449 / 16.0));
        const double rev = (double)pos[t] * inv * 0.15915494309189535; const float fr = (float)(rev - floor(rev));
        fROPE(F)[(size_t)t * 32 + j] = __builtin_amdgcn_cosf(fr); fROPE(F)[(size_t)t * 32 + 16 + j] = __builtin_amdgcn_sinf(fr); }
}

__device__ __forceinline__ void phase_inproj(const Frame& F) {
    pg8::DenseOrder S; S.init(T, LDU, F.G, (int)blockIdx.x, 1024, 0, fWin(F), 1024);
    EpiU E{fU(F)};
    pg8::gemm_phase<EpiU, pg8::DenseOrder>(F.lds, F.lds + LDS_VOFF, (const char*)fXB(F), 1024, 1024, S, E);
}

template <int WIDTH>
__device__ __forceinline__ void rms_tables(const Frame& F, const pg8::DenseOrder& S, LAS float* tbl, int col0) {
    pg8::Unit u;
    for (int i = 0; i < 4 && S.next(i, u); ++i) {
        const int r = F.tid >> 1, hf = F.tid & 1; const bf16_t* xr = fU(F) + (size_t)(u.pm * 256 + r) * LDU + col0 + hf * (WIDTH / 2);
        u32x4 v[WIDTH / 16];
#pragma unroll
        for (int c = 0; c < WIDTH / 16; ++c) v[c] = *(const u32x4*)(xr + 8 * c);
        float ss = 0.f;
#pragma unroll
        for (int c = 0; c < WIDTH / 16; ++c)
#pragma unroll
            for (int j = 0; j < 4; ++j) { const float lo = bf2f(v[c][j] & 0xffffu), hi = bf2f(v[c][j] >> 16); ss += lo * lo + hi * hi; }
        ss += __shfl_xor(ss, 1);
        if (hf == 0) tbl[i * 256 + r] = 1.0f / sqrtf(ss / (float)WIDTH + RMS_EPS);
    }
}

__device__ __forceinline__ void phase_mla_up(const Frame& F, const Params& p) {
    LAS float* tq = (LAS float*)(F.lds + LDS_TBL); LAS float* tkv = tq + 1024;
    pg8::DenseOrder Sq; Sq.init(T, 768, F.G, (int)blockIdx.x, LDU, U_CQ, fWuq(F), 256);
    pg8::DenseOrder Sk; Sk.init(T, 768, F.G, (int)blockIdx.x, LDU, U_CKV, fWukv(F), 256);
    rms_tables<256>(F, Sq, tq, U_CQ); rms_tables<128>(F, Sk, tkv, U_CKV);
    __syncthreads();
    { EpiQup E{fMQ(F), tq, fROPE(F)}; pg8::gemm_phase<EpiQup, pg8::DenseOrder>(F.lds, F.lds + LDS_VOFF, (const char*)fU(F), 256, 256, Sq, E); }
    { EpiKVup E{fMK(F), fMV(F), tkv}; pg8::gemm_phase<EpiKVup, pg8::DenseOrder>(F.lds, F.lds + LDS_VOFF, (const char*)fU(F), 256, 256, Sk, E); }
    for (int i = F.vcu * NTHR + F.tid; i < T * 16; i += F.G * NTHR) { const int t = i >> 4, j = i & 15;
        const float x1 = bf2f(fU(F)[(size_t)t * LDU + U_KR + j]), x2 = bf2f(fU(F)[(size_t)t * LDU + U_KR + 16 + j]);
        const float cs = fROPE(F)[(size_t)t * 32 + j], sn = fROPE(F)[(size_t)t * 32 + 16 + j];
        fKR(F)[(size_t)t * 32 + j] = (bf16_t)f2bf(x1 * cs - x2 * sn); fKR(F)[(size_t)t * 32 + 16 + j] = (bf16_t)f2bf(x2 * cs + x1 * sn); }
}

__device__ __forceinline__ void phase_outproj(const Frame& F) {
    pg8::DenseOrder S; S.init(T, 1024, F.G, (int)blockIdx.x, 1024, 0, fWout(F), 1024);
    EpiResB E{fXB(F)};
    pg8::gemm_phase<EpiResB, pg8::DenseOrder>(F.lds, F.lds + LDS_VOFF, (const char*)fAO(F), 1024, 1024, S, E);
}

__device__ __forceinline__ void phase_router_sharedg1(const Frame& F) {
    { RouterOrder S{F.G, (int)blockIdx.x, (const char*)fWr(F)}; EpiLogit E{fLG(F)}; pg8::gemm_phase<EpiLogit, RouterOrder>(F.lds, F.lds + LDS_VOFF, (const char*)fXB(F), 512, 1024, S, E); }
    { pg8::DenseOrder S; S.init(T, 512, F.G, (int)blockIdx.x, 1024, 0, fW13(F) + (size_t)64 * 512 * 1024, 1024);
      EpiG1 E{fH(F), nullptr, nullptr, T * 8, nullptr}; pg8::gemm_phase<EpiG1, pg8::DenseOrder>(F.lds, F.lds + LDS_VOFF, (const char*)fXB(F), 1024, 1024, S, E); }
}

__device__ __forceinline__ void phase_shared_g2(const Frame& F) {
    pg8::DenseOrder S; S.init(T, 1024, F.G, (int)blockIdx.x, 256, 0, fW2(F) + (size_t)64 * 1024 * 256, 256);
    EpiSH E{fSH(F)};
    pg8::gemm_phase<EpiSH, pg8::DenseOrder>(F.lds, F.lds + LDS_VOFF, (const char*)(fH(F) + (size_t)T * 8 * 256), 256, 256, S, E);
}

__device__ __forceinline__ void moe_tables(const Frame& F, int l, int npn, LAS int*& cnt, LAS int*& ubase) {
    cnt = (LAS int*)(F.lds + LDS_TBL); ubase = cnt + 64;
    __syncthreads();
    if (F.tid < 64) cnt[F.tid] = (int)F.ctl[CW_CNT + l * 64 + F.tid];
    __syncthreads();
    if (F.tid == 0) { int s = 0, c = 0; for (int e = 0; e < 64; ++e) { ubase[e] = s; s += ((cnt[e] + 255) >> 8) * npn; ubase[65 + e] = c; c += cnt[e]; } ubase[64] = s; }
    __syncthreads();
}
__device__ __forceinline__ void phase_moe_g1(const Frame& F, int l) {
    LAS int *cnt, *ubase; moe_tables(F, l, 2, cnt, ubase);
    MoeOrder S{cnt, ubase, 2, ubase[64], F.G, (int)blockIdx.x, fLST(F), 0, 1024u, ubase + 65, (const char*)fW13(F), (size_t)512 * 1024 * 2, 1024u};
    EpiG1 E{fH(F), fGS(F), cnt, 0, ubase + 65};
    pg8::gemm_phase<EpiG1, MoeOrder>(F.lds, F.lds + LDS_VOFF, (const char*)fXB(F), 1024, 1024, S, E);
}
__device__ __forceinline__ void phase_moe_g2(const Frame& F, int l) {
    LAS int *cnt, *ubase; moe_tables(F, l, 4, cnt, ubase);
    MoeOrder S{cnt, ubase, 4, ubase[64], F.G, (int)blockIdx.x, fLST(F), -1, 256u, ubase + 65, (const char*)fW2(F), (size_t)1024 * 256 * 2, 256u};
    EpiG2 E{fYB(F), cnt, ubase + 65};
    pg8::gemm_phase<EpiG2, MoeOrder>(F.lds, F.lds + LDS_VOFF, (const char*)fH(F), 256, 256, S, E);
}
constexpr int AT_K0 = 0, AT_KSZ = 12288, AT_V0 = 2 * AT_KSZ, AT_VSZ = 8192, AT_TBL = AT_V0 + 2 * AT_VSZ;

__device__ __forceinline__ float t5_dist_bias(const float* rel_bias, int head10, int d) {
    int bk;
    if (d < 16) bk = d;
    else { const float v = logf((float)d / 16.0f) / 4.852030263919617f * 16.0f; bk = 16 + (int)v; bk = bk < 31 ? bk : 31; }
    return rel_bias[bk * 10 + head10];
}

__device__ __forceinline__ void phase_dist_tables(const Frame& F, const float* rel_bias) {
    for (int i = F.vcu * NTHR + F.tid; i < 10 * 2112; i += F.G * NTHR) { const int h = i / 2112, e = i % 2112, d = e - 64; float v;
        if (h < 6) { const int mlt = (d <= 128 ? 1 : 0) + (((d & 3) == 0 && d <= 512) ? 1 : 0) + (((d & 15) == 0) ? 1 : 0);
            v = (d >= 0 && mlt) ? (t5_dist_bias(rel_bias, h, d) + logf((float)mlt)) * LOG2E : -INFINITY; }
        else v = d >= 0 ? t5_dist_bias(rel_bias, h, d) * LOG2E : 0.f;
        fDTAB(F)[i] = v; }
}

template <int MODE, int KS>
__device__ __forceinline__ void attn_unit(const Frame& F, const int b, const int qb,
                                          const bf16_t* __restrict__ Qp, const int ldq, const bf16_t* __restrict__ Kp, const int ldk, const bf16_t* __restrict__ KRp,
                                          const bf16_t* __restrict__ Vp, const int ldv, bf16_t* __restrict__ Op, const unsigned* __restrict__ maskp, const float* dtab, const int head10) {
    LAS unsigned char* lds = F.lds;
    const int tid = F.tid, lane = F.lane, w = F.wave, q32 = lane & 31, hh = lane >> 5;
    const size_t tb = (size_t)b * SEQ;
    const int qw0 = qb * 256 + 32 * w, qpos = qw0 + q32;
    const int ntile = 4 * (qb + 1);
    __syncthreads();
    if (MODE != 0) {
        LAS float* tblw = (LAS float*)(lds + AT_TBL); const float* src = dtab + head10 * 2112;
        for (int i = tid; i < SEQ + 64; i += NTHR) tblw[i] = src[i];
    }
    bf16x8 qf[KS];
    { const bf16_t* qr = Qp + (tb + qpos) * (size_t)ldq + 8 * hh;
#pragma unroll
      for (int ks = 0; ks < KS; ++ks) { if (MODE == 0 && ks >= 4) qf[ks] = *(const bf16x8*)(qr + 16 * ks); else qf[ks] = *(const bf16x8*)(qr + 16 * ks); } }
    const int skey = tid >> 3, sch = tid & 7;
    const bf16_t* kg = Kp + (tb + skey) * (size_t)ldk + 8 * sch;
    const bf16_t* vg = Vp + (tb + skey) * (size_t)ldv + 8 * sch;
    const bf16_t* rg = (MODE == 0) ? KRp + (tb + (tid >> 2)) * 32 + 8 * (tid & 3) : nullptr;
    const int kdst = sch * 1024 + ((skey ^ sch) << 4);
    const int rdst = (8 + (tid & 3)) * 1024 + ((((tid >> 2) & 63) ^ (tid & 3)) << 4);
    const int vdst = (sch >> 2) * 4096 + skey * 64 + (sch & 3) * 16;
    const unsigned* mg = (MODE == 1) ? maskp + (tb + qpos) * 64 : nullptr;
    u32x4 kreg, vreg, rreg; u32x2 mw = {0u, 0u}, mwn = {0u, 0u};
    kreg = *(const u32x4*)kg; vreg = *(const u32x4*)vg; if (MODE == 0 && tid < 256) rreg = *(const u32x4*)rg;
    if (MODE == 1) mw = *(const u32x2*)mg;
    *(LAS u32x4*)(lds + AT_K0 + kdst) = kreg; *(LAS u32x4*)(lds + AT_V0 + vdst) = vreg; if (MODE == 0 && tid < 256) *(LAS u32x4*)(lds + AT_K0 + rdst) = rreg;
    __syncthreads();
    f32x16 o0, o1;
#pragma unroll
    for (int r = 0; r < 16; ++r) { o0[r] = 0.f; o1[r] = 0.f; }
    float lsum = 0.f; bool started = false;
    f32x16 negm;
#pragma unroll
    for (int r = 0; r < 16; ++r) negm[r] = 0.f;
    const LAS float* tbl = (const LAS float*)(lds + AT_TBL);
    for (int t = 0; t < ntile; ++t) {
        const int buf = t & 1;
        if (t + 1 < ntile) { kreg = *(const u32x4*)(kg + (size_t)(t + 1) * 64 * ldk); vreg = *(const u32x4*)(vg + (size_t)(t + 1) * 64 * ldv);
            if (MODE == 0 && tid < 256) rreg = *(const u32x4*)(rg + (size_t)(t + 1) * 64 * 32);
            if (MODE == 1) mwn = *(const u32x2*)(mg + 2 * (t + 1)); }
        const int k0 = 64 * t;
        if (k0 <= qw0 + 31) {
            const LAS unsigned char* kb = lds + AT_K0 + buf * AT_KSZ; const LAS unsigned char* vb = lds + AT_V0 + buf * AT_VSZ;
            f32x16 s0, s1;
#pragma unroll
            for (int ks = 0; ks < KS; ++ks) { const int c = 2 * ks + hh;
                const bf16x8 a0 = *(const LAS bf16x8*)(kb + c * 1024 + ((q32 ^ (c & 7)) << 4));
                const bf16x8 a1 = *(const LAS bf16x8*)(kb + c * 1024 + (((32 + q32) ^ (c & 7)) << 4));
                if (ks == 0) { s0 = __builtin_amdgcn_mfma_f32_32x32x16_bf16(a0, qf[0], negm, 0, 0, 0); s1 = __builtin_amdgcn_mfma_f32_32x32x16_bf16(a1, qf[0], negm, 0, 0, 0); }
                else { s0 = __builtin_amdgcn_mfma_f32_32x32x16_bf16(a0, qf[ks], s0, 0, 0, 0); s1 = __builtin_amdgcn_mfma_f32_32x32x16_bf16(a1, qf[ks], s1, 0, 0, 0); } }
            if (MODE == 0) { if (k0 + 63 > qw0) {
#pragma unroll
                for (int r = 0; r < 16; ++r) { const int key = k0 + (r & 3) + 8 * (r >> 2) + 4 * hh; if (key > qpos) s0[r] = -INFINITY; if (key + 32 > qpos) s1[r] = -INFINITY; } } }
            if (MODE == 1) { const unsigned w0 = mw[0] >> (4 * hh), w1 = mw[1] >> (4 * hh); const LAS float* tp = tbl + (qpos - k0 - 4 * hh + 64);
#pragma unroll
                for (int r = 0; r < 16; ++r) { const int bit = (r & 3) + 8 * (r >> 2);
                    const float t0 = tp[-bit], t1 = tp[-bit - 32];
                    s0[r] = ((w0 >> bit) & 1u) ? s0[r] + t0 : -INFINITY; s1[r] = ((w1 >> bit) & 1u) ? s1[r] + t1 : -INFINITY; } }
            if (MODE == 2) { const LAS float* tp = tbl + (qpos - k0 - 4 * hh + 64);
#pragma unroll
                for (int r = 0; r < 16; ++r) { const int bit = (r & 3) + 8 * (r >> 2); s0[r] += tp[-bit]; s1[r] += tp[-bit - 32]; } }
            float mx = fmaxf(s0[0], s1[0]);
#pragma unroll
            for (int r = 1; r < 16; ++r) mx = fmaxf(mx, fmaxf(s0[r], s1[r]));
            mx = fmaxf(mx, __shfl_xor(mx, 32));
            const bool need = (mx > 8.0f) || (!started && mx > -INFINITY);
            if (__any(need)) {
                const float delta = need ? mx : 0.f, alpha = __builtin_amdgcn_exp2f(-delta);
                lsum *= alpha;
#pragma unroll
                for (int r = 0; r < 16; ++r) { o0[r] *= alpha; o1[r] *= alpha; negm[r] -= delta; s0[r] -= delta; s1[r] -= delta; }
            }
            started = started || (mx > -INFINITY);
            float ps = 0.f;
#pragma unroll
            for (int r = 0; r < 16; ++r) { s0[r] = __builtin_amdgcn_exp2f(s0[r]); s1[r] = __builtin_amdgcn_exp2f(s1[r]); ps += s0[r] + s1[r]; }
            lsum += ps;
            bf16x8 pb[4];
#pragma unroll
            for (int s2 = 0; s2 < 2; ++s2) {
                u32x4 a = {cvt_pk(s0[8 * s2 + 0], s0[8 * s2 + 1]), cvt_pk(s0[8 * s2 + 2], s0[8 * s2 + 3]), cvt_pk(s0[8 * s2 + 4], s0[8 * s2 + 5]), cvt_pk(s0[8 * s2 + 6], s0[8 * s2 + 7])};
                u32x4 c = {cvt_pk(s1[8 * s2 + 0], s1[8 * s2 + 1]), cvt_pk(s1[8 * s2 + 2], s1[8 * s2 + 3]), cvt_pk(s1[8 * s2 + 4], s1[8 * s2 + 5]), cvt_pk(s1[8 * s2 + 6], s1[8 * s2 + 7])};
                pb[s2] = __builtin_bit_cast(bf16x8, a); pb[2 + s2] = __builtin_bit_cast(bf16x8, c); }
            const int vlane = (4 * hh + ((lane & 15) >> 2)) * 64 + (((lane >> 4) & 1) * 16 + 4 * (lane & 3)) * 2;
#pragma unroll
            for (int dt = 0; dt < 2; ++dt) {
#pragma unroll
                for (int kk = 0; kk < 4; ++kk) {
                    const LAS unsigned char* va = vb + dt * 4096 + kk * 16 * 64 + vlane;
                    const s16x4 lo = __builtin_bit_cast(s16x4, __builtin_amdgcn_ds_read_tr16_b64_v4i16((LAS s16x4*)(va)));
                    const s16x4 hi = __builtin_bit_cast(s16x4, __builtin_amdgcn_ds_read_tr16_b64_v4i16((LAS s16x4*)(va + 8 * 64)));
                    const bf16x8 vf = {lo[0], lo[1], lo[2], lo[3], hi[0], hi[1], hi[2], hi[3]};
                    if (dt == 0) o0 = __builtin_amdgcn_mfma_f32_32x32x16_bf16(vf, pb[kk], o0, 0, 0, 0);
                    else o1 = __builtin_amdgcn_mfma_f32_32x32x16_bf16(vf, pb[kk], o1, 0, 0, 0); } }
        }
        if (t + 1 < ntile) { const int nb = (t + 1) & 1;
            *(LAS u32x4*)(lds + AT_K0 + nb * AT_KSZ + kdst) = kreg; *(LAS u32x4*)(lds + AT_V0 + nb * AT_VSZ + vdst) = vreg;
            if (MODE == 0 && tid < 256) *(LAS u32x4*)(lds + AT_K0 + nb * AT_KSZ + rdst) = rreg;
            if (MODE == 1) mw = mwn; }
        __syncthreads();
    }
    const float ltot = lsum + __shfl_xor(lsum, 32);
    const float inv = ltot > 0.f ? 1.0f / ltot : 0.f;
    bf16_t* orow = Op + (tb + qpos) * 1024 + 4 * hh;
#pragma unroll
    for (int g = 0; g < 4; ++g) {
        *(u32x2*)(orow + 8 * g) = (u32x2){cvt_pk(o0[4 * g] * inv, o0[4 * g + 1] * inv), cvt_pk(o0[4 * g + 2] * inv, o0[4 * g + 3] * inv)};
        *(u32x2*)(orow + 32 + 8 * g) = (u32x2){cvt_pk(o1[4 * g] * inv, o1[4 * g + 1] * inv), cvt_pk(o1[4 * g + 2] * inv, o1[4 * g + 3] * inv)}; }
}

__device__ __forceinline__ void phase_attention(const Frame& F, const Params& p, const int l) {
    int slice = 0;
    constexpr int KTOT = (65 * 384 + 2047) / 2048 + 1;
    for (int L = (int)blockIdx.x; L < 2048; L += F.G) {
        const int level = L >> 8, idx = ((L & 255) + 37 * level) & 255, qb = 7 - level;
        if (idx < 96) { const int b = idx / 6, h = idx % 6;
            attn_unit<0, 6>(F, b, qb, fMQ(F) + h * 96, 576, fMK(F) + h * 64, 384, fKR(F), fMV(F) + h * 64, 384, fAO(F) + 640 + h * 64, nullptr, nullptr, 0);
        } else if (idx < 160) { const int j = idx - 96, b = j >> 2, h = j & 3;
            attn_unit<1, 4>(F, b, qb, fU(F) + U_SQ + h * 64, LDU, fU(F) + U_SK + h * 64, LDU, nullptr, fU(F) + U_SV + h * 64, LDU, fAO(F) + 384 + h * 64, fMASK(F), fDTAB(F), 6 + h);
        } else { const int j = idx - 160, b = j / 6, h = j % 6;
            attn_unit<2, 4>(F, b, qb, fU(F) + U_DQ + h * 64, LDU, fU(F) + U_DK + h * 64, LDU, nullptr, fU(F) + U_DV + h * 64, LDU, fAO(F) + h * 64, nullptr, fDTAB(F), h);
        }
        convert_experts(F, p, l, 2 * slice, 2 * slice + 2, 65536); ++slice;
    }
    { const int NGW = F.G * NWAVES; const int kmax = (65 * 384 + NGW - 1) / NGW; if (2 * slice < kmax) convert_experts(F, p, l, 2 * slice, kmax, 65536); }
}
__device__ __forceinline__ int wave_isum(int c) {
    c += __builtin_amdgcn_update_dpp(0, c, 0x128, 0xf, 0xf, false);
    c += __builtin_amdgcn_update_dpp(0, c, 0x124, 0xf, 0xf, false);
    c += __builtin_amdgcn_update_dpp(0, c, 0x122, 0xf, 0xf, false);
    c += __builtin_amdgcn_update_dpp(0, c, 0x121, 0xf, 0xf, false);
    return __builtin_amdgcn_readlane(c, 0) + __builtin_amdgcn_readlane(c, 16) + __builtin_amdgcn_readlane(c, 32) + __builtin_amdgcn_readlane(c, 48);
}
__device__ __forceinline__ float wave_fmax(float v) {
#define DPPF(x, c) __builtin_bit_cast(float, __builtin_amdgcn_update_dpp(0, __builtin_bit_cast(int, x), c, 0xf, 0xf, false))
    v = fmaxf(v, DPPF(v, 0x128)); v = fmaxf(v, DPPF(v, 0x124)); v = fmaxf(v, DPPF(v, 0x122)); v = fmaxf(v, DPPF(v, 0x121));
    const int i = __builtin_bit_cast(int, v);
    return fmaxf(fmaxf(__builtin_bit_cast(float, __builtin_amdgcn_readlane(i, 0)), __builtin_bit_cast(float, __builtin_amdgcn_readlane(i, 16))), fmaxf(__builtin_bit_cast(float, __builtin_amdgcn_readlane(i, 32)), __builtin_bit_cast(float, __builtin_amdgcn_readlane(i, 48))));
}
__device__ __forceinline__ float wave_fmin(float v) {
    v = fminf(v, DPPF(v, 0x128)); v = fminf(v, DPPF(v, 0x124)); v = fminf(v, DPPF(v, 0x122)); v = fminf(v, DPPF(v, 0x121));
    const int i = __builtin_bit_cast(int, v);
    return fminf(fminf(__builtin_bit_cast(float, __builtin_amdgcn_readlane(i, 0)), __builtin_bit_cast(float, __builtin_amdgcn_readlane(i, 16))), fminf(__builtin_bit_cast(float, __builtin_amdgcn_readlane(i, 32)), __builtin_bit_cast(float, __builtin_amdgcn_readlane(i, 48))));
#undef DPPF
}
template <int NJ> __device__ __forceinline__ int count_ge(const float (&x)[32], const float v) {
    unsigned acc = 0u;
#pragma unroll
    for (int j = 0; j < NJ; ++j) acc = __builtin_amdgcn_alignbit(acc, __builtin_bit_cast(unsigned, x[j] - v), 31);
    return 64 * NJ - wave_isum(__builtin_popcount(acc));
}
template <int NJ> __device__ __forceinline__ unsigned long long select_row(const LAS float* srow, const int q, const int lane) {
    float x[32];
#pragma unroll
    for (int j = 0; j < NJ; ++j) x[j] = srow[64 * j];
#pragma unroll
    for (int j = 0; j < NJ; ++j) x[j] = (64 * j + lane <= q) ? x[j] : -INFINITY;
    float mx = -INFINITY, mn = INFINITY;
#pragma unroll
    for (int j = 0; j < NJ; ++j) { mx = fmaxf(mx, x[j]); mn = fminf(mn, x[j] == -INFINITY ? INFINITY : x[j]); }
    float lo = wave_fmin(mn), hi = wave_fmax(mx);
    float thr = 0.f; bool exact = false;
    int c_hi = count_ge<NJ>(x, hi), c_lo = q + 1;
    if (c_hi < 256) {
#pragma unroll 1
        for (int it = 0; it < 320; ++it) {
            float mid = 0.5f * lo + 0.5f * hi;
            if (!(mid > lo && mid < hi)) break;
            if (false) { const float fr = ((float)(c_lo - 256) + 0.5f) / (float)(c_lo - c_hi), tc = lo + fr * (hi - lo); if (tc > lo && tc < hi) mid = tc; }
            const int c = count_ge<NJ>(x, mid);
            if (c == 256) { thr = mid; exact = true; break; }
            if (c > 256) { lo = mid; c_lo = c; } else { hi = mid; c_hi = c; }
        }
    } else { lo = hi; hi = INFINITY; c_hi = 0; }
    unsigned long long myw = 0ull;
    if (exact) {
#pragma unroll
        for (int j = 0; j < NJ; ++j) { const unsigned long long sel = __ballot(x[j] >= thr); if (lane == j) myw = sel; }
    } else {
        int need = 256 - c_hi;
#pragma unroll 1
        for (int j = 0; j < NJ; ++j) { float xj = x[0];
#pragma unroll
            for (int k = 1; k < NJ; ++k) xj = (k == j) ? x[k] : xj;
            const unsigned long long eq = __ballot(xj == lo); const int rank = __builtin_popcountll(eq & ((1ull << lane) - 1ull));
            const unsigned long long sel = __ballot(xj >= hi) | __ballot(xj == lo && rank < need); const int ne = __builtin_popcountll(eq); need = need > ne ? need - ne : 0;
            if (lane == j) myw = sel; }
    }
    return myw;
}
constexpr int IX_PITCH = 2052, IX_IQ = 16 * IX_PITCH * 4, IX_IW = IX_IQ + 16384;
typedef float f32x4_t __attribute__((ext_vector_type(4)));
__device__ __forceinline__ void indexer_block(const Frame& F, const int b, const int qk) {
    LAS unsigned char* lds = F.lds;
    const int tid = F.tid, lane = F.lane, w = F.wave, q16 = lane & 15, kg = lane >> 4;
    const size_t tb = (size_t)b * SEQ; const int q0 = 16 * qk, ntile = qk + 1;
    LAS float* sl = (LAS float*)lds;
    __syncthreads();
#pragma unroll
    for (int i = 0; i < 2; ++i) { const int idx = tid + 512 * i, q = idx >> 6, c = idx & 63;
        *(LAS u32x4*)(lds + IX_IQ + c * 256 + q * 16) = *(const u32x4*)(fU(F) + (tb + q0 + q) * LDU + U_IQ + 8 * c); }
    if (tid < 128) { const int q = tid >> 3, h8 = tid & 7; ((LAS float*)(lds + IX_IW))[h8 * 16 + q] = bf2f(fU(F)[(tb + q0 + q) * LDU + U_IW + h8]); }
    __syncthreads();
    const int qpos = q0 + q16;
    bf16x8 kf[2];
    if (w < ntile) { const bf16_t* kr = fU(F) + (tb + 16 * w + q16) * LDU + U_IK + 8 * kg; kf[0] = *(const bf16x8*)kr; kf[1] = *(const bf16x8*)(kr + 32); }
#pragma unroll 1
    for (int ti = w; ti < ntile; ti += NWAVES) {
        const int key0 = 16 * ti;
        bf16x8 kn[2];
        { const int tn = (ti + NWAVES < ntile) ? ti + NWAVES : ti; const bf16_t* kr = fU(F) + (tb + 16 * tn + q16) * LDU + U_IK + 8 * kg; kn[0] = *(const bf16x8*)kr; kn[1] = *(const bf16x8*)(kr + 32); }
        f32x4 sc = {0.f, 0.f, 0.f, 0.f};
#pragma unroll
        for (int h8 = 0; h8 < 8; ++h8) {
            const float iwq = ((const LAS float*)(lds + IX_IW))[h8 * 16 + q16];
            f32x4 a = {0.f, 0.f, 0.f, 0.f};
#pragma unroll
            for (int ks = 0; ks < 2; ++ks) { const bf16x8 qv = *(const LAS bf16x8*)(lds + IX_IQ + (8 * h8 + 4 * ks + kg) * 256 + q16 * 16);
                a = __builtin_amdgcn_mfma_f32_16x16x32_bf16(kf[ks], qv, a, 0, 0, 0); }
#pragma unroll
            for (int r = 0; r < 4; ++r) sc[r] += iwq * fmaxf(a[r], 0.f);
        }
        if (ti == qk) {
#pragma unroll
            for (int r = 0; r < 4; ++r) { const int key = key0 + 4 * kg + r; if (key > qpos) sc[r] = -INFINITY; } }
        *(LAS f32x4*)(sl + q16 * IX_PITCH + key0 + 4 * kg) = sc;
        kf[0] = kn[0]; kf[1] = kn[1];
    }
    __syncthreads();
#pragma unroll 1
    for (int rr = 0; rr < 2; ++rr) {
        const int ql = w + 8 * rr, q = q0 + ql, n = q + 1;
        unsigned long long myw = 0ull;
        if (n <= 256) {
            if (lane < 32) { const int lo = 64 * lane; myw = (lo + 63 <= q) ? ~0ull : (lo <= q ? ((1ull << (q - lo + 1)) - 1ull) : 0ull); }
        } else {
            const LAS float* srow = sl + ql * IX_PITCH + lane; const int nj = (q0 + 16 + 63) >> 6;
            if (nj <= 8) myw = select_row<8>(srow, q, lane); else if (nj <= 16) myw = select_row<16>(srow, q, lane); else if (nj <= 24) myw = select_row<24>(srow, q, lane); else myw = select_row<32>(srow, q, lane);
        }
        if (lane < 32) *(unsigned long long*)(fMASK(F) + (tb + q) * 64 + 2 * lane) = myw;
    }
}
__device__ __forceinline__ void phase_indexer(const Frame& F) {
    for (int L = (int)blockIdx.x; L < 1024; L += F.G) { const int b = L >> 6, j = L & 63;
#pragma unroll 1
        for (int s = 0; s < 2; ++s) indexer_block(F, b, s ? j : 127 - j); }
}

__device__ __forceinline__ void ln_finish(const Frame& F, float (&v)[16], const float* g, const float* bta, bf16_t* ob, float* of) {
    float s = 0.f;
#pragma unroll
    for (int j = 0; j < 16; ++j) s += v[j];
    const float mean = wave_sum(s) * (1.f / 1024.f); float s2 = 0.f;
#pragma unroll
    for (int j = 0; j < 16; ++j) { v[j] -= mean; s2 += v[j] * v[j]; }
    const float rstd = 1.f / sqrtf(wave_sum(s2) * (1.f / 1024.f) + LN_EPS);
    const int c0 = 16 * F.lane; float o[16];
#pragma unroll
    for (int q4 = 0; q4 < 4; ++q4) { const f32x4 gg = *(const f32x4*)(g + c0 + 4 * q4), bb = *(const f32x4*)(bta + c0 + 4 * q4);
#pragma unroll
        for (int j = 0; j < 4; ++j) o[4 * q4 + j] = v[4 * q4 + j] * rstd * gg[j] + bb[j]; }
    if (ob) { *(u32x4*)(ob + c0) = (u32x4){cvt_pk(o[0], o[1]), cvt_pk(o[2], o[3]), cvt_pk(o[4], o[5]), cvt_pk(o[6], o[7])};
              *(u32x4*)(ob + c0 + 8) = (u32x4){cvt_pk(o[8], o[9]), cvt_pk(o[10], o[11]), cvt_pk(o[12], o[13]), cvt_pk(o[14], o[15])}; }
    if (of) {
#pragma unroll
        for (int q4 = 0; q4 < 4; ++q4) *(f32x4*)(of + c0 + 4 * q4) = (f32x4){o[4 * q4], o[4 * q4 + 1], o[4 * q4 + 2], o[4 * q4 + 3]}; }
}
__device__ __forceinline__ void ld16(float (&v)[16], const bf16_t* row, int lane, float sc) {
#pragma unroll
    for (int h = 0; h < 2; ++h) { const u32x4 q = *(const u32x4*)(row + 16 * lane + 8 * h);
#pragma unroll
        for (int j = 0; j < 4; ++j) { v[8 * h + 2 * j] = sc * bf2f(q[j] & 0xffffu); v[8 * h + 2 * j + 1] = sc * bf2f(q[j] >> 16); } }
}
__device__ __forceinline__ void add16(float (&v)[16], const bf16_t* row, int lane) {
#pragma unroll
    for (int h = 0; h < 2; ++h) { const u32x4 q = *(const u32x4*)(row + 16 * lane + 8 * h);
#pragma unroll
        for (int j = 0; j < 4; ++j) { v[8 * h + 2 * j] += bf2f(q[j] & 0xffffu); v[8 * h + 2 * j + 1] += bf2f(q[j] >> 16); } }
}
typedef float f32x2v __attribute__((ext_vector_type(2)));
__device__ __forceinline__ void add16_fp8(float (&v)[16], const unsigned char* row, int lane) {
    const u32x4 q = __builtin_nontemporal_load((const u32x4*)(row + 16 * lane));
#pragma unroll
    for (int j = 0; j < 4; ++j) { const f32x2v a = __builtin_amdgcn_cvt_pk_f32_fp8((int)q[j], false), b = __builtin_amdgcn_cvt_pk_f32_fp8((int)q[j], true);
        v[4 * j] += a[0]; v[4 * j + 1] += a[1]; v[4 * j + 2] += b[0]; v[4 * j + 3] += b[1]; }
}
__device__ __forceinline__ void phase_ln1(const Frame& F, const Params& p, int l) {
    const int gw = F.vcu * NWAVES + F.wave, NGW = F.G * NWAVES;
    for (int m = gw; m < T; m += NGW) { bf16_t* row = fXB(F) + (size_t)m * 1024; float v[16]; ld16(v, row, F.lane, 1.0f);
        ln_finish(F, v, p.ln1_g + l * 1024, p.ln1_b + l * 1024, row, nullptr); }
}
__device__ __forceinline__ void phase_ln2(const Frame& F, const Params& p, int l) {
    const int gw = F.vcu * NWAVES + F.wave, NGW = F.G * NWAVES; const bool lastl = (l == NL - 1);
    LAS int* cb = (LAS int*)(F.lds + LDS_TBL);
    __syncthreads();
    if (F.tid == 0) { int c = 0; for (int e = 0; e < 64; ++e) { cb[e] = c; c += (int)F.ctl[CW_CNT + l * 64 + e]; } }
    __syncthreads();
    for (int m = gw; m < T; m += NGW) { bf16_t* row = fXB(F) + (size_t)m * 1024;
        const unsigned pkv = fPK(F)[(size_t)m * 8 + (F.lane & 7)];
        float r[16];
#pragma unroll
        for (int j = 0; j < 16; ++j) r[j] = 0.f;
#pragma unroll
        for (int k = 0; k < 8; ++k) { const unsigned pe = (unsigned)__builtin_amdgcn_readlane((int)pkv, k); const int srow = cb[pe >> 16] + (int)(pe & 0xffffu);
            add16_fp8(r, fYB(F) + (size_t)srow * 1024, F.lane); }
        float v[16]; ld16(v, row, F.lane, DN_ALPHA); add16(v, fSH(F) + (size_t)m * 1024, F.lane);
#pragma unroll
        for (int j = 0; j < 16; ++j) v[j] += r[j] * (1.0f / YB_SCALE);
        ln_finish(F, v, p.ln2_g + l * 1024, p.ln2_b + l * 1024, lastl ? nullptr : row, lastl ? p.out + (size_t)m * 1024 : nullptr); }
}

__device__ __forceinline__ void phase_route(const Frame& F, const Params& p, int l) {
    LAS int* lcnt = (LAS int*)(F.lds + LDS_TBL + 8192); LAS int* lbase = lcnt + 64;
    const float* rb = p.router_b + l * 64;
    const int nth = F.G * NTHR, iters = (T + nth - 1) / nth;
    for (int it = 0; it < iters; ++it) {
        const int t = it * nth + F.vcu * NTHR + F.tid; const bool act = t < T;
        __syncthreads();
        if (F.tid < 64) lcnt[F.tid] = 0;
        __syncthreads();
        int ek[8], pk[8]; float gk[8];
        if (act) {
            float sel[64];
            const float* l0 = fLG(F) + (size_t)t * 64; const float* l1 = fLG(F) + ((size_t)T + t) * 64;
#pragma unroll
            for (int e4 = 0; e4 < 16; ++e4) { const f32x4 a = *(const f32x4*)(l0 + 4 * e4), c = *(const f32x4*)(l1 + 4 * e4), bb = *(const f32x4*)(rb + 4 * e4);
#pragma unroll
                for (int j = 0; j < 4; ++j) sel[4 * e4 + j] = 1.0f / (1.0f + __expf(-(a[j] + c[j]))) + bb[j]; }
            float gs = 0.f;
#pragma unroll
            for (int k = 0; k < 8; ++k) { float best = -INFINITY; int bi = 0;
#pragma unroll
                for (int e = 0; e < 64; ++e) { const bool gt = sel[e] > best; best = gt ? sel[e] : best; bi = gt ? e : bi; }
#pragma unroll
                for (int e = 0; e < 64; ++e) sel[e] = (e == bi) ? -INFINITY : sel[e];
                ek[k] = bi; gk[k] = best - rb[bi]; gs += gk[k]; }
            const float sc = ROUTED_SCALE / gs;
#pragma unroll
            for (int k = 0; k < 8; ++k) { gk[k] *= sc; pk[k] = __hip_atomic_fetch_add(lcnt + ek[k], 1, __ATOMIC_RELAXED, __HIP_MEMORY_SCOPE_WORKGROUP); }
        }
        __syncthreads();
        if (F.tid < 64) { const int c = lcnt[F.tid]; lbase[F.tid] = c ? (int)__hip_atomic_fetch_add(F.ctl + CW_CNT + l * 64 + F.tid, (unsigned)c, __ATOMIC_RELAXED, __HIP_MEMORY_SCOPE_AGENT) : 0; }
        __syncthreads();
        if (act) {
#pragma unroll
            for (int k = 0; k < 8; ++k) { const int pos = lbase[ek[k]] + pk[k]; fLST(F)[(size_t)ek[k] * T + pos] = (unsigned)t; fGS(F)[(size_t)ek[k] * T + pos] = gk[k]; fPK(F)[(size_t)t * 8 + k] = ((unsigned)ek[k] << 16) | (unsigned)pos; } }
    }
}
__device__ __forceinline__ void frame_init(Frame& F, const Params& p, unsigned char* lds) {
    F.lds = (LAS unsigned char*)lds; F.MISC = (volatile LAS unsigned*)(F.lds + LDS_MISC);
    F.tid = threadIdx.x; F.lane = F.tid & 63; F.wave = __builtin_amdgcn_readfirstlane(F.tid >> 6);
    F.G = gridDim.x; { const int bx = blockIdx.x; F.vcu = (F.G % 8 == 0) ? (bx % 8) * (F.G / 8) + bx / 8 : bx; }
    F.ws = p.ws; F.ctl = (unsigned*)(p.ws + WS_CTL);
}

constexpr int NPHASE = 1 + 10 * NL;
__global__ void __launch_bounds__(NTHR, 2) mega(Params p) {
    extern __shared__ __attribute__((aligned(16))) unsigned char lds_raw[];
    Frame F; frame_init(F, p, lds_raw);
    if (F.tid < 64) F.MISC[F.tid] = 0u;
    __syncthreads();
    const int lo = p.ph_lo, hi = p.ph_hi;
    XcdBarrier bar; bar.bar = F.ctl + CW_BAR; bar.x = 0; bar.st = F.MISC + 8;
    if (hi - lo > 1) bar = xcd_barrier_post(F.ctl + CW_BAR, F.MISC + 8);
#define IN(k) (lo <= (k) && (k) < hi)
#define SEAM(k) do { if (IN(k) && IN((k) + 1)) xcd_barrier(bar); } while (0)
    if (IN(0)) { const Frame Fp = phase_frame(F); phase_x_to_xb(Fp, p.x); phase_rope_table(Fp, p.pos); phase_dist_tables(Fp, p.rel_bias); convert_small(Fp, p, 0); }
    SEAM(0);
    for (int l = 0; l < NL; ++l) {
        const int pb = 1 + 10 * l;
        if (IN(pb + 0)) phase_inproj(phase_frame(F));
        SEAM(pb + 0);
        if (IN(pb + 1)) { phase_mla_up(phase_frame(F), p); phase_indexer(phase_frame(F)); }
        SEAM(pb + 1);
        if (IN(pb + 2)) phase_attention(phase_frame(F), p, l);
        SEAM(pb + 2);
        if (IN(pb + 3)) phase_outproj(phase_frame(F));
        SEAM(pb + 3);
        if (IN(pb + 4)) phase_ln1(phase_frame(F), p, l);
        SEAM(pb + 4);
        if (IN(pb + 5)) phase_router_sharedg1(phase_frame(F));
        SEAM(pb + 5);
        if (IN(pb + 6)) phase_route(phase_frame(F), p, l);
        SEAM(pb + 6);
        if (IN(pb + 7)) phase_moe_g1(phase_frame(F), l);
        SEAM(pb + 7);
        if (IN(pb + 8)) { phase_moe_g2(phase_frame(F), l); phase_shared_g2(phase_frame(F)); }
        SEAM(pb + 8);
        if (IN(pb + 9)) { phase_ln2(phase_frame(F), p, l); if (l + 1 < NL) convert_small(phase_frame(F), p, l + 1); }
        SEAM(pb + 9);
    }
#undef IN
#undef SEAM
}
#ifndef DBG
#define DBG 0
#endif
#if DBG
#endif
extern "C" void kernel_launch(void* const* d_in, const int* in_sizes, int n_in, void* d_out, int out_size, void* d_ws, size_t ws_size, hipStream_t stream) {
    static int grid = 0;
    if (grid == 0) {
        if (n_in != 21 || out_size != T * DM || ws_size < WS_END) { fprintf(stderr, "kernel_launch: unexpected problem (n_in %d, out %d, ws %zu < %zu); nothing launched\n", n_in, out_size, ws_size, (size_t)WS_END); grid = -1; return; }
        int dev = 0, cus = 0, per_cu = 0;
        if (hipGetDevice(&dev) != hipSuccess || hipDeviceGetAttribute(&cus, hipDeviceAttributeMultiprocessorCount, dev) != hipSuccess) { grid = -1; return; }
        if (hipFuncSetAttribute((const void*)mega, hipFuncAttributeMaxDynamicSharedMemorySize, LDS_BYTES) != hipSuccess) { fprintf(stderr, "kernel_launch: hipFuncSetAttribute failed\n"); grid = -1; return; }
        if (hipOccupancyMaxActiveBlocksPerMultiprocessor(&per_cu, (const void*)mega, NTHR, LDS_BYTES) != hipSuccess || per_cu < 1) { fprintf(stderr, "kernel_launch: occupancy query says %d\n", per_cu); (void)hipGetLastError(); per_cu = 1; }
        grid = cus > 256 ? 256 : cus;
    }
    if (grid < 0) return;
    (void)hipMemsetAsync((char*)d_ws + WS_CTL, 0, CTL_BYTES, stream);
    Params p{};
    p.x = (const float*)d_in[0]; p.pos = (const int*)d_in[1]; p.w_in = (const float*)d_in[2]; p.q_norm = (const float*)d_in[3]; p.w_uq = (const float*)d_in[4];
    p.kv_norm = (const float*)d_in[5]; p.w_ukv = (const float*)d_in[6]; p.w_out = (const float*)d_in[7]; p.ln1_g = (const float*)d_in[8]; p.ln1_b = (const float*)d_in[9];
    p.router_w = (const float*)d_in[10]; p.router_b = (const float*)d_in[11]; p.w1 = (const float*)d_in[12]; p.w3 = (const float*)d_in[13]; p.w2 = (const float*)d_in[14];
    p.sw1 = (const float*)d_in[15]; p.sw3 = (const float*)d_in[16]; p.sw2 = (const float*)d_in[17]; p.ln2_g = (const float*)d_in[18]; p.ln2_b = (const float*)d_in[19]; p.rel_bias = (const float*)d_in[20];
    p.out = (float*)d_out; p.ws = (unsigned char*)d_ws;
#if DBG
    dbg_run(p, grid, stream);
#elif defined(MULTI_LAUNCH)
    for (int k = 0; k < NPHASE; ++k) { p.ph_lo = k; p.ph_hi = k + 1; mega<<<dim3(grid), dim3(NTHR), LDS_BYTES, stream>>>(p); }
#else
    p.ph_lo = 0; p.ph_hi = NPHASE;
    mega<<<dim3(grid), dim3(NTHR), LDS_BYTES, stream>>>(p);
#endif
}
```

```cpp
#include <hip/hip_runtime.h>
#include <cstdio>
#include <cstdint>

#define LAS __attribute__((address_space(3)))
typedef unsigned short bf16_t;
typedef short bf16x8 __attribute__((ext_vector_type(8)));
typedef short s16x4 __attribute__((ext_vector_type(4)));
typedef float f32x2 __attribute__((ext_vector_type(2)));
typedef float f32x4 __attribute__((ext_vector_type(4)));
typedef float f32x16 __attribute__((ext_vector_type(16)));
typedef unsigned u32x4 __attribute__((ext_vector_type(4)));
typedef unsigned u32x2 __attribute__((ext_vector_type(2)));
typedef __bf16 bf16x2_t __attribute__((ext_vector_type(2)));

constexpr int NB = 16, SEQ = 2048, T = NB * SEQ, DM = 1024, NL = 4;
constexpr int IN_W = 2920, LDU = 3072;
constexpr int U_DQ = 0, U_DK = 384, U_DV = 768, U_SQ = 1152, U_SK = 1408, U_SV = 1664, U_IQ = 1920, U_IK = 2432, U_IW = 2496, U_CQ = 2560, U_CKV = 2816, U_KR = 2944;
constexpr int NE = 64, FF = 256;
constexpr float LOG2E = 1.4426950408889634f;
constexpr float QSCALE = 0.125f * LOG2E;
constexpr float MLA_QSCALE = 0.10206207261596575f * LOG2E;
constexpr float DN_ALPHA = 1.6817928305074290f;
constexpr float LN_EPS = 1e-5f, RMS_EPS = 1e-6f;
constexpr float ROUTED_SCALE = 2.5f;

constexpr size_t MiB = (size_t)1 << 20;
constexpr size_t WS_CTL = 0, CTL_BYTES = 1 * MiB;
constexpr size_t WS_DTAB = 512 * 1024;
constexpr size_t WS_W = 1 * MiB;
constexpr size_t W_IN = 0, W_UQ = W_IN + (size_t)3072 * 1024 * 2, W_UKV = W_UQ + (size_t)768 * 256 * 2, W_OUT = W_UKV + (size_t)768 * 256 * 2,
                 W_R = W_OUT + (size_t)1024 * 1024 * 2, W_13 = W_R + (size_t)256 * 1024 * 2, W_2 = W_13 + (size_t)65 * 512 * 1024 * 2, W_END = W_2 + (size_t)65 * 1024 * 256 * 2;
static_assert(W_END <= 108 * MiB, "weights region");
constexpr size_t WS_XF = 109 * MiB;
constexpr size_t WS_XB = 237 * MiB;
constexpr size_t WS_H = 301 * MiB;
constexpr size_t WS_LST = 445 * MiB;
constexpr size_t WS_GATE = 453 * MiB;
constexpr size_t WS_ROPE = 454 * MiB;
constexpr size_t WS_R = 458 * MiB;
constexpr size_t R_U = 0, R_MQ = 192 * MiB, R_MK = 228 * MiB, R_MV = 252 * MiB, R_KR = 276 * MiB, R_AO = 278 * MiB, R_MASK = 342 * MiB, R_SCR = 350 * MiB, R_LG = 414 * MiB;
constexpr size_t WS_END = 970 * MiB;
constexpr int CW_TMO = 0, CW_FLAG = 16  , CW_BAR = 4096, CW_CNT = 8192  , CW_Q = 16384  ;

__device__ __forceinline__ unsigned f2bf(float f) { unsigned u = __builtin_bit_cast(unsigned, f); return (u + 0x7fffu + ((u >> 16) & 1u)) >> 16; }
__device__ __forceinline__ float bf2f(unsigned b) { return __builtin_bit_cast(float, b << 16); }
__device__ __forceinline__ unsigned cvt_pk(float lo, float hi) { f32x2 v = {lo, hi}; bf16x2_t b = __builtin_convertvector(v, bf16x2_t); return __builtin_bit_cast(unsigned, b); }
#define LDS_WAIT() asm volatile("s_waitcnt lgkmcnt(0)" ::: "memory")
#define VM_WAIT() asm volatile("s_waitcnt vmcnt(0)" ::: "memory")
__device__ __forceinline__ float wave_sum(float v) {
#pragma unroll
    for (int o = 1; o < 64; o <<= 1) v += __shfl_xor(v, o);
    return v;
}

#define XB_TMO      128
#define XB_XCNT(j)  (256  + 64 * (j))
#define XB_XSUB(j)  (1280 + 64 * (j))
#define XB_XGEN(j)  (2304 + 64 * (j))
#define XB_TOP      3328
#define XB_TOPGEN   3392
#define XCD_BAR_WORDS 3456
#define XB_SPIN_CAP (1u << 18)
__device__ __forceinline__ unsigned xb_ld(unsigned* p)              { return __hip_atomic_load(p, __ATOMIC_RELAXED, __HIP_MEMORY_SCOPE_AGENT); }
__device__ __forceinline__ unsigned xb_add(unsigned* p, unsigned v) { return __hip_atomic_fetch_add(p, v, __ATOMIC_RELAXED, __HIP_MEMORY_SCOPE_AGENT); }
__device__ __forceinline__ unsigned xb_xcc_id() { return (unsigned)__builtin_amdgcn_s_getreg((3 << 11) | 20) & 0xFu; }
#define XB_SPIN(cond, bar) do { unsigned _sp = 0; while (cond) { __builtin_amdgcn_s_sleep(1); \
    if ((++_sp & 255u) == 0u) { if (xb_ld(&(bar)[XB_TMO])) break; if (_sp > XB_SPIN_CAP) { atomicAdd(&(bar)[XB_TMO], 1u); break; } } } } while (0)
struct XcdBarrier { unsigned* bar; unsigned x; volatile LAS unsigned* st; };
__device__ __forceinline__ XcdBarrier xcd_barrier_post(unsigned* bar, volatile LAS unsigned* st) {
    XcdBarrier b; b.bar = bar; b.x = xb_xcc_id(); b.st = st;
    if (threadIdx.x == 0) (void)xb_add(&bar[XB_XCNT(b.x)], 1u);
    return b;
}
__device__ __forceinline__ void xcd_barrier_complete(unsigned* bar, unsigned x, unsigned& nloc, unsigned& nx) {
    const unsigned G = gridDim.x * gridDim.y * gridDim.z;
    unsigned sum, cnt, mine, sp = 0u;
    for (;;) {
        sum = 0u; cnt = 0u; mine = 0u;
#pragma unroll
        for (unsigned j = 0; j < 16; ++j) { const unsigned c = xb_ld(&bar[XB_XCNT(j)]); sum += c; cnt += (c > 0u) ? 1u : 0u; mine = (j == x) ? c : mine; }
        if (sum == G) break;
        __builtin_amdgcn_s_sleep(1);
        if ((++sp & 255u) == 0u) { if (xb_ld(&bar[XB_TMO])) break; if (sp > XB_SPIN_CAP) { atomicAdd(&bar[XB_TMO], 1u); break; } }
    }
    nloc = mine > 0u ? mine : 1u; nx = cnt > 0u ? cnt : 1u;
}
__device__ __forceinline__ void xcd_barrier(const XcdBarrier& b) {
    asm volatile("s_waitcnt vmcnt(0)" ::: "memory");
    __syncthreads();
    if (threadIdx.x == 0) {
        unsigned* bar = b.bar;
        __builtin_amdgcn_s_waitcnt(0);
        unsigned nloc = b.st[0], nx = b.st[1];
        if (nloc == 0u) { xcd_barrier_complete(bar, b.x, nloc, nx); b.st[0] = nloc; b.st[1] = nx; }
        const unsigned old = xb_add(&bar[XB_XSUB(b.x)], 1u);
        const unsigned gen = old / nloc;
        if (old + 1u == (gen + 1u) * nloc) {
            __builtin_amdgcn_fence(__ATOMIC_RELEASE, "agent");
            asm volatile("s_waitcnt vmcnt(0)" ::: "memory");
            const unsigned og = xb_add(&bar[XB_TOP], 1u);
            const unsigned tg = og / nx;
            if (og + 1u == (tg + 1u) * nx) xb_add(&bar[XB_TOPGEN], 1u);
            else XB_SPIN(xb_ld(&bar[XB_TOPGEN]) == tg, bar);
            __builtin_amdgcn_fence(__ATOMIC_ACQUIRE, "agent");
            xb_add(&bar[XB_XGEN(b.x)], 1u);
            asm volatile("s_waitcnt vmcnt(0)" ::: "memory");
        } else {
            XB_SPIN(xb_ld(&bar[XB_XGEN(b.x)]) == gen, bar);
            __builtin_amdgcn_fence(__ATOMIC_ACQUIRE, "agent");
            asm volatile("s_waitcnt vmcnt(0)" ::: "memory");
        }
    }
    __syncthreads();
}

namespace pg8 {
constexpr int BM = 256, BK = 64, HALF = 128, HTB = HALF * BK * 2, STAGE_BYTES = 8 * HTB, NXCD = 8, WGM = 4;
__device__ __forceinline__ int lds_byte(int r, int c) { const int st = (r >> 4) * 2 + (c >> 5), rr = r & 15, cc = c & 31, ob = rr * 64 + cc * 2; return st * 1024 + (ob ^ (((ob >> 9) & 1) << 5)); }
__device__ __forceinline__ void stage_rc(int b, int& R, int& C) { const int st = b / 1024, sb = b % 1024, swz = sb ^ (((sb >> 9) & 1) << 5); R = (st >> 1) * 16 + swz / 64; C = (st & 1) * 32 + (swz % 64) / 2; }
__device__ __forceinline__ int perm32(int rho) { const int n = rho >> 4, i = rho & 15; return 8 * (i >> 2) + 4 * n + (i & 3); }
struct Unit { int pm, pn, e, seq; };

__device__ __forceinline__ int xcd_remap(int L, int nwg) { const int q = nwg / NXCD, r = nwg % NXCD, xcd = L % NXCD, off = L / NXCD; return (xcd < r ? xcd * (q + 1) : r * (q + 1) + (xcd - r) * q) + off; }

struct DenseOrder {
    int nM, nN, nwg, G, c; unsigned lda, acol; const char* Bt; unsigned ldb;
    __device__ void init(int M, int N, int G_, int c_, unsigned lda_, unsigned acol_, const void* Bt_, unsigned ldb_) { nM = M / BM; nN = N / BM; nwg = nM * nN; G = G_; c = c_; lda = lda_; acol = acol_; Bt = (const char*)Bt_; ldb = ldb_; }
    __device__ __forceinline__ bool next(int i, Unit& u) const {
        const long L = (long)i * G + c; if (L >= nwg) return false;
        const int wgid = xcd_remap((int)L, nwg);
        const int nig = WGM * nN, gid = wgid / nig, fm = gid * WGM, gsz = (nM - fm) < WGM ? (nM - fm) : WGM;
        u.pm = fm + ((wgid % nig) % gsz); u.pn = (wgid % nig) / gsz; u.e = 0; u.seq = i; return true;
    }
    __device__ __forceinline__ void a_voff(const Unit& u, int tid, unsigned (&v)[2][2]) const {
#pragma unroll
        for (int i = 0; i < 2; ++i) { int R, C; stage_rc(tid * 16 + i * 8192, R, C);
#pragma unroll
            for (int h = 0; h < 2; ++h) v[h][i] = ((unsigned)(u.pm * BM + h * HALF + R) * lda + acol + (unsigned)C) * 2u; }
    }
    __device__ __forceinline__ const char* b_base(const Unit& u) const { return Bt + (size_t)u.pn * BM * ldb * 2; }
};

template <class Epi, class Sched>
__device__ __forceinline__ void gemm_phase(LAS unsigned char* lds, LAS unsigned char* vslot  , const char* Abase, const int K, const unsigned ldb, const Sched& S, const Epi& E) {
    int tid = threadIdx.x; asm volatile("" : "+v"(tid));
    const int wid = __builtin_amdgcn_readfirstlane(tid >> 6), wr = wid >> 2, wc = wid & 3;
    const int nt = K / BK;
    unsigned voffB[2];
#pragma unroll
    for (int i = 0; i < 2; ++i) { int R, C; stage_rc(tid * 16 + i * 8192, R, C); const int Rb = (Epi::PERM == 2) ? (((R >> 5) & 3) * 64 + perm32(R & 31)) : (Epi::PERM ? ((R & ~31) + perm32(R & 31)) : R); voffB[i] = ((unsigned)Rb * ldb + (unsigned)C) * 2u; }
    const size_t kstep = (size_t)(BK * 2);
    const size_t hstepB = (size_t)(Epi::PERM == 2 ? 32 : HALF) * ldb * 2;
    const unsigned ldsw = (unsigned)wid * 1024u;
    const int aoff = lds_byte(wr * 64 + (tid & 15), ((tid & 63) >> 4) * 8), boff = lds_byte(wc * 32 + (tid & 15), ((tid & 63) >> 4) * 8);
#define PG8_SA(b, h) (((b) * 2 + (h)) * HTB)
#define PG8_SB(b, h) ((4 + (b) * 2 + (h)) * HTB)
#define PG8_STAGE(bufoff, gbase, voff) do { _Pragma("unroll") for (int _i = 0; _i < 2; ++_i) \
        __builtin_amdgcn_global_load_lds((const unsigned*)((const char*)(gbase) + (voff)[_i]), (LAS unsigned*)(lds + (bufoff) + ldsw + _i * 8192), 16, 0, 0); } while (0)
#define PG8_LDA(dst, b, h) do { _Pragma("unroll") for (int m = 0; m < 4; ++m) _Pragma("unroll") for (int k = 0; k < 2; ++k) dst[m][k] = *(const LAS bf16x8*)(lds + PG8_SA(b, h) + aoff + m * 2048 + k * 1024); } while (0)
#define PG8_LDB(dst, b, h) do { _Pragma("unroll") for (int n = 0; n < 2; ++n) _Pragma("unroll") for (int k = 0; k < 2; ++k) dst[n][k] = *(const LAS bf16x8*)(lds + PG8_SB(b, h) + boff + n * 2048 + k * 1024); } while (0)
#define PG8_MMA(ai, bj, At, Bt) do { __builtin_amdgcn_s_setprio(1); _Pragma("unroll") for (int m = 0; m < 4; ++m) _Pragma("unroll") for (int n = 0; n < 2; ++n) _Pragma("unroll") for (int k = 0; k < 2; ++k) \
        acc[ai][bj][m][n] = __builtin_amdgcn_mfma_f32_16x16x32_bf16(Bt[n][k], At[m][k], acc[ai][bj][m][n], 0, 0, 0); __builtin_amdgcn_s_setprio(0); } while (0)
#define PG8_WAIT_V(n) asm volatile("s_waitcnt vmcnt(" #n ")" ::: "memory")
#define PG8_WAIT_L(n) asm volatile("s_waitcnt lgkmcnt(" #n ")" ::: "memory")
#define PG8_BAR __builtin_amdgcn_s_barrier()
#define PG8_SCHED __builtin_amdgcn_sched_barrier(0)
    Unit cur, nxt; int ui = 0;
    if (!S.next(0, cur)) return;
    f32x4 acc[2][2][4][2];
#pragma unroll
    for (int a = 0; a < 2; ++a)
#pragma unroll
        for (int b = 0; b < 2; ++b)
#pragma unroll
            for (int m = 0; m < 4; ++m)
#pragma unroll
                for (int n = 0; n < 2; ++n) acc[a][b][m][n] = (f32x4){0.f, 0.f, 0.f, 0.f};
    bf16x8 At[4][2], B0[2][2], B1[2][2];
    unsigned vc[2][2];
    S.a_voff(cur, tid, vc);
    const char* cB = S.b_base(cur);
    PG8_STAGE(PG8_SB(0, 0), cB, voffB); PG8_STAGE(PG8_SB(0, 1), cB + hstepB, voffB); PG8_STAGE(PG8_SA(0, 0), Abase, vc[0]); PG8_STAGE(PG8_SA(0, 1), Abase, vc[1]);
    if (wr == 1) PG8_BAR;
    PG8_WAIT_V(2); PG8_BAR;
    PG8_STAGE(PG8_SB(1, 0), cB + kstep, voffB); PG8_STAGE(PG8_SA(1, 0), Abase + kstep, vc[0]); PG8_STAGE(PG8_SB(1, 1), cB + hstepB + kstep, voffB);
    PG8_WAIT_V(6); PG8_BAR;
    for (;;) {
        const bool has_next = S.next(ui + 1, nxt);
        const char* nB = has_next ? S.b_base(nxt) : cB;
        if (has_next) { unsigned vn[2][2]; int tz = threadIdx.x; asm volatile("" : "+v"(tz)); S.a_voff(nxt, tz, vn); *(LAS u32x4*)(vslot + tz * 16) = (u32x4){vn[0][0], vn[0][1], vn[1][0], vn[1][1]}; }
#pragma unroll 1
        for (int t = 0; t < nt; t += 2) {
            const bool last = (t == nt - 2);
            const char* a1 = Abase + (size_t)(t + 1) * kstep;
            const char* a2 = last ? Abase : Abase + (size_t)(t + 2) * kstep; const char* b2 = last ? nB : cB + (size_t)(t + 2) * kstep;
            const char* a3 = a2 + kstep; const char* b3 = b2 + kstep;
            u32x4 vnx = (u32x4){vc[0][0], vc[0][1], vc[1][0], vc[1][1]};
            if (last && has_next) vnx = *(const LAS u32x4*)(vslot + tid * 16);
            PG8_LDB(B0, 0, 0); PG8_LDB(B1, 0, 1); PG8_SCHED; PG8_LDA(At, 0, 0); PG8_STAGE(PG8_SA(1, 1), a1, vc[1]);
            vc[0][0] = vnx[0]; vc[0][1] = vnx[1]; vc[1][0] = vnx[2]; vc[1][1] = vnx[3];
            PG8_WAIT_V(8); PG8_WAIT_L(0); PG8_BAR; PG8_MMA(0, 0, At, B0); PG8_MMA(0, 1, At, B1); PG8_BAR; PG8_SCHED;
            PG8_LDA(At, 0, 1); PG8_STAGE(PG8_SB(0, 0), b2, voffB); PG8_STAGE(PG8_SB(0, 1), b2 + hstepB, voffB); PG8_STAGE(PG8_SA(0, 0), a2, vc[0]);
            PG8_WAIT_V(8); PG8_WAIT_L(0); PG8_BAR; PG8_MMA(1, 0, At, B0); PG8_MMA(1, 1, At, B1); PG8_BAR; PG8_SCHED;
            PG8_LDB(B0, 1, 0); PG8_LDB(B1, 1, 1); PG8_SCHED; PG8_LDA(At, 1, 0); PG8_STAGE(PG8_SA(0, 1), a2, vc[1]);
            PG8_WAIT_V(8); PG8_WAIT_L(0); PG8_BAR; PG8_MMA(0, 0, At, B0); PG8_MMA(0, 1, At, B1); PG8_BAR; PG8_SCHED;
            PG8_LDA(At, 1, 1); PG8_STAGE(PG8_SB(1, 0), b3, voffB); PG8_STAGE(PG8_SB(1, 1), b3 + hstepB, voffB); PG8_STAGE(PG8_SA(1, 0), a3, vc[0]);
            PG8_WAIT_V(8); PG8_WAIT_L(0); PG8_BAR; PG8_MMA(1, 0, At, B0); PG8_MMA(1, 1, At, B1); PG8_BAR; PG8_SCHED;
        }
        if (wr == 0) PG8_BAR;
        { int tz = threadIdx.x; asm volatile("" : "+v"(tz)); const int ln = tz & 63; E(acc, cur, wr, wc, ln & 15, ln >> 4); }
        if (!has_next) break;
#pragma unroll
        for (int a = 0; a < 2; ++a)
#pragma unroll
            for (int b = 0; b < 2; ++b)
#pragma unroll
                for (int m = 0; m < 4; ++m)
#pragma unroll
                    for (int n = 0; n < 2; ++n) acc[a][b][m][n] = (f32x4){0.f, 0.f, 0.f, 0.f};
        cur = nxt; cB = nB; ++ui;
        if (wr == 1) PG8_BAR;
    }
    PG8_WAIT_V(0);
    PG8_BAR;
#undef PG8_SA
#undef PG8_SB
#undef PG8_STAGE
#undef PG8_LDA
#undef PG8_LDB
#undef PG8_MMA
#undef PG8_WAIT_V
#undef PG8_WAIT_L
#undef PG8_BAR
#undef PG8_SCHED
}
}
constexpr int NWAVES = 8, NTHR = 512;
constexpr int LDS_RING = 131072;
constexpr int LDS_TBL = LDS_RING;
constexpr int LDS_VOFF = LDS_TBL + 22528;
constexpr int LDS_MISC = LDS_VOFF + 8192;
constexpr int LDS_BYTES = 162304;

struct Params {
    const float* x; const int* pos; const float* w_in; const float* q_norm; const float* w_uq; const float* kv_norm; const float* w_ukv; const float* w_out;
    const float* ln1_g; const float* ln1_b; const float* router_w; const float* router_b; const float* w1; const float* w3; const float* w2;
    const float* sw1; const float* sw3; const float* sw2; const float* ln2_g; const float* ln2_b; const float* rel_bias;
    float* out; unsigned char* ws;
    int ph_lo, ph_hi;
};

struct Frame {
    LAS unsigned char* lds; volatile LAS unsigned* MISC; unsigned* ctl;
    int tid, lane, wave, G, vcu;
    unsigned char* ws;
};
#define FP(name, type, off) __device__ __forceinline__ type* name(const Frame& F) { return (type*)(F.ws + (off)); }
FP(fWin, bf16_t, WS_W + W_IN) FP(fWuq, bf16_t, WS_W + W_UQ) FP(fWukv, bf16_t, WS_W + W_UKV) FP(fWout, bf16_t, WS_W + W_OUT) FP(fWr, bf16_t, WS_W + W_R) FP(fW13, bf16_t, WS_W + W_13) FP(fW2, bf16_t, WS_W + W_2)
FP(fSH, bf16_t, WS_XF) FP(fXB, bf16_t, WS_XB) FP(fH, bf16_t, WS_H) FP(fLST, unsigned, WS_LST) FP(fPK, unsigned, WS_GATE) FP(fGS, float, WS_XF + 64 * MiB) FP(fROPE, float, WS_ROPE) FP(fDTAB, float, WS_DTAB)
FP(fU, bf16_t, WS_R + R_U) FP(fMQ, bf16_t, WS_R + R_MQ) FP(fMK, bf16_t, WS_R + R_MK) FP(fMV, bf16_t, WS_R + R_MV) FP(fKR, bf16_t, WS_R + R_KR) FP(fAO, bf16_t, WS_R + R_AO)
FP(fMASK, unsigned, WS_R + R_MASK) FP(fSCR, float, WS_R + R_SCR) FP(fLG, float, WS_R + R_LG) FP(fYB, unsigned char, WS_R)
__device__ __forceinline__ Frame phase_frame(const Frame& F0) { Frame F = F0; int tz = threadIdx.x; asm volatile("" : "+v"(tz)); F.tid = tz; F.lane = tz & 63; return F; }

struct MapIn  { __device__ int row(int n) const { return n < 2504 ? n : n + 56; }   __device__ float sc(int k, int n) const { return (n < 384 || (n >= 1152 && n < 1408)) ? QSCALE : 1.0f; } };
struct MapUq  { const float* g; __device__ int row(int n) const { return n; }         __device__ float sc(int k, int n) const { return g[k] * MLA_QSCALE; } };
struct MapUkv { const float* g; __device__ int row(int n) const { const int h = n >> 7, c = n & 127; return c < 64 ? h * 64 + c : 384 + h * 64 + (c - 64); } __device__ float sc(int k, int n) const { return g[k]; } };
struct MapId  { __device__ int row(int n) const { return n; }                         __device__ float sc(int k, int n) const { return 1.0f; } };
struct MapW13 { int add; __device__ int row(int f) const { return 32 * (f >> 4) + (f & 15) + add; } __device__ float sc(int k, int n) const { return 1.0f; } };

template <class MAP>
__device__ __forceinline__ void tr_item(const float* W, int N, int kb, int nb, bf16_t* WT, int ldk, const MAP map, LAS float* scr, int lane) {
    const int k0 = 64 * kb, n0 = 32 * nb;
    const int nq = n0 + 4 * (lane & 7); const bool ok = nq < N;
    f32x4 w4[8];
#pragma unroll
    for (int i = 0; i < 8; ++i) { const int kk = 8 * i + (lane >> 3); w4[i] = ok ? __builtin_nontemporal_load((const f32x4*)(W + (size_t)(k0 + kk) * N + nq)) : (f32x4){0.f, 0.f, 0.f, 0.f}; }
#pragma unroll
    for (int i = 0; i < 8; ++i) { const int kk = 8 * i + (lane >> 3);
#pragma unroll
        for (int j = 0; j < 4; ++j) scr[kk * 33 + 4 * (lane & 7) + j] = w4[i][j] * map.sc(k0 + kk, nq + j); }
    LDS_WAIT(); asm volatile("" ::: "memory");
    const int c = lane & 7;
#pragma unroll
    for (int j = 0; j < 4; ++j) { const int n = (lane >> 3) + 8 * j; const LAS float* s = scr + (8 * c) * 33 + n;
        u32x4 o; o.x = cvt_pk(s[0 * 33], s[1 * 33]); o.y = cvt_pk(s[2 * 33], s[3 * 33]); o.z = cvt_pk(s[4 * 33], s[5 * 33]); o.w = cvt_pk(s[6 * 33], s[7 * 33]);
        if (n0 + n < N) *(u32x4*)(WT + (size_t)map.row(n0 + n) * ldk + k0 + 8 * c) = o; }
    LDS_WAIT(); asm volatile("" ::: "memory");
}

__device__ __forceinline__ void zero_rows(bf16_t* base, int row0, int nrows, int ldk, int k0, int kn, int gt, int ngt) {
    const int per = kn / 8; const int total = nrows * per;
    for (int i = gt; i < total; i += ngt) { const int r = i / per, c = i % per; *(u32x4*)(base + (size_t)(row0 + r) * ldk + k0 + 8 * c) = (u32x4){0u, 0u, 0u, 0u}; }
}

__device__ __forceinline__ void convert_small(const Frame& F, const Params& p, int l) {
    LAS float* scr = (LAS float*)(F.lds + F.wave * 16384);
    const int gw = F.vcu * NWAVES + F.wave, NGW = F.G * NWAVES;
    constexpr int I_IN = 16 * 92, I_UQ = 4 * 18, I_UKV = 2 * 24, I_OUT = 16 * 32, I_R = 16 * 2;
    constexpr int NIT = I_IN + I_UQ + I_UKV + I_OUT + I_R;
    const float* w_in = p.w_in + (size_t)l * 1024 * IN_W;
    const float* w_uq = p.w_uq + (size_t)l * 256 * 576; const float* w_ukv = p.w_ukv + (size_t)l * 128 * 768;
    const float* w_out = p.w_out + (size_t)l * 1024 * 1024; const float* rw = p.router_w + (size_t)l * 1024 * 64;
    for (int it = gw; it < NIT; it += NGW) {
        int r = it;
        if (r < I_IN) { tr_item(w_in, IN_W, r / 92, r % 92, fWin(F), 1024, MapIn{}, scr, F.lane); continue; } r -= I_IN;
        if (r < I_UQ) { tr_item(w_uq, 576, r / 18, r % 18, fWuq(F), 256, MapUq{p.q_norm + l * 256}, scr, F.lane); continue; } r -= I_UQ;
        if (r < I_UKV) { tr_item(w_ukv, 768, r / 24, r % 24, fWukv(F), 256, MapUkv{p.kv_norm + l * 128}, scr, F.lane); continue; } r -= I_UKV;
        if (r < I_OUT) { tr_item(w_out, 1024, r / 32, r % 32, fWout(F), 1024, MapId{}, scr, F.lane); continue; } r -= I_OUT;
        tr_item(rw, 64, r / 2, r % 2, fWr(F), 1024, MapId{}, scr, F.lane);
    }
    const int gt = F.vcu * NTHR + F.tid, ngt = F.G * NTHR;
    zero_rows(fWin(F), 2504, 56, 1024, 0, 1024, gt, ngt); zero_rows(fWin(F), 2976, 96, 1024, 0, 1024, gt, ngt);
    zero_rows(fWuq(F), 576, 192, 256, 0, 256, gt, ngt);
    zero_rows(fWukv(F), 0, 768, 256, 128, 128, gt, ngt);
    zero_rows(fWr(F), 64, 192, 1024, 0, 1024, gt, ngt);
}
__device__ __forceinline__ void convert_experts(const Frame& F, const Params& p, int l, int k0, int k1, int scr_off) {
    LAS float* scr = (LAS float*)(F.lds + scr_off + F.wave * 8448);
    const int gw = F.vcu * NWAVES + F.wave, NGW = F.G * NWAVES;
    constexpr int I_E1 = 16 * 8, I_E2 = 4 * 32, I_EXP = 2 * I_E1 + I_E2, NIT = 65 * I_EXP;
    for (int k = k0; k < k1; ++k) { const int it = gw + k * NGW; if (it >= NIT) break;
        const int e = it / I_EXP; int r = it - e * I_EXP;
        const float *s1, *s3, *s2;
        if (e < 64) { s1 = p.w1 + ((size_t)l * 64 + e) * 1024 * 256; s3 = p.w3 + ((size_t)l * 64 + e) * 1024 * 256; s2 = p.w2 + ((size_t)l * 64 + e) * 256 * 1024; }
        else { s1 = p.sw1 + (size_t)l * 1024 * 256; s3 = p.sw3 + (size_t)l * 1024 * 256; s2 = p.sw2 + (size_t)l * 256 * 1024; }
        bf16_t* d13 = fW13(F) + (size_t)e * 512 * 1024; bf16_t* d2 = fW2(F) + (size_t)e * 1024 * 256;
        if (r < I_E1) { tr_item(s1, 256, r / 8, r % 8, d13, 1024, MapW13{0}, scr, F.lane); continue; } r -= I_E1;
        if (r < I_E1) { tr_item(s3, 256, r / 8, r % 8, d13, 1024, MapW13{16}, scr, F.lane); continue; } r -= I_E1;
        tr_item(s2, 1024, r / 32, r % 32, d2, 256, MapId{}, scr, F.lane);
    }
}

typedef f32x4 Acc[2][2][4][2];
#define EPI_ROWS(ai, m) for (int ai = 0; ai < 2; ++ai) for (int m = 0; m < 4; ++m)

struct EpiU {
    static constexpr int PERM = 2; bf16_t* U;
    __device__ __forceinline__ void operator()(const Acc& acc, const pg8::Unit& u, int wr, int wc, int fr, int fq) const {
#pragma unroll
        EPI_ROWS(ai, m) { bf16_t* rowp = U + (size_t)(u.pm * 256 + ai * 128 + wr * 64 + m * 16 + fr) * LDU + u.pn * 256 + wc * 64 + 8 * fq;
#pragma unroll
            for (int bj = 0; bj < 2; ++bj) { const f32x4 a = acc[ai][bj][m][0], b = acc[ai][bj][m][1];
                *(u32x4*)(rowp + bj * 32) = (u32x4){cvt_pk(a[0], a[1]), cvt_pk(a[2], a[3]), cvt_pk(b[0], b[1]), cvt_pk(b[2], b[3])}; } }
    }
};
struct EpiQup {
    static constexpr int PERM = 0; bf16_t* MQ; const LAS float* tbl; const float* rope;
    __device__ __forceinline__ void operator()(const Acc& acc, const pg8::Unit& u, int wr, int wc, int fr, int fq) const {
#pragma unroll
        EPI_ROWS(ai, m) { const int rl = ai * 128 + wr * 64 + m * 16 + fr, row = u.pm * 256 + rl; const float rs = tbl[u.seq * 256 + rl];
#pragma unroll
            for (int bj = 0; bj < 2; ++bj) { const int c0 = u.pn * 256 + bj * 128 + wc * 32; f32x4 a = acc[ai][bj][m][0] * rs, b = acc[ai][bj][m][1] * rs;
                if (((c0 >> 5) % 3) == 2) {
                    const f32x4 cs = *(const f32x4*)(rope + (size_t)row * 32 + 4 * fq), sn = *(const f32x4*)(rope + (size_t)row * 32 + 16 + 4 * fq);
                    const f32x4 x1 = a, x2 = b; a = x1 * cs - x2 * sn; b = x2 * cs + x1 * sn; }
                if (c0 < 576) { bf16_t* o = MQ + (size_t)row * 576 + c0 + 4 * fq; *(u32x2*)o = (u32x2){cvt_pk(a[0], a[1]), cvt_pk(a[2], a[3])}; *(u32x2*)(o + 16) = (u32x2){cvt_pk(b[0], b[1]), cvt_pk(b[2], b[3])}; } }
            asm volatile("" ::: "memory"); }
    }
};
struct EpiKVup {
    static constexpr int PERM = 1; bf16_t* MK; bf16_t* MV; const LAS float* tbl;
    __device__ __forceinline__ void operator()(const Acc& acc, const pg8::Unit& u, int wr, int wc, int fr, int fq) const {
#pragma unroll
        EPI_ROWS(ai, m) { const int rl = ai * 128 + wr * 64 + m * 16 + fr, row = u.pm * 256 + rl; const float rs = tbl[u.seq * 256 + rl];
#pragma unroll
            for (int bj = 0; bj < 2; ++bj) { const int c = u.pn * 256 + bj * 128 + wc * 32 + 8 * fq; const f32x4 a = acc[ai][bj][m][0] * rs, b = acc[ai][bj][m][1] * rs;
                bf16_t* o = c < 384 ? MK + (size_t)row * 384 + c : MV + (size_t)row * 384 + (c - 384);
                *(u32x4*)o = (u32x4){cvt_pk(a[0], a[1]), cvt_pk(a[2], a[3]), cvt_pk(b[0], b[1]), cvt_pk(b[2], b[3])}; } }
    }
};
struct EpiResB {
    static constexpr int PERM = 2; bf16_t* X;
    __device__ __forceinline__ void operator()(const Acc& acc, const pg8::Unit& u, int wr, int wc, int fr, int fq) const {
        u32x4 r[2][4][2];
#pragma unroll
        EPI_ROWS(ai, m) { const bf16_t* rowp = X + (size_t)(u.pm * 256 + ai * 128 + wr * 64 + m * 16 + fr) * 1024 + u.pn * 256 + wc * 64 + 8 * fq;
            r[ai][m][0] = *(const u32x4*)rowp; r[ai][m][1] = *(const u32x4*)(rowp + 32); }
#pragma unroll
        EPI_ROWS(ai, m) { bf16_t* rowp = X + (size_t)(u.pm * 256 + ai * 128 + wr * 64 + m * 16 + fr) * 1024 + u.pn * 256 + wc * 64 + 8 * fq;
#pragma unroll
            for (int bj = 0; bj < 2; ++bj) { const f32x4 a = acc[ai][bj][m][0], b = acc[ai][bj][m][1]; const u32x4 q = r[ai][m][bj];
                *(u32x4*)(rowp + bj * 32) = (u32x4){cvt_pk(DN_ALPHA * bf2f(q[0] & 0xffffu) + a[0], DN_ALPHA * bf2f(q[0] >> 16) + a[1]), cvt_pk(DN_ALPHA * bf2f(q[1] & 0xffffu) + a[2], DN_ALPHA * bf2f(q[1] >> 16) + a[3]),
                                                       cvt_pk(DN_ALPHA * bf2f(q[2] & 0xffffu) + b[0], DN_ALPHA * bf2f(q[2] >> 16) + b[1]), cvt_pk(DN_ALPHA * bf2f(q[3] & 0xffffu) + b[2], DN_ALPHA * bf2f(q[3] >> 16) + b[3])}; } }
    }
};
struct EpiSH {
    static constexpr int PERM = 2; bf16_t* SH;
    __device__ __forceinline__ void operator()(const Acc& acc, const pg8::Unit& u, int wr, int wc, int fr, int fq) const {
#pragma unroll
        EPI_ROWS(ai, m) { bf16_t* rowp = SH + (size_t)(u.pm * 256 + ai * 128 + wr * 64 + m * 16 + fr) * 1024 + u.pn * 256 + wc * 64 + 8 * fq;
#pragma unroll
            for (int bj = 0; bj < 2; ++bj) { const f32x4 a = acc[ai][bj][m][0], b = acc[ai][bj][m][1];
                *(u32x4*)(rowp + bj * 32) = (u32x4){cvt_pk(a[0], a[1]), cvt_pk(a[2], a[3]), cvt_pk(b[0], b[1]), cvt_pk(b[2], b[3])}; } }
    }
};
struct EpiLogit {
    static constexpr int PERM = 0; float* LG;
    __device__ __forceinline__ void operator()(const Acc& acc, const pg8::Unit& u, int wr, int wc, int fr, int fq) const {
        if (wc >= 2) return;
#pragma unroll
        EPI_ROWS(ai, m) { float* o = LG + ((size_t)u.pn * T + (u.pm * 256 + ai * 128 + wr * 64 + m * 16 + fr)) * 64 + wc * 32 + 4 * fq;
            *(f32x4*)o = acc[ai][0][m][0]; *(f32x4*)(o + 16) = acc[ai][0][m][1]; }
    }
};
__device__ __forceinline__ float silu_f(float v) { return v / (1.0f + __expf(-v)); }
struct EpiG1 {
    static constexpr int PERM = 0; bf16_t* H; const float* GS; const LAS int* cnt; int shared_base; const LAS int* cb;
    __device__ __forceinline__ void operator()(const Acc& acc, const pg8::Unit& u, int wr, int wc, int fr, int fq) const {
        float g[2][4]; const int n = GS ? cnt[u.e] : 0x7fffffff;
#pragma unroll
        EPI_ROWS(ai, m) { const int idx = u.pm * 256 + ai * 128 + wr * 64 + m * 16 + fr; g[ai][m] = GS ? (idx < n ? GS[(size_t)u.e * T + idx] : 0.f) : 1.0f; }
#pragma unroll
        EPI_ROWS(ai, m) { const int idx = u.pm * 256 + ai * 128 + wr * 64 + m * 16 + fr; const float gg = g[ai][m];
            const f32x4 a0 = acc[ai][0][m][0], b0 = acc[ai][0][m][1] * gg, a1 = acc[ai][1][m][0], b1 = acc[ai][1][m][1] * gg;
            const auto lo = __builtin_amdgcn_permlane16_swap(cvt_pk(silu_f(a0[0]) * b0[0], silu_f(a0[1]) * b0[1]), cvt_pk(silu_f(a1[0]) * b1[0], silu_f(a1[1]) * b1[1]), false, false);
            const auto hi = __builtin_amdgcn_permlane16_swap(cvt_pk(silu_f(a0[2]) * b0[2], silu_f(a0[3]) * b0[3]), cvt_pk(silu_f(a1[2]) * b1[2], silu_f(a1[3]) * b1[3]), false, false);
            if (idx >= n) continue;
            const size_t hr = GS ? (size_t)(cb[u.e] + idx) : (size_t)(shared_base + idx);
            bf16_t* o = H + hr * 256 + u.pn * 128 + wc * 16 + 4 * (fq & ~1) + (fq & 1) * 64;
            *(u32x4*)o = (u32x4){lo[0], hi[0], lo[1], hi[1]}; }
    }
};
constexpr float YB_SCALE = 64.0f;
__device__ __forceinline__ unsigned pk_fp8x4(float a, float b, float c, float d) {
    a = __builtin_amdgcn_fmed3f(a, -448.f, 448.f); b = __builtin_amdgcn_fmed3f(b, -448.f, 448.f); c = __builtin_amdgcn_fmed3f(c, -448.f, 448.f); d = __builtin_amdgcn_fmed3f(d, -448.f, 448.f);
    int p = __builtin_amdgcn_cvt_pk_fp8_f32(a, b, 0, false); p = __builtin_amdgcn_cvt_pk_fp8_f32(c, d, p, true); return (unsigned)p; }
struct EpiG2 {
    static constexpr int PERM = 1; unsigned char* YB; const LAS int* cnt; const LAS int* cb;
    __device__ __forceinline__ void operator()(const Acc& acc, const pg8::Unit& u, int wr, int wc, int fr, int fq) const {
        const int n = cnt[u.e];
#pragma unroll
        EPI_ROWS(ai, m) { const int idx = u.pm * 256 + ai * 128 + wr * 64 + m * 16 + fr;
            const f32x4 a0 = acc[ai][0][m][0] * YB_SCALE, b0 = acc[ai][0][m][1] * YB_SCALE, a1 = acc[ai][1][m][0] * YB_SCALE, b1 = acc[ai][1][m][1] * YB_SCALE;
            const auto lo = __builtin_amdgcn_permlane16_swap(pk_fp8x4(a0[0], a0[1], a0[2], a0[3]), pk_fp8x4(a1[0], a1[1], a1[2], a1[3]), false, false);
            const auto hi = __builtin_amdgcn_permlane16_swap(pk_fp8x4(b0[0], b0[1], b0[2], b0[3]), pk_fp8x4(b1[0], b1[1], b1[2], b1[3]), false, false);
            if (idx >= n) continue;
            unsigned char* o = YB + (size_t)(cb[u.e] + idx) * 1024 + u.pn * 256 + wc * 32 + 8 * (fq & ~1) + (fq & 1) * 128;
            *(u32x4*)o = (u32x4){lo[0], hi[0], lo[1], hi[1]}; }
    }
};

struct MoeOrder {
    const LAS int* cnt; const LAS int* ubase;
    int npn, total, G, c; const unsigned* LST; int shift  ; unsigned lda; const LAS int* cb; const char* Bt; size_t bexp  ; unsigned ldb;
    __device__ __forceinline__ bool next(int i, pg8::Unit& u) const {
        const long L = (long)i * G + c; if (L >= total) return false;
        const int w = pg8::xcd_remap((int)L, total);
        int lo = 0, hi = 64;
        while (hi - lo > 1) { const int mid = (lo + hi) >> 1; if (ubase[mid] <= w) lo = mid; else hi = mid; }
        const int loc = w - ubase[lo]; u.e = lo; u.pn = loc % npn; u.pm = loc / npn; u.seq = i; return true;
    }
    __device__ __forceinline__ void a_voff(const pg8::Unit& u, int tid, unsigned (&v)[2][2]) const {
        const int n = cnt[u.e];
#pragma unroll
        for (int i = 0; i < 2; ++i) { int R, C; pg8::stage_rc(tid * 16 + i * 8192, R, C);
#pragma unroll
            for (int h = 0; h < 2; ++h) { int idx = u.pm * 256 + h * 128 + R; idx = idx < n ? idx : 0;
                if (shift < 0) { v[h][i] = ((unsigned)(cb[u.e] + idx) * lda + (unsigned)C) * 2u; }
                else { const unsigned ent = LST[(size_t)u.e * T + idx];
                    v[h][i] = ((ent >> shift) * lda + (unsigned)C) * 2u; } } }
    }
    __device__ __forceinline__ const char* b_base(const pg8::Unit& u) const { return Bt + (size_t)u.e * bexp + (size_t)u.pn * 256 * ldb * 2; }
};
struct RouterOrder {
    int G, c; const char* Bt;
    __device__ __forceinline__ bool next(int i, pg8::Unit& u) const { const long L = (long)i * G + c; if (L >= 256) return false; u.pm = (int)L >> 1; u.pn = (int)L & 1; u.e = 0; u.seq = i; return true; }
    __device__ __forceinline__ void a_voff(const pg8::Unit& u, int tid, unsigned (&v)[2][2]) const {
#pragma unroll
        for (int i = 0; i < 2; ++i) { int R, C; pg8::stage_rc(tid * 16 + i * 8192, R, C);
#pragma unroll
            for (int h = 0; h < 2; ++h) v[h][i] = ((unsigned)(u.pm * 256 + h * 128 + R) * 1024u + (unsigned)(u.pn * 512 + C)) * 2u; }
    }
    __device__ __forceinline__ const char* b_base(const pg8::Unit& u) const { return Bt + (size_t)u.pn * 512 * 2; }
};

__device__ __forceinline__ void phase_x_to_xb(const Frame& F, const float* x) {
    const size_t n8 = (size_t)T * 1024 / 8;
    for (size_t i = (size_t)F.vcu * NTHR + F.tid; i < n8; i += (size_t)F.G * NTHR) {
        const f32x4 a = __builtin_nontemporal_load((const f32x4*)(x + i * 8)), b = __builtin_nontemporal_load((const f32x4*)(x + i * 8 + 4));
        *(u32x4*)(fXB(F) + i * 8) = (u32x4){cvt_pk(a[0], a[1]), cvt_pk(a[2], a[3]), cvt_pk(b[0], b[1]), cvt_pk(b[2], b[3])};
    }
}

__device__ __forceinline__ void phase_rope_table(const Frame& F, const int* pos) {
    for (int i = F.vcu * NTHR + F.tid; i < T * 16; i += F.G * NTHR) { const int t = i >> 4, j = i & 15;
        const double inv = exp2(-(double)j * (13.287712379549449 / 16.0));
        const double rev = (double)pos[t] * inv * 0.15915494309189535; const float fr = (float)(rev - floor(rev));
        fROPE(F)[(size_t)t * 32 + j] = __builtin_amdgcn_cosf(fr); fROPE(F)[(size_t)t * 32 + 16 + j] = __builtin_amdgcn_sinf(fr); }
}

__device__ __forceinline__ void phase_inproj(const Frame& F) {
    pg8::DenseOrder S; S.init(T, LDU, F.G, (int)blockIdx.x, 1024, 0, fWin(F), 1024);
    EpiU E{fU(F)};
    pg8::gemm_phase<EpiU, pg8::DenseOrder>(F.lds, F.lds + LDS_VOFF, (const char*)fXB(F), 1024, 1024, S, E);
}

template <int WIDTH>
__device__ __forceinline__ void rms_tables(const Frame& F, const pg8::DenseOrder& S, LAS float* tbl, int col0) {
    pg8::Unit u;
    for (int i = 0; i < 4 && S.next(i, u); ++i) {
        const int r = F.tid >> 1, hf = F.tid & 1; const bf16_t* xr = fU(F) + (size_t)(u.pm * 256 + r) * LDU + col0 + hf * (WIDTH / 2);
        u32x4 v[WIDTH / 16];
#pragma unroll
        for (int c = 0; c < WIDTH / 16; ++c) v[c] = *(const u32x4*)(xr + 8 * c);
        float ss = 0.f;
#pragma unroll
        for (int c = 0; c < WIDTH / 16; ++c)
#pragma unroll
            for (int j = 0; j < 4; ++j) { const float lo = bf2f(v[c][j] & 0xffffu), hi = bf2f(v[c][j] >> 16); ss += lo * lo + hi * hi; }
        ss += __shfl_xor(ss, 1);
        if (hf == 0) tbl[i * 256 + r] = 1.0f / sqrtf(ss / (float)WIDTH + RMS_EPS);
    }
}

__device__ __forceinline__ void phase_mla_up(const Frame& F, const Params& p) {
    LAS float* tq = (LAS float*)(F.lds + LDS_TBL); LAS float* tkv = tq + 1024;
    pg8::DenseOrder Sq; Sq.init(T, 768, F.G, (int)blockIdx.x, LDU, U_CQ, fWuq(F), 256);
    pg8::DenseOrder Sk; Sk.init(T, 768, F.G, (int)blockIdx.x, LDU, U_CKV, fWukv(F), 256);
    rms_tables<256>(F, Sq, tq, U_CQ); rms_tables<128>(F, Sk, tkv, U_CKV);
    __syncthreads();
    { EpiQup E{fMQ(F), tq, fROPE(F)}; pg8::gemm_phase<EpiQup, pg8::DenseOrder>(F.lds, F.lds + LDS_VOFF, (const char*)fU(F), 256, 256, Sq, E); }
    { EpiKVup E{fMK(F), fMV(F), tkv}; pg8::gemm_phase<EpiKVup, pg8::DenseOrder>(F.lds, F.lds + LDS_VOFF, (const char*)fU(F), 256, 256, Sk, E); }
    for (int i = F.vcu * NTHR + F.tid; i < T * 16; i += F.G * NTHR) { const int t = i >> 4, j = i & 15;
        const float x1 = bf2f(fU(F)[(size_t)t * LDU + U_KR + j]), x2 = bf2f(fU(F)[(size_t)t * LDU + U_KR + 16 + j]);
        const float cs = fROPE(F)[(size_t)t * 32 + j], sn = fROPE(F)[(size_t)t * 32 + 16 + j];
        fKR(F)[(size_t)t * 32 + j] = (bf16_t)f2bf(x1 * cs - x2 * sn); fKR(F)[(size_t)t * 32 + 16 + j] = (bf16_t)f2bf(x2 * cs + x1 * sn); }
}

__device__ __forceinline__ void phase_outproj(const Frame& F) {
    pg8::DenseOrder S; S.init(T, 1024, F.G, (int)blockIdx.x, 1024, 0, fWout(F), 1024);
    EpiResB E{fXB(F)};
    pg8::gemm_phase<EpiResB, pg8::DenseOrder>(F.lds, F.lds + LDS_VOFF, (const char*)fAO(F), 1024, 1024, S, E);
}

__device__ __forceinline__ void phase_router_sharedg1(const Frame& F) {
    { RouterOrder S{F.G, (int)blockIdx.x, (const char*)fWr(F)}; EpiLogit E{fLG(F)}; pg8::gemm_phase<EpiLogit, RouterOrder>(F.lds, F.lds + LDS_VOFF, (const char*)fXB(F), 512, 1024, S, E); }
    { pg8::DenseOrder S; S.init(T, 512, F.G, (int)blockIdx.x, 1024, 0, fW13(F) + (size_t)64 * 512 * 1024, 1024);
      EpiG1 E{fH(F), nullptr, nullptr, T * 8, nullptr}; pg8::gemm_phase<EpiG1, pg8::DenseOrder>(F.lds, F.lds + LDS_VOFF, (const char*)fXB(F), 1024, 1024, S, E); }
}

__device__ __forceinline__ void phase_shared_g2(const Frame& F) {
    pg8::DenseOrder S; S.init(T, 1024, F.G, (int)blockIdx.x, 256, 0, fW2(F) + (size_t)64 * 1024 * 256, 256);
    EpiSH E{fSH(F)};
    pg8::gemm_phase<EpiSH, pg8::DenseOrder>(F.lds, F.lds + LDS_VOFF, (const char*)(fH(F) + (size_t)T * 8 * 256), 256, 256, S, E);
}

__device__ __forceinline__ void moe_tables(const Frame& F, int l, int npn, LAS int*& cnt, LAS int*& ubase) {
    cnt = (LAS int*)(F.lds + LDS_TBL); ubase = cnt + 64;
    __syncthreads();
    if (F.tid < 64) cnt[F.tid] = (int)F.ctl[CW_CNT + l * 64 + F.tid];
    __syncthreads();
    if (F.tid == 0) { int s = 0, c = 0; for (int e = 0; e < 64; ++e) { ubase[e] = s; s += ((cnt[e] + 255) >> 8) * npn; ubase[65 + e] = c; c += cnt[e]; } ubase[64] = s; }
    __syncthreads();
}
__device__ __forceinline__ void phase_moe_g1(const Frame& F, int l) {
    LAS int *cnt, *ubase; moe_tables(F, l, 2, cnt, ubase);
    MoeOrder S{cnt, ubase, 2, ubase[64], F.G, (int)blockIdx.x, fLST(F), 0, 1024u, ubase + 65, (const char*)fW13(F), (size_t)512 * 1024 * 2, 1024u};
    EpiG1 E{fH(F), fGS(F), cnt, 0, ubase + 65};
    pg8::gemm_phase<EpiG1, MoeOrder>(F.lds, F.lds + LDS_VOFF, (const char*)fXB(F), 1024, 1024, S, E);
}
__device__ __forceinline__ void phase_moe_g2(const Frame& F, int l) {
    LAS int *cnt, *ubase; moe_tables(F, l, 4, cnt, ubase);
    MoeOrder S{cnt, ubase, 4, ubase[64], F.G, (int)blockIdx.x, fLST(F), -1, 256u, ubase + 65, (const char*)fW2(F), (size_t)1024 * 256 * 2, 256u};
    EpiG2 E{fYB(F), cnt, ubase + 65};
    pg8::gemm_phase<EpiG2, MoeOrder>(F.lds, F.lds + LDS_VOFF, (const char*)fH(F), 256, 256, S, E);
}
constexpr int AT_K0 = 0, AT_KSZ = 12288, AT_V0 = 2 * AT_KSZ, AT_VSZ = 8192, AT_TBL = AT_V0 + 2 * AT_VSZ;

__device__ __forceinline__ float t5_dist_bias(const float* rel_bias, int head10, int d) {
    int bk;
    if (d < 16) bk = d;
    else { const float v = logf((float)d / 16.0f) / 4.852030263919617f * 16.0f; bk = 16 + (int)v; bk = bk < 31 ? bk : 31; }
    return rel_bias[bk * 10 + head10];
}

__device__ __forceinline__ void phase_dist_tables(const Frame& F, const float* rel_bias) {
    for (int i = F.vcu * NTHR + F.tid; i < 10 * 2112; i += F.G * NTHR) { const int h = i / 2112, e = i % 2112, d = e - 64; float v;
        if (h < 6) { const int mlt = (d <= 128 ? 1 : 0) + (((d & 3) == 0 && d <= 512) ? 1 : 0) + (((d & 15) == 0) ? 1 : 0);
            v = (d >= 0 && mlt) ? (t5_dist_bias(rel_bias, h, d) + logf((float)mlt)) * LOG2E : -INFINITY; }
        else v = d >= 0 ? t5_dist_bias(rel_bias, h, d) * LOG2E : 0.f;
        fDTAB(F)[i] = v; }
}

template <int MODE, int KS>
__device__ __forceinline__ void attn_unit(const Frame& F, const int b, const int qb,
                                          const bf16_t* __restrict__ Qp, const int ldq, const bf16_t* __restrict__ Kp, const int ldk, const bf16_t* __restrict__ KRp,
                                          const bf16_t* __restrict__ Vp, const int ldv, bf16_t* __restrict__ Op, const unsigned* __restrict__ maskp, const float* dtab, const int head10) {
    LAS unsigned char* lds = F.lds;
    const int tid = F.tid, lane = F.lane, w = F.wave, q32 = lane & 31, hh = lane >> 5;
    const size_t tb = (size_t)b * SEQ;
    const int qw0 = qb * 256 + 32 * w, qpos = qw0 + q32;
    const int ntile = 4 * (qb + 1);
    __syncthreads();
    if (MODE != 0) {
        LAS float* tblw = (LAS float*)(lds + AT_TBL); const float* src = dtab + head10 * 2112;
        for (int i = tid; i < SEQ + 64; i += NTHR) tblw[i] = src[i];
    }
    bf16x8 qf[KS];
    { const bf16_t* qr = Qp + (tb + qpos) * (size_t)ldq + 8 * hh;
#pragma unroll
      for (int ks = 0; ks < KS; ++ks) { if (MODE == 0 && ks >= 4) qf[ks] = *(const bf16x8*)(qr + 16 * ks); else qf[ks] = *(const bf16x8*)(qr + 16 * ks); } }
    const int skey = tid >> 3, sch = tid & 7;
    const bf16_t* kg = Kp + (tb + skey) * (size_t)ldk + 8 * sch;
    const bf16_t* vg = Vp + (tb + skey) * (size_t)ldv + 8 * sch;
    const bf16_t* rg = (MODE == 0) ? KRp + (tb + (tid >> 2)) * 32 + 8 * (tid & 3) : nullptr;
    const int kdst = sch * 1024 + ((skey ^ sch) << 4);
    const int rdst = (8 + (tid & 3)) * 1024 + ((((tid >> 2) & 63) ^ (tid & 3)) << 4);
    const int vdst = (sch >> 2) * 4096 + skey * 64 + (sch & 3) * 16;
    const unsigned* mg = (MODE == 1) ? maskp + (tb + qpos) * 64 : nullptr;
    u32x4 kreg, vreg, rreg; u32x2 mw = {0u, 0u}, mwn = {0u, 0u};
    kreg = *(const u32x4*)kg; vreg = *(const u32x4*)vg; if (MODE == 0 && tid < 256) rreg = *(const u32x4*)rg;
    if (MODE == 1) mw = *(const u32x2*)mg;
    *(LAS u32x4*)(lds + AT_K0 + kdst) = kreg; *(LAS u32x4*)(lds + AT_V0 + vdst) = vreg; if (MODE == 0 && tid < 256) *(LAS u32x4*)(lds + AT_K0 + rdst) = rreg;
    __syncthreads();
    f32x16 o0, o1;
#pragma unroll
    for (int r = 0; r < 16; ++r) { o0[r] = 0.f; o1[r] = 0.f; }
    float lsum = 0.f; bool started = false;
    f32x16 negm;
#pragma unroll
    for (int r = 0; r < 16; ++r) negm[r] = 0.f;
    const LAS float* tbl = (const LAS float*)(lds + AT_TBL);
    for (int t = 0; t < ntile; ++t) {
        const int buf = t & 1;
        if (t + 1 < ntile) { kreg = *(const u32x4*)(kg + (size_t)(t + 1) * 64 * ldk); vreg = *(const u32x4*)(vg + (size_t)(t + 1) * 64 * ldv);
            if (MODE == 0 && tid < 256) rreg = *(const u32x4*)(rg + (size_t)(t + 1) * 64 * 32);
            if (MODE == 1) mwn = *(const u32x2*)(mg + 2 * (t + 1)); }
        const int k0 = 64 * t;
        if (k0 <= qw0 + 31) {
            const LAS unsigned char* kb = lds + AT_K0 + buf * AT_KSZ; const LAS unsigned char* vb = lds + AT_V0 + buf * AT_VSZ;
            f32x16 s0, s1;
#pragma unroll
            for (int ks = 0; ks < KS; ++ks) { const int c = 2 * ks + hh;
                const bf16x8 a0 = *(const LAS bf16x8*)(kb + c * 1024 + ((q32 ^ (c & 7)) << 4));
                const bf16x8 a1 = *(const LAS bf16x8*)(kb + c * 1024 + (((32 + q32) ^ (c & 7)) << 4));
                if (ks == 0) { s0 = __builtin_amdgcn_mfma_f32_32x32x16_bf16(a0, qf[0], negm, 0, 0, 0); s1 = __builtin_amdgcn_mfma_f32_32x32x16_bf16(a1, qf[0], negm, 0, 0, 0); }
                else { s0 = __builtin_amdgcn_mfma_f32_32x32x16_bf16(a0, qf[ks], s0, 0, 0, 0); s1 = __builtin_amdgcn_mfma_f32_32x32x16_bf16(a1, qf[ks], s1, 0, 0, 0); } }
            if (MODE == 0) { if (k0 + 63 > qw0) {
#pragma unroll
                for (int r = 0; r < 16; ++r) { const int key = k0 + (r & 3) + 8 * (r >> 2) + 4 * hh; if (key > qpos) s0[r] = -INFINITY; if (key + 32 > qpos) s1[r] = -INFINITY; } } }
            if (MODE == 1) { const unsigned w0 = mw[0] >> (4 * hh), w1 = mw[1] >> (4 * hh); const LAS float* tp = tbl + (qpos - k0 - 4 * hh + 64);
#pragma unroll
                for (int r = 0; r < 16; ++r) { const int bit = (r & 3) + 8 * (r >> 2);
                    const float t0 = tp[-bit], t1 = tp[-bit - 32];
                    s0[r] = ((w0 >> bit) & 1u) ? s0[r] + t0 : -INFINITY; s1[r] = ((w1 >> bit) & 1u) ? s1[r] + t1 : -INFINITY; } }
            if (MODE == 2) { const LAS float* tp = tbl + (qpos - k0 - 4 * hh + 64);
#pragma unroll
                for (int r = 0; r < 16; ++r) { const int bit = (r & 3) + 8 * (r >> 2); s0[r] += tp[-bit]; s1[r] += tp[-bit - 32]; } }
            float mx = fmaxf(s0[0], s1[0]);
#pragma unroll
            for (int r = 1; r < 16; ++r) mx = fmaxf(mx, fmaxf(s0[r], s1[r]));
            mx = fmaxf(mx, __shfl_xor(mx, 32));
            const bool need = (mx > 8.0f) || (!started && mx > -INFINITY);
            if (__any(need)) {
                const float delta = need ? mx : 0.f, alpha = __builtin_amdgcn_exp2f(-delta);
                lsum *= alpha;
#pragma unroll
                for (int r = 0; r < 16; ++r) { o0[r] *= alpha; o1[r] *= alpha; negm[r] -= delta; s0[r] -= delta; s1[r] -= delta; }
            }
            started = started || (mx > -INFINITY);
            float ps = 0.f;
#pragma unroll
            for (int r = 0; r < 16; ++r) { s0[r] = __builtin_amdgcn_exp2f(s0[r]); s1[r] = __builtin_amdgcn_exp2f(s1[r]); ps += s0[r] + s1[r]; }
            lsum += ps;
            bf16x8 pb[4];
#pragma unroll
            for (int s2 = 0; s2 < 2; ++s2) {
                u32x4 a = {cvt_pk(s0[8 * s2 + 0], s0[8 * s2 + 1]), cvt_pk(s0[8 * s2 + 2], s0[8 * s2 + 3]), cvt_pk(s0[8 * s2 + 4], s0[8 * s2 + 5]), cvt_pk(s0[8 * s2 + 6], s0[8 * s2 + 7])};
                u32x4 c = {cvt_pk(s1[8 * s2 + 0], s1[8 * s2 + 1]), cvt_pk(s1[8 * s2 + 2], s1[8 * s2 + 3]), cvt_pk(s1[8 * s2 + 4], s1[8 * s2 + 5]), cvt_pk(s1[8 * s2 + 6], s1[8 * s2 + 7])};
                pb[s2] = __builtin_bit_cast(bf16x8, a); pb[2 + s2] = __builtin_bit_cast(bf16x8, c); }
            const int vlane = (4 * hh + ((lane & 15) >> 2)) * 64 + (((lane >> 4) & 1) * 16 + 4 * (lane & 3)) * 2;
#pragma unroll
            for (int dt = 0; dt < 2; ++dt) {
#pragma unroll
                for (int kk = 0; kk < 4; ++kk) {
                    const LAS unsigned char* va = vb + dt * 4096 + kk * 16 * 64 + vlane;
                    const s16x4 lo = __builtin_bit_cast(s16x4, __builtin_amdgcn_ds_read_tr16_b64_v4i16((LAS s16x4*)(va)));
                    const s16x4 hi = __builtin_bit_cast(s16x4, __builtin_amdgcn_ds_read_tr16_b64_v4i16((LAS s16x4*)(va + 8 * 64)));
                    const bf16x8 vf = {lo[0], lo[1], lo[2], lo[3], hi[0], hi[1], hi[2], hi[3]};
                    if (dt == 0) o0 = __builtin_amdgcn_mfma_f32_32x32x16_bf16(vf, pb[kk], o0, 0, 0, 0);
                    else o1 = __builtin_amdgcn_mfma_f32_32x32x16_bf16(vf, pb[kk], o1, 0, 0, 0); } }
        }
        if (t + 1 < ntile) { const int nb = (t + 1) & 1;
            *(LAS u32x4*)(lds + AT_K0 + nb * AT_KSZ + kdst) = kreg; *(LAS u32x4*)(lds + AT_V0 + nb * AT_VSZ + vdst) = vreg;
            if (MODE == 0 && tid < 256) *(LAS u32x4*)(lds + AT_K0 + nb * AT_KSZ + rdst) = rreg;
            if (MODE == 1) mw = mwn; }
        __syncthreads();
    }
    const float ltot = lsum + __shfl_xor(lsum, 32);
    const float inv = ltot > 0.f ? 1.0f / ltot : 0.f;
    bf16_t* orow = Op + (tb + qpos) * 1024 + 4 * hh;
#pragma unroll
    for (int g = 0; g < 4; ++g) {
        *(u32x2*)(orow + 8 * g) = (u32x2){cvt_pk(o0[4 * g] * inv, o0[4 * g + 1] * inv), cvt_pk(o0[4 * g + 2] * inv, o0[4 * g + 3] * inv)};
        *(u32x2*)(orow + 32 + 8 * g) = (u32x2){cvt_pk(o1[4 * g] * inv, o1[4 * g + 1] * inv), cvt_pk(o1[4 * g + 2] * inv, o1[4 * g + 3] * inv)}; }
}

__device__ __forceinline__ void phase_attention(const Frame& F, const Params& p, const int l) {
    int slice = 0;
    constexpr int KTOT = (65 * 384 + 2047) / 2048 + 1;
    for (int L = (int)blockIdx.x; L < 2048; L += F.G) {
        const int level = L >> 8, idx = ((L & 255) + 37 * level) & 255, qb = 7 - level;
        if (idx < 96) { const int b = idx / 6, h = idx % 6;
            attn_unit<0, 6>(F, b, qb, fMQ(F) + h * 96, 576, fMK(F) + h * 64, 384, fKR(F), fMV(F) + h * 64, 384, fAO(F) + 640 + h * 64, nullptr, nullptr, 0);
        } else if (idx < 160) { const int j = idx - 96, b = j >> 2, h = j & 3;
            attn_unit<1, 4>(F, b, qb, fU(F) + U_SQ + h * 64, LDU, fU(F) + U_SK + h * 64, LDU, nullptr, fU(F) + U_SV + h * 64, LDU, fAO(F) + 384 + h * 64, fMASK(F), fDTAB(F), 6 + h);
        } else { const int j = idx - 160, b = j / 6, h = j % 6;
            attn_unit<2, 4>(F, b, qb, fU(F) + U_DQ + h * 64, LDU, fU(F) + U_DK + h * 64, LDU, nullptr, fU(F) + U_DV + h * 64, LDU, fAO(F) + h * 64, nullptr, fDTAB(F), h);
        }
        convert_experts(F, p, l, 2 * slice, 2 * slice + 2, 65536); ++slice;
    }
    { const int NGW = F.G * NWAVES; const int kmax = (65 * 384 + NGW - 1) / NGW; if (2 * slice < kmax) convert_experts(F, p, l, 2 * slice, kmax, 65536); }
}
__device__ __forceinline__ int wave_isum(int c) {
    c += __builtin_amdgcn_update_dpp(0, c, 0x128, 0xf, 0xf, false);
    c += __builtin_amdgcn_update_dpp(0, c, 0x124, 0xf, 0xf, false);
    c += __builtin_amdgcn_update_dpp(0, c, 0x122, 0xf, 0xf, false);
    c += __builtin_amdgcn_update_dpp(0, c, 0x121, 0xf, 0xf, false);
    return __builtin_amdgcn_readlane(c, 0) + __builtin_amdgcn_readlane(c, 16) + __builtin_amdgcn_readlane(c, 32) + __builtin_amdgcn_readlane(c, 48);
}
__device__ __forceinline__ float wave_fmax(float v) {
#define DPPF(x, c) __builtin_bit_cast(float, __builtin_amdgcn_update_dpp(0, __builtin_bit_cast(int, x), c, 0xf, 0xf, false))
    v = fmaxf(v, DPPF(v, 0x128)); v = fmaxf(v, DPPF(v, 0x124)); v = fmaxf(v, DPPF(v, 0x122)); v = fmaxf(v, DPPF(v, 0x121));
    const int i = __builtin_bit_cast(int, v);
    return fmaxf(fmaxf(__builtin_bit_cast(float, __builtin_amdgcn_readlane(i, 0)), __builtin_bit_cast(float, __builtin_amdgcn_readlane(i, 16))), fmaxf(__builtin_bit_cast(float, __builtin_amdgcn_readlane(i, 32)), __builtin_bit_cast(float, __builtin_amdgcn_readlane(i, 48))));
}
__device__ __forceinline__ float wave_fmin(float v) {
    v = fminf(v, DPPF(v, 0x128)); v = fminf(v, DPPF(v, 0x124)); v = fminf(v, DPPF(v, 0x122)); v = fminf(v, DPPF(v, 0x121));
    const int i = __builtin_bit_cast(int, v);
    return fminf(fminf(__builtin_bit_cast(float, __builtin_amdgcn_readlane(i, 0)), __builtin_bit_cast(float, __builtin_amdgcn_readlane(i, 16))), fminf(__builtin_bit_cast(float, __builtin_amdgcn_readlane(i, 32)), __builtin_bit_cast(float, __builtin_amdgcn_readlane(i, 48))));
#undef DPPF
}
template <int NJ> __device__ __forceinline__ int count_ge(const float (&x)[32], const float v) {
    unsigned acc = 0u;
#pragma unroll
    for (int j = 0; j < NJ; ++j) acc = __builtin_amdgcn_alignbit(acc, __builtin_bit_cast(unsigned, x[j] - v), 31);
    return 64 * NJ - wave_isum(__builtin_popcount(acc));
}
template <int NJ> __device__ __forceinline__ unsigned long long select_row(const LAS float* srow, const int q, const int lane) {
    float x[32];
#pragma unroll
    for (int j = 0; j < NJ; ++j) x[j] = srow[64 * j];
#pragma unroll
    for (int j = 0; j < NJ; ++j) x[j] = (64 * j + lane <= q) ? x[j] : -INFINITY;
    float mx = -INFINITY, mn = INFINITY;
#pragma unroll
    for (int j = 0; j < NJ; ++j) { mx = fmaxf(mx, x[j]); mn = fminf(mn, x[j] == -INFINITY ? INFINITY : x[j]); }
    float lo = wave_fmin(mn), hi = wave_fmax(mx);
    float thr = 0.f; bool exact = false;
    int c_hi = count_ge<NJ>(x, hi), c_lo = q + 1;
    if (c_hi < 256) {
#pragma unroll 1
        for (int it = 0; it < 320; ++it) {
            float mid = 0.5f * lo + 0.5f * hi;
            if (!(mid > lo && mid < hi)) break;
            if (false) { const float fr = ((float)(c_lo - 256) + 0.5f) / (float)(c_lo - c_hi), tc = lo + fr * (hi - lo); if (tc > lo && tc < hi) mid = tc; }
            const int c = count_ge<NJ>(x, mid);
            if (c == 256) { thr = mid; exact = true; break; }
            if (c > 256) { lo = mid; c_lo = c; } else { hi = mid; c_hi = c; }
        }
    } else { lo = hi; hi = INFINITY; c_hi = 0; }
    unsigned long long myw = 0ull;
    if (exact) {
#pragma unroll
        for (int j = 0; j < NJ; ++j) { const unsigned long long sel = __ballot(x[j] >= thr); if (lane == j) myw = sel; }
    } else {
        int need = 256 - c_hi;
#pragma unroll 1
        for (int j = 0; j < NJ; ++j) { float xj = x[0];
#pragma unroll
            for (int k = 1; k < NJ; ++k) xj = (k == j) ? x[k] : xj;
            const unsigned long long eq = __ballot(xj == lo); const int rank = __builtin_popcountll(eq & ((1ull << lane) - 1ull));
            const unsigned long long sel = __ballot(xj >= hi) | __ballot(xj == lo && rank < need); const int ne = __builtin_popcountll(eq); need = need > ne ? need - ne : 0;
            if (lane == j) myw = sel; }
    }
    return myw;
}
constexpr int IX_PITCH = 2052, IX_IQ = 16 * IX_PITCH * 4, IX_IW = IX_IQ + 16384;
typedef float f32x4_t __attribute__((ext_vector_type(4)));
__device__ __forceinline__ void indexer_block(const Frame& F, const int b, const int qk) {
    LAS unsigned char* lds = F.lds;
    const int tid = F.tid, lane = F.lane, w = F.wave, q16 = lane & 15, kg = lane >> 4;
    const size_t tb = (size_t)b * SEQ; const int q0 = 16 * qk, ntile = qk + 1;
    LAS float* sl = (LAS float*)lds;
    __syncthreads();
#pragma unroll
    for (int i = 0; i < 2; ++i) { const int idx = tid + 512 * i, q = idx >> 6, c = idx & 63;
        *(LAS u32x4*)(lds + IX_IQ + c * 256 + q * 16) = *(const u32x4*)(fU(F) + (tb + q0 + q) * LDU + U_IQ + 8 * c); }
    if (tid < 128) { const int q = tid >> 3, h8 = tid & 7; ((LAS float*)(lds + IX_IW))[h8 * 16 + q] = bf2f(fU(F)[(tb + q0 + q) * LDU + U_IW + h8]); }
    __syncthreads();
    const int qpos = q0 + q16;
    bf16x8 kf[2];
    if (w < ntile) { const bf16_t* kr = fU(F) + (tb + 16 * w + q16) * LDU + U_IK + 8 * kg; kf[0] = *(const bf16x8*)kr; kf[1] = *(const bf16x8*)(kr + 32); }
#pragma unroll 1
    for (int ti = w; ti < ntile; ti += NWAVES) {
        const int key0 = 16 * ti;
        bf16x8 kn[2];
        { const int tn = (ti + NWAVES < ntile) ? ti + NWAVES : ti; const bf16_t* kr = fU(F) + (tb + 16 * tn + q16) * LDU + U_IK + 8 * kg; kn[0] = *(const bf16x8*)kr; kn[1] = *(const bf16x8*)(kr + 32); }
        f32x4 sc = {0.f, 0.f, 0.f, 0.f};
#pragma unroll
        for (int h8 = 0; h8 < 8; ++h8) {
            const float iwq = ((const LAS float*)(lds + IX_IW))[h8 * 16 + q16];
            f32x4 a = {0.f, 0.f, 0.f, 0.f};
#pragma unroll
            for (int ks = 0; ks < 2; ++ks) { const bf16x8 qv = *(const LAS bf16x8*)(lds + IX_IQ + (8 * h8 + 4 * ks + kg) * 256 + q16 * 16);
                a = __builtin_amdgcn_mfma_f32_16x16x32_bf16(kf[ks], qv, a, 0, 0, 0); }
#pragma unroll
            for (int r = 0; r < 4; ++r) sc[r] += iwq * fmaxf(a[r], 0.f);
        }
        if (ti == qk) {
#pragma unroll
            for (int r = 0; r < 4; ++r) { const int key = key0 + 4 * kg + r; if (key > qpos) sc[r] = -INFINITY; } }
        *(LAS f32x4*)(sl + q16 * IX_PITCH + key0 + 4 * kg) = sc;
        kf[0] = kn[0]; kf[1] = kn[1];
    }
    __syncthreads();
#pragma unroll 1
    for (int rr = 0; rr < 2; ++rr) {
        const int ql = w + 8 * rr, q = q0 + ql, n = q + 1;
        unsigned long long myw = 0ull;
        if (n <= 256) {
            if (lane < 32) { const int lo = 64 * lane; myw = (lo + 63 <= q) ? ~0ull : (lo <= q ? ((1ull << (q - lo + 1)) - 1ull) : 0ull); }
        } else {
            const LAS float* srow = sl + ql * IX_PITCH + lane; const int nj = (q0 + 16 + 63) >> 6;
            if (nj <= 8) myw = select_row<8>(srow, q, lane); else if (nj <= 16) myw = select_row<16>(srow, q, lane); else if (nj <= 24) myw = select_row<24>(srow, q, lane); else myw = select_row<32>(srow, q, lane);
        }
        if (lane < 32) *(unsigned long long*)(fMASK(F) + (tb + q) * 64 + 2 * lane) = myw;
    }
}
__device__ __forceinline__ void phase_indexer(const Frame& F) {
    for (int L = (int)blockIdx.x; L < 1024; L += F.G) { const int b = L >> 6, j = L & 63;
#pragma unroll 1
        for (int s = 0; s < 2; ++s) indexer_block(F, b, s ? j : 127 - j); }
}

__device__ __forceinline__ void ln_finish(const Frame& F, float (&v)[16], const float* g, const float* bta, bf16_t* ob, float* of) {
    float s = 0.f;
#pragma unroll
    for (int j = 0; j < 16; ++j) s += v[j];
    const float mean = wave_sum(s) * (1.f / 1024.f); float s2 = 0.f;
#pragma unroll
    for (int j = 0; j < 16; ++j) { v[j] -= mean; s2 += v[j] * v[j]; }
    const float rstd = 1.f / sqrtf(wave_sum(s2) * (1.f / 1024.f) + LN_EPS);
    const int c0 = 16 * F.lane; float o[16];
#pragma unroll
    for (int q4 = 0; q4 < 4; ++q4) { const f32x4 gg = *(const f32x4*)(g + c0 + 4 * q4), bb = *(const f32x4*)(bta + c0 + 4 * q4);
#pragma unroll
        for (int j = 0; j < 4; ++j) o[4 * q4 + j] = v[4 * q4 + j] * rstd * gg[j] + bb[j]; }
    if (ob) { *(u32x4*)(ob + c0) = (u32x4){cvt_pk(o[0], o[1]), cvt_pk(o[2], o[3]), cvt_pk(o[4], o[5]), cvt_pk(o[6], o[7])};
              *(u32x4*)(ob + c0 + 8) = (u32x4){cvt_pk(o[8], o[9]), cvt_pk(o[10], o[11]), cvt_pk(o[12], o[13]), cvt_pk(o[14], o[15])}; }
    if (of) {
#pragma unroll
        for (int q4 = 0; q4 < 4; ++q4) *(f32x4*)(of + c0 + 4 * q4) = (f32x4){o[4 * q4], o[4 * q4 + 1], o[4 * q4 + 2], o[4 * q4 + 3]}; }
}
__device__ __forceinline__ void ld16(float (&v)[16], const bf16_t* row, int lane, float sc) {
#pragma unroll
    for (int h = 0; h < 2; ++h) { const u32x4 q = *(const u32x4*)(row + 16 * lane + 8 * h);
#pragma unroll
        for (int j = 0; j < 4; ++j) { v[8 * h + 2 * j] = sc * bf2f(q[j] & 0xffffu); v[8 * h + 2 * j + 1] = sc * bf2f(q[j] >> 16); } }
}
__device__ __forceinline__ void add16(float (&v)[16], const bf16_t* row, int lane) {
#pragma unroll
    for (int h = 0; h < 2; ++h) { const u32x4 q = *(const u32x4*)(row + 16 * lane + 8 * h);
#pragma unroll
        for (int j = 0; j < 4; ++j) { v[8 * h + 2 * j] += bf2f(q[j] & 0xffffu); v[8 * h + 2 * j + 1] += bf2f(q[j] >> 16); } }
}
typedef float f32x2v __attribute__((ext_vector_type(2)));
__device__ __forceinline__ void add16_fp8(float (&v)[16], const unsigned char* row, int lane) {
    const u32x4 q = __builtin_nontemporal_load((const u32x4*)(row + 16 * lane));
#pragma unroll
    for (int j = 0; j < 4; ++j) { const f32x2v a = __builtin_amdgcn_cvt_pk_f32_fp8((int)q[j], false), b = __builtin_amdgcn_cvt_pk_f32_fp8((int)q[j], true);
        v[4 * j] += a[0]; v[4 * j + 1] += a[1]; v[4 * j + 2] += b[0]; v[4 * j + 3] += b[1]; }
}
__device__ __forceinline__ void phase_ln1(const Frame& F, const Params& p, int l) {
    const int gw = F.vcu * NWAVES + F.wave, NGW = F.G * NWAVES;
    for (int m = gw; m < T; m += NGW) { bf16_t* row = fXB(F) + (size_t)m * 1024; float v[16]; ld16(v, row, F.lane, 1.0f);
        ln_finish(F, v, p.ln1_g + l * 1024, p.ln1_b + l * 1024, row, nullptr); }
}
__device__ __forceinline__ void phase_ln2(const Frame& F, const Params& p, int l) {
    const int gw = F.vcu * NWAVES + F.wave, NGW = F.G * NWAVES; const bool lastl = (l == NL - 1);
    LAS int* cb = (LAS int*)(F.lds + LDS_TBL);
    __syncthreads();
    if (F.tid == 0) { int c = 0; for (int e = 0; e < 64; ++e) { cb[e] = c; c += (int)F.ctl[CW_CNT + l * 64 + e]; } }
    __syncthreads();
    for (int m = gw; m < T; m += NGW) { bf16_t* row = fXB(F) + (size_t)m * 1024;
        const unsigned pkv = fPK(F)[(size_t)m * 8 + (F.lane & 7)];
        float r[16];
#pragma unroll
        for (int j = 0; j < 16; ++j) r[j] = 0.f;
#pragma unroll
        for (int k = 0; k < 8; ++k) { const unsigned pe = (unsigned)__builtin_amdgcn_readlane((int)pkv, k); const int srow = cb[pe >> 16] + (int)(pe & 0xffffu);
            add16_fp8(r, fYB(F) + (size_t)srow * 1024, F.lane); }
        float v[16]; ld16(v, row, F.lane, DN_ALPHA); add16(v, fSH(F) + (size_t)m * 1024, F.lane);
#pragma unroll
        for (int j = 0; j < 16; ++j) v[j] += r[j] * (1.0f / YB_SCALE);
        ln_finish(F, v, p.ln2_g + l * 1024, p.ln2_b + l * 1024, lastl ? nullptr : row, lastl ? p.out + (size_t)m * 1024 : nullptr); }
}

__device__ __forceinline__ void phase_route(const Frame& F, const Params& p, int l) {
    LAS int* lcnt = (LAS int*)(F.lds + LDS_TBL + 8192); LAS int* lbase = lcnt + 64;
    const float* rb = p.router_b + l * 64;
    const int nth = F.G * NTHR, iters = (T + nth - 1) / nth;
    for (int it = 0; it < iters; ++it) {
        const int t = it * nth + F.vcu * NTHR + F.tid; const bool act = t < T;
        __syncthreads();
        if (F.tid < 64) lcnt[F.tid] = 0;
        __syncthreads();
        int ek[8], pk[8]; float gk[8];
        if (act) {
            float sel[64];
            const float* l0 = fLG(F) + (size_t)t * 64; const float* l1 = fLG(F) + ((size_t)T + t) * 64;
#pragma unroll
            for (int e4 = 0; e4 < 16; ++e4) { const f32x4 a = *(const f32x4*)(l0 + 4 * e4), c = *(const f32x4*)(l1 + 4 * e4), bb = *(const f32x4*)(rb + 4 * e4);
#pragma unroll
                for (int j = 0; j < 4; ++j) sel[4 * e4 + j] = 1.0f / (1.0f + __expf(-(a[j] + c[j]))) + bb[j]; }
            float gs = 0.f;
#pragma unroll
            for (int k = 0; k < 8; ++k) { float best = -INFINITY; int bi = 0;
#pragma unroll
                for (int e = 0; e < 64; ++e) { const bool gt = sel[e] > best; best = gt ? sel[e] : best; bi = gt ? e : bi; }
#pragma unroll
                for (int e = 0; e < 64; ++e) sel[e] = (e == bi) ? -INFINITY : sel[e];
                ek[k] = bi; gk[k] = best - rb[bi]; gs += gk[k]; }
            const float sc = ROUTED_SCALE / gs;
#pragma unroll
            for (int k = 0; k < 8; ++k) { gk[k] *= sc; pk[k] = __hip_atomic_fetch_add(lcnt + ek[k], 1, __ATOMIC_RELAXED, __HIP_MEMORY_SCOPE_WORKGROUP); }
        }
        __syncthreads();
        if (F.tid < 64) { const int c = lcnt[F.tid]; lbase[F.tid] = c ? (int)__hip_atomic_fetch_add(F.ctl + CW_CNT + l * 64 + F.tid, (unsigned)c, __ATOMIC_RELAXED, __HIP_MEMORY_SCOPE_AGENT) : 0; }
        __syncthreads();
        if (act) {
#pragma unroll
            for (int k = 0; k < 8; ++k) { const int pos = lbase[ek[k]] + pk[k]; fLST(F)[(size_t)ek[k] * T + pos] = (unsigned)t; fGS(F)[(size_t)ek[k] * T + pos] = gk[k]; fPK(F)[(size_t)t * 8 + k] = ((unsigned)ek[k] << 16) | (unsigned)pos; } }
    }
}
__device__ __forceinline__ void frame_init(Frame& F, const Params& p, unsigned char* lds) {
    F.lds = (LAS unsigned char*)lds; F.MISC = (volatile LAS unsigned*)(F.lds + LDS_MISC);
    F.tid = threadIdx.x; F.lane = F.tid & 63; F.wave = __builtin_amdgcn_readfirstlane(F.tid >> 6);
    F.G = gridDim.x; { const int bx = blockIdx.x; F.vcu = (F.G % 8 == 0) ? (bx % 8) * (F.G / 8) + bx / 8 : bx; }
    F.ws = p.ws; F.ctl = (unsigned*)(p.ws + WS_CTL);
}

constexpr int NPHASE = 1 + 10 * NL;
__global__ void __launch_bounds__(NTHR, 2) mega(Params p) {
    extern __shared__ __attribute__((aligned(16))) unsigned char lds_raw[];
    Frame F; frame_init(F, p, lds_raw);
    if (F.tid < 64) F.MISC[F.tid] = 0u;
    __syncthreads();
    const int lo = p.ph_lo, hi = p.ph_hi;
    XcdBarrier bar; bar.bar = F.ctl + CW_BAR; bar.x = 0; bar.st = F.MISC + 8;
    if (hi - lo > 1) bar = xcd_barrier_post(F.ctl + CW_BAR, F.MISC + 8);
#define IN(k) (lo <= (k) && (k) < hi)
#define SEAM(k) do { if (IN(k) && IN((k) + 1)) xcd_barrier(bar); } while (0)
    if (IN(0)) { const Frame Fp = phase_frame(F); phase_x_to_xb(Fp, p.x); phase_rope_table(Fp, p.pos); phase_dist_tables(Fp, p.rel_bias); convert_small(Fp, p, 0); }
    SEAM(0);
    for (int l = 0; l < NL; ++l) {
        const int pb = 1 + 10 * l;
        if (IN(pb + 0)) phase_inproj(phase_frame(F));
        SEAM(pb + 0);
        if (IN(pb + 1)) { phase_indexer(phase_frame(F)); phase_mla_up(phase_frame(F), p); }
        SEAM(pb + 1);
        if (IN(pb + 2)) phase_attention(phase_frame(F), p, l);
        SEAM(pb + 2);
        if (IN(pb + 3)) phase_outproj(phase_frame(F));
        SEAM(pb + 3);
        if (IN(pb + 4)) phase_ln1(phase_frame(F), p, l);
        SEAM(pb + 4);
        if (IN(pb + 5)) phase_router_sharedg1(phase_frame(F));
        SEAM(pb + 5);
        if (IN(pb + 6)) phase_route(phase_frame(F), p, l);
        SEAM(pb + 6);
        if (IN(pb + 7)) phase_moe_g1(phase_frame(F), l);
        SEAM(pb + 7);
        if (IN(pb + 8)) { phase_moe_g2(phase_frame(F), l); phase_shared_g2(phase_frame(F)); }
        SEAM(pb + 8);
        if (IN(pb + 9)) { phase_ln2(phase_frame(F), p, l); if (l + 1 < NL) convert_small(phase_frame(F), p, l + 1); }
        SEAM(pb + 9);
    }
#undef IN
#undef SEAM
}
#ifndef DBG
#define DBG 0
#endif
#if DBG
#endif
extern "C" void kernel_launch(void* const* d_in, const int* in_sizes, int n_in, void* d_out, int out_size, void* d_ws, size_t ws_size, hipStream_t stream) {
    static int grid = 0;
    if (grid == 0) {
        if (n_in != 21 || out_size != T * DM || ws_size < WS_END) { fprintf(stderr, "kernel_launch: unexpected problem (n_in %d, out %d, ws %zu < %zu); nothing launched\n", n_in, out_size, ws_size, (size_t)WS_END); grid = -1; return; }
        int dev = 0, cus = 0, per_cu = 0;
        if (hipGetDevice(&dev) != hipSuccess || hipDeviceGetAttribute(&cus, hipDeviceAttributeMultiprocessorCount, dev) != hipSuccess) { grid = -1; return; }
        if (hipFuncSetAttribute((const void*)mega, hipFuncAttributeMaxDynamicSharedMemorySize, LDS_BYTES) != hipSuccess) { fprintf(stderr, "kernel_launch: hipFuncSetAttribute failed\n"); grid = -1; return; }
        if (hipOccupancyMaxActiveBlocksPerMultiprocessor(&per_cu, (const void*)mega, NTHR, LDS_BYTES) != hipSuccess || per_cu < 1) { fprintf(stderr, "kernel_launch: occupancy query says %d\n", per_cu); (void)hipGetLastError(); per_cu = 1; }
        grid = cus > 256 ? 256 : cus;
    }
    if (grid < 0) return;
    (void)hipMemsetAsync((char*)d_ws + WS_CTL, 0, CTL_BYTES, stream);
    Params p{};
    p.x = (const float*)d_in[0]; p.pos = (const int*)d_in[1]; p.w_in = (const float*)d_in[2]; p.q_norm = (const float*)d_in[3]; p.w_uq = (const float*)d_in[4];
    p.kv_norm = (const float*)d_in[5]; p.w_ukv = (const float*)d_in[6]; p.w_out = (const float*)d_in[7]; p.ln1_g = (const float*)d_in[8]; p.ln1_b = (const float*)d_in[9];
    p.router_w = (const float*)d_in[10]; p.router_b = (const float*)d_in[11]; p.w1 = (const float*)d_in[12]; p.w3 = (const float*)d_in[13]; p.w2 = (const float*)d_in[14];
    p.sw1 = (const float*)d_in[15]; p.sw3 = (const float*)d_in[16]; p.sw2 = (const float*)d_in[17]; p.ln2_g = (const float*)d_in[18]; p.ln2_b = (const float*)d_in[19]; p.rel_bias = (const float*)d_in[20];
    p.out = (float*)d_out; p.ws = (unsigned char*)d_ws;
#if DBG
    dbg_run(p, grid, stream);
#elif defined(MULTI_LAUNCH)
    for (int k = 0; k < NPHASE; ++k) { p.ph_lo = k; p.ph_hi = k + 1; mega<<<dim3(grid), dim3(NTHR), LDS_BYTES, stream>>>(p); }
#else
    p.ph_lo = 0; p.ph_hi = NPHASE;
    mega<<<dim3(grid), dim3(NTHR), LDS_BYTES, stream>>>(p);
#endif
}
```

```cpp
#include <hip/hip_runtime.h>
#include <cstdio>
#include <cstdint>

#define LAS __attribute__((address_space(3)))
typedef unsigned short bf16_t;
typedef short bf16x8 __attribute__((ext_vector_type(8)));
typedef short s16x4 __attribute__((ext_vector_type(4)));
typedef float f32x2 __attribute__((ext_vector_type(2)));
typedef float f32x4 __attribute__((ext_vector_type(4)));
typedef float f32x16 __attribute__((ext_vector_type(16)));
typedef unsigned u32x4 __attribute__((ext_vector_type(4)));
typedef unsigned u32x2 __attribute__((ext_vector_type(2)));
typedef __bf16 bf16x2_t __attribute__((ext_vector_type(2)));

constexpr int NB = 16, SEQ = 2048, T = NB * SEQ, DM = 1024, NL = 4;
constexpr int IN_W = 2920, LDU = 3072;
constexpr int U_DQ = 0, U_DK = 384, U_DV = 768, U_SQ = 1152, U_SK = 1408, U_SV = 1664, U_IQ = 1920, U_IK = 2432, U_IW = 2496, U_CQ = 2560, U_CKV = 2816, U_KR = 2944;
constexpr int NE = 64, FF = 256;
constexpr float LOG2E = 1.4426950408889634f;
constexpr float QSCALE = 0.125f * LOG2E;
constexpr float MLA_QSCALE = 0.10206207261596575f * LOG2E;
constexpr float DN_ALPHA = 1.6817928305074290f;
constexpr float LN_EPS = 1e-5f, RMS_EPS = 1e-6f;
constexpr float ROUTED_SCALE = 2.5f;

constexpr size_t MiB = (size_t)1 << 20;
constexpr size_t WS_CTL = 0, CTL_BYTES = 1 * MiB;
constexpr size_t WS_DTAB = 512 * 1024;
constexpr size_t WS_W = 1 * MiB;
constexpr size_t W_IN = 0, W_UQ = W_IN + (size_t)3072 * 1024 * 2, W_UKV = W_UQ + (size_t)768 * 256 * 2, W_OUT = W_UKV + (size_t)768 * 256 * 2,
                 W_R = W_OUT + (size_t)1024 * 1024 * 2, W_13 = W_R + (size_t)256 * 1024 * 2, W_2 = W_13 + (size_t)65 * 512 * 1024 * 2, W_END = W_2 + (size_t)65 * 1024 * 256 * 2;
static_assert(W_END <= 108 * MiB, "weights region");
constexpr size_t WS_XF = 109 * MiB;
constexpr size_t WS_XB = 237 * MiB;
constexpr size_t WS_H = 301 * MiB;
constexpr size_t WS_LST = 445 * MiB;
constexpr size_t WS_GATE = 453 * MiB;
constexpr size_t WS_ROPE = 454 * MiB;
constexpr size_t WS_R = 458 * MiB;
constexpr size_t R_U = 0, R_MQ = 192 * MiB, R_MK = 228 * MiB, R_MV = 252 * MiB, R_KR = 276 * MiB, R_AO = 278 * MiB, R_MASK = 342 * MiB, R_SCR = 350 * MiB, R_LG = 414 * MiB;
constexpr size_t WS_END = 970 * MiB;
constexpr int CW_TMO = 0, CW_FLAG = 16  , CW_BAR = 4096, CW_CNT = 8192  , CW_Q = 16384  ;

__device__ __forceinline__ unsigned f2bf(float f) { unsigned u = __builtin_bit_cast(unsigned, f); return (u + 0x7fffu + ((u >> 16) & 1u)) >> 16; }
__device__ __forceinline__ float bf2f(unsigned b) { return __builtin_bit_cast(float, b << 16); }
__device__ __forceinline__ unsigned cvt_pk(float lo, float hi) { f32x2 v = {lo, hi}; bf16x2_t b = __builtin_convertvector(v, bf16x2_t); return __builtin_bit_cast(unsigned, b); }
#define LDS_WAIT() asm volatile("s_waitcnt lgkmcnt(0)" ::: "memory")
#define VM_WAIT() asm volatile("s_waitcnt vmcnt(0)" ::: "memory")
__device__ __forceinline__ float wave_sum(float v) {
#pragma unroll
    for (int o = 1; o < 64; o <<= 1) v += __shfl_xor(v, o);
    return v;
}

#define XB_TMO      128
#define XB_XCNT(j)  (256  + 64 * (j))
#define XB_XSUB(j)  (1280 + 64 * (j))
#define XB_XGEN(j)  (2304 + 64 * (j))
#define XB_TOP      3328
#define XB_TOPGEN   3392
#define XCD_BAR_WORDS 3456
#define XB_SPIN_CAP (1u << 18)
__device__ __forceinline__ unsigned xb_ld(unsigned* p)              { return __hip_atomic_load(p, __ATOMIC_RELAXED, __HIP_MEMORY_SCOPE_AGENT); }
__device__ __forceinline__ unsigned xb_add(unsigned* p, unsigned v) { return __hip_atomic_fetch_add(p, v, __ATOMIC_RELAXED, __HIP_MEMORY_SCOPE_AGENT); }
__device__ __forceinline__ unsigned xb_xcc_id() { return (unsigned)__builtin_amdgcn_s_getreg((3 << 11) | 20) & 0xFu; }
#define XB_SPIN(cond, bar) do { unsigned _sp = 0; while (cond) { __builtin_amdgcn_s_sleep(1); \
    if ((++_sp & 255u) == 0u) { if (xb_ld(&(bar)[XB_TMO])) break; if (_sp > XB_SPIN_CAP) { atomicAdd(&(bar)[XB_TMO], 1u); break; } } } } while (0)
struct XcdBarrier { unsigned* bar; unsigned x; volatile LAS unsigned* st; };
__device__ __forceinline__ XcdBarrier xcd_barrier_post(unsigned* bar, volatile LAS unsigned* st) {
    XcdBarrier b; b.bar = bar; b.x = xb_xcc_id(); b.st = st;
    if (threadIdx.x == 0) (void)xb_add(&bar[XB_XCNT(b.x)], 1u);
    return b;
}
__device__ __forceinline__ void xcd_barrier_complete(unsigned* bar, unsigned x, unsigned& nloc, unsigned& nx) {
    const unsigned G = gridDim.x * gridDim.y * gridDim.z;
    unsigned sum, cnt, mine, sp = 0u;
    for (;;) {
        sum = 0u; cnt = 0u; mine = 0u;
#pragma unroll
        for (unsigned j = 0; j < 16; ++j) { const unsigned c = xb_ld(&bar[XB_XCNT(j)]); sum += c; cnt += (c > 0u) ? 1u : 0u; mine = (j == x) ? c : mine; }
        if (sum == G) break;
        __builtin_amdgcn_s_sleep(1);
        if ((++sp & 255u) == 0u) { if (xb_ld(&bar[XB_TMO])) break; if (sp > XB_SPIN_CAP) { atomicAdd(&bar[XB_TMO], 1u); break; } }
    }
    nloc = mine > 0u ? mine : 1u; nx = cnt > 0u ? cnt : 1u;
}
__device__ __forceinline__ void xcd_barrier(const XcdBarrier& b) {
    asm volatile("s_waitcnt vmcnt(0)" ::: "memory");
    __syncthreads();
    if (threadIdx.x == 0) {
        unsigned* bar = b.bar;
        __builtin_amdgcn_s_waitcnt(0);
        unsigned nloc = b.st[0], nx = b.st[1];
        if (nloc == 0u) { xcd_barrier_complete(bar, b.x, nloc, nx); b.st[0] = nloc; b.st[1] = nx; }
        const unsigned old = xb_add(&bar[XB_XSUB(b.x)], 1u);
        const unsigned gen = old / nloc;
        if (old + 1u == (gen + 1u) * nloc) {
            __builtin_amdgcn_fence(__ATOMIC_RELEASE, "agent");
            asm volatile("s_waitcnt vmcnt(0)" ::: "memory");
            const unsigned og = xb_add(&bar[XB_TOP], 1u);
            const unsigned tg = og / nx;
            if (og + 1u == (tg + 1u) * nx) xb_add(&bar[XB_TOPGEN], 1u);
            else XB_SPIN(xb_ld(&bar[XB_TOPGEN]) == tg, bar);
            __builtin_amdgcn_fence(__ATOMIC_ACQUIRE, "agent");
            xb_add(&bar[XB_XGEN(b.x)], 1u);
            asm volatile("s_waitcnt vmcnt(0)" ::: "memory");
        } else {
            XB_SPIN(xb_ld(&bar[XB_XGEN(b.x)]) == gen, bar);
            __builtin_amdgcn_fence(__ATOMIC_ACQUIRE, "agent");
            asm volatile("s_waitcnt vmcnt(0)" ::: "memory");
        }
    }
    __syncthreads();
}

namespace pg8 {
constexpr int BM = 256, BK = 64, HALF = 128, HTB = HALF * BK * 2, STAGE_BYTES = 8 * HTB, NXCD = 8, WGM = 4;
__device__ __forceinline__ int lds_byte(int r, int c) { const int st = (r >> 4) * 2 + (c >> 5), rr = r & 15, cc = c & 31, ob = rr * 64 + cc * 2; return st * 1024 + (ob ^ (((ob >> 9) & 1) << 5)); }
__device__ __forceinline__ void stage_rc(int b, int& R, int& C) { const int st = b / 1024, sb = b % 1024, swz = sb ^ (((sb >> 9) & 1) << 5); R = (st >> 1) * 16 + swz / 64; C = (st & 1) * 32 + (swz % 64) / 2; }
__device__ __forceinline__ int perm32(int rho) { const int n = rho >> 4, i = rho & 15; return 8 * (i >> 2) + 4 * n + (i & 3); }
struct Unit { int pm, pn, e, seq; };

__device__ __forceinline__ int xcd_remap(int L, int nwg) { const int q = nwg / NXCD, r = nwg % NXCD, xcd = L % NXCD, off = L / NXCD; return (xcd < r ? xcd * (q + 1) : r * (q + 1) + (xcd - r) * q) + off; }

struct DenseOrder {
    int nM, nN, nwg, G, c; unsigned lda, acol; const char* Bt; unsigned ldb;
    __device__ void init(int M, int N, int G_, int c_, unsigned lda_, unsigned acol_, const void* Bt_, unsigned ldb_) { nM = M / BM; nN = N / BM; nwg = nM * nN; G = G_; c = c_; lda = lda_; acol = acol_; Bt = (const char*)Bt_; ldb = ldb_; }
    __device__ __forceinline__ bool next(int i, Unit& u) const {
        const long L = (long)i * G + c; if (L >= nwg) return false;
        const int wgid = xcd_remap((int)L, nwg);
        const int nig = WGM * nN, gid = wgid / nig, fm = gid * WGM, gsz = (nM - fm) < WGM ? (nM - fm) : WGM;
        u.pm = fm + ((wgid % nig) % gsz); u.pn = (wgid % nig) / gsz; u.e = 0; u.seq = i; return true;
    }
    __device__ __forceinline__ void a_voff(const Unit& u, int tid, unsigned (&v)[2][2]) const {
#pragma unroll
        for (int i = 0; i < 2; ++i) { int R, C; stage_rc(tid * 16 + i * 8192, R, C);
#pragma unroll
            for (int h = 0; h < 2; ++h) v[h][i] = ((unsigned)(u.pm * BM + h * HALF + R) * lda + acol + (unsigned)C) * 2u; }
    }
    __device__ __forceinline__ const char* b_base(const Unit& u) const { return Bt + (size_t)u.pn * BM * ldb * 2; }
};

typedef int v8i32 __attribute__((ext_vector_type(8)));
template <class Epi, class Sched, bool FP8 = false>
__device__ __forceinline__ void gemm_phase(LAS unsigned char* lds, LAS unsigned char* vslot  , const char* Abase, const int K, const unsigned ldb, const Sched& S, const Epi& E) {
    int tid = threadIdx.x; asm volatile("" : "+v"(tid));
    const int wid = __builtin_amdgcn_readfirstlane(tid >> 6), wr = wid >> 2, wc = wid & 3;
    int nt = K / BK; asm volatile("" : "+s"(nt));
    unsigned voffB[2];
#pragma unroll
    for (int i = 0; i < 2; ++i) { int R, C; stage_rc(tid * 16 + i * 8192, R, C); const int Rb = (Epi::PERM == 2) ? (((R >> 5) & 3) * 64 + perm32(R & 31)) : (Epi::PERM ? ((R & ~31) + perm32(R & 31)) : R); voffB[i] = ((unsigned)Rb * ldb + (unsigned)C) * 2u; }
    const size_t kstep = (size_t)(BK * 2);
    const size_t hstepB = (size_t)(Epi::PERM == 2 ? 32 : HALF) * ldb * 2;
    const unsigned ldsw = (unsigned)wid * 1024u;
    const int aoff = lds_byte(wr * 64 + (tid & 15), ((tid & 63) >> 4) * (FP8 ? 16 : 8)), boff = lds_byte(wc * 32 + (tid & 15), ((tid & 63) >> 4) * (FP8 ? 16 : 8));
#define PG8_SA(b, h) (((b) * 2 + (h)) * HTB)
#define PG8_SB(b, h) ((4 + (b) * 2 + (h)) * HTB)
#define PG8_STAGE(bufoff, gbase, voff) do { _Pragma("unroll") for (int _i = 0; _i < 2; ++_i) \
        __builtin_amdgcn_global_load_lds((const unsigned*)((const char*)(gbase) + (voff)[_i]), (LAS unsigned*)(lds + (bufoff) + ldsw + _i * 8192), 16, 0, 0); } while (0)
typedef int v4i32 __attribute__((ext_vector_type(4)));
#define PG8_LDA8(dst, b, h) do { _Pragma("unroll") for (int m = 0; m < 4; ++m) { dst[m].lo = *(const LAS v4i32*)(lds + PG8_SA(b, h) + aoff + m * 2048); dst[m].hi = *(const LAS v4i32*)(lds + PG8_SA(b, h) + aoff + m * 2048 + 16); } } while (0)
#define PG8_LDB8(dst, b, h) do { _Pragma("unroll") for (int n = 0; n < 2; ++n) { dst[n].lo = *(const LAS v4i32*)(lds + PG8_SB(b, h) + boff + n * 2048); dst[n].hi = *(const LAS v4i32*)(lds + PG8_SB(b, h) + boff + n * 2048 + 16); } } while (0)
#define PG8_MMA8(ai, bj, At, Bt) do { __builtin_amdgcn_s_setprio(1); _Pragma("unroll") for (int m = 0; m < 4; ++m) _Pragma("unroll") for (int n = 0; n < 2; ++n) \
        acc[ai][bj][m][n] = __builtin_amdgcn_mfma_scale_f32_16x16x128_f8f6f4(Bt[n], At[m], acc[ai][bj][m][n], 0, 0, 0, Epi::SCALE_W, 0, Epi::SCALE_A); __builtin_amdgcn_s_setprio(0); } while (0)
#define PG8_LDA(dst, b, h) do { _Pragma("unroll") for (int m = 0; m < 4; ++m) _Pragma("unroll") for (int k = 0; k < 2; ++k) dst[m][k] = *(const LAS bf16x8*)(lds + PG8_SA(b, h) + aoff + m * 2048 + k * 1024); } while (0)
#define PG8_LDB(dst, b, h) do { _Pragma("unroll") for (int n = 0; n < 2; ++n) _Pragma("unroll") for (int k = 0; k < 2; ++k) dst[n][k] = *(const LAS bf16x8*)(lds + PG8_SB(b, h) + boff + n * 2048 + k * 1024); } while (0)
#define PG8_MMA(ai, bj, At, Bt) do { __builtin_amdgcn_s_setprio(1); _Pragma("unroll") for (int m = 0; m < 4; ++m) _Pragma("unroll") for (int n = 0; n < 2; ++n) _Pragma("unroll") for (int k = 0; k < 2; ++k) \
        acc[ai][bj][m][n] = __builtin_amdgcn_mfma_f32_16x16x32_bf16(Bt[n][k], At[m][k], acc[ai][bj][m][n], 0, 0, 0); __builtin_amdgcn_s_setprio(0); } while (0)
#define PG8_WAIT_V(n) asm volatile("s_waitcnt vmcnt(" #n ")" ::: "memory")
#define PG8_WAIT_L(n) asm volatile("s_waitcnt lgkmcnt(" #n ")" ::: "memory")
#define PG8_BAR __builtin_amdgcn_s_barrier()
#define PG8_SCHED __builtin_amdgcn_sched_barrier(0)
    Unit cur, nxt; int ui = 0;
    if (!S.next(0, cur)) return;
    f32x4 acc[2][2][4][2];
#pragma unroll
    for (int a = 0; a < 2; ++a)
#pragma unroll
        for (int b = 0; b < 2; ++b)
#pragma unroll
            for (int m = 0; m < 4; ++m)
#pragma unroll
                for (int n = 0; n < 2; ++n) acc[a][b][m][n] = (f32x4){0.f, 0.f, 0.f, 0.f};
    bf16x8 At[4][2], B0[2][2], B1[2][2];
    v8i32 At8[4], B08[2], B18[2];
    unsigned vc[2][2];
    S.a_voff(cur, tid, vc);
    const char* cB = S.b_base(cur);
    PG8_STAGE(PG8_SB(0, 0), cB, voffB); PG8_STAGE(PG8_SB(0, 1), cB + hstepB, voffB); PG8_STAGE(PG8_SA(0, 0), Abase, vc[0]); PG8_STAGE(PG8_SA(0, 1), Abase, vc[1]);
    if (wr == 1) PG8_BAR;
    PG8_WAIT_V(2); PG8_BAR;
    PG8_STAGE(PG8_SB(1, 0), cB + kstep, voffB); PG8_STAGE(PG8_SA(1, 0), Abase + kstep, vc[0]); PG8_STAGE(PG8_SB(1, 1), cB + hstepB + kstep, voffB);
    PG8_WAIT_V(6); PG8_BAR;
    for (;;) {
        const bool has_next = S.next(ui + 1, nxt);
        const char* nB = has_next ? S.b_base(nxt) : cB;
        if (has_next) { unsigned vn[2][2]; int tz = threadIdx.x; asm volatile("" : "+v"(tz)); S.a_voff(nxt, tz, vn); *(LAS u32x4*)(vslot + tz * 16) = (u32x4){vn[0][0], vn[0][1], vn[1][0], vn[1][1]}; }
#pragma unroll 1
        for (int t = 0; t < nt; t += 2) {
            const bool last = (t == nt - 2);
            const char* a1 = Abase + (size_t)(t + 1) * kstep;
            const char* a2 = last ? Abase : Abase + (size_t)(t + 2) * kstep; const char* b2 = last ? nB : cB + (size_t)(t + 2) * kstep;
            const char* a3 = a2 + kstep; const char* b3 = b2 + kstep;
            if constexpr (!FP8) {
            PG8_LDB(B0, 0, 0); PG8_LDB(B1, 0, 1); PG8_SCHED; PG8_LDA(At, 0, 0); PG8_STAGE(PG8_SA(1, 1), a1, vc[1]);
            if (last && has_next) { const u32x4 vnx = *(const LAS u32x4*)(vslot + tid * 16); vc[0][0] = vnx[0]; vc[0][1] = vnx[1]; vc[1][0] = vnx[2]; vc[1][1] = vnx[3]; }
            PG8_WAIT_V(8); PG8_WAIT_L(0); PG8_BAR; PG8_MMA(0, 0, At, B0); PG8_MMA(0, 1, At, B1); PG8_BAR; PG8_SCHED;
            PG8_LDA(At, 0, 1); PG8_STAGE(PG8_SB(0, 0), b2, voffB); PG8_STAGE(PG8_SB(0, 1), b2 + hstepB, voffB); PG8_STAGE(PG8_SA(0, 0), a2, vc[0]);
            PG8_WAIT_V(8); PG8_WAIT_L(0); PG8_BAR; PG8_MMA(1, 0, At, B0); PG8_MMA(1, 1, At, B1); PG8_BAR; PG8_SCHED;
            PG8_LDB(B0, 1, 0); PG8_LDB(B1, 1, 1); PG8_SCHED; PG8_LDA(At, 1, 0); PG8_STAGE(PG8_SA(0, 1), a2, vc[1]);
            PG8_WAIT_V(8); PG8_WAIT_L(0); PG8_BAR; PG8_MMA(0, 0, At, B0); PG8_MMA(0, 1, At, B1); PG8_BAR; PG8_SCHED;
            PG8_LDA(At, 1, 1); PG8_STAGE(PG8_SB(1, 0), b3, voffB); PG8_STAGE(PG8_SB(1, 1), b3 + hstepB, voffB); PG8_STAGE(PG8_SA(1, 0), a3, vc[0]);
            PG8_WAIT_V(8); PG8_WAIT_L(0); PG8_BAR; PG8_MMA(1, 0, At, B0); PG8_MMA(1, 1, At, B1); PG8_BAR; PG8_SCHED;
            } else {
            PG8_LDB8(B08, 0, 0); PG8_LDB8(B18, 0, 1); PG8_SCHED; PG8_LDA8(At8, 0, 0); PG8_STAGE(PG8_SA(1, 1), a1, vc[1]);
            if (last && has_next) { const u32x4 vnx = *(const LAS u32x4*)(vslot + tid * 16); vc[0][0] = vnx[0]; vc[0][1] = vnx[1]; vc[1][0] = vnx[2]; vc[1][1] = vnx[3]; }
            PG8_WAIT_V(8); PG8_WAIT_L(0); PG8_BAR; PG8_MMA8(0, 0, At8, B08); PG8_MMA8(0, 1, At8, B18); PG8_BAR; PG8_SCHED;
            PG8_LDA8(At8, 0, 1); PG8_STAGE(PG8_SB(0, 0), b2, voffB); PG8_STAGE(PG8_SB(0, 1), b2 + hstepB, voffB); PG8_STAGE(PG8_SA(0, 0), a2, vc[0]);
            PG8_WAIT_V(8); PG8_WAIT_L(0); PG8_BAR; PG8_MMA8(1, 0, At8, B08); PG8_MMA8(1, 1, At8, B18); PG8_BAR; PG8_SCHED;
            PG8_LDB8(B08, 1, 0); PG8_LDB8(B18, 1, 1); PG8_SCHED; PG8_LDA8(At8, 1, 0); PG8_STAGE(PG8_SA(0, 1), a2, vc[1]);
            PG8_WAIT_V(8); PG8_WAIT_L(0); PG8_BAR; PG8_MMA8(0, 0, At8, B08); PG8_MMA8(0, 1, At8, B18); PG8_BAR; PG8_SCHED;
            PG8_LDA8(At8, 1, 1); PG8_STAGE(PG8_SB(1, 0), b3, voffB); PG8_STAGE(PG8_SB(1, 1), b3 + hstepB, voffB); PG8_STAGE(PG8_SA(1, 0), a3, vc[0]);
            PG8_WAIT_V(8); PG8_WAIT_L(0); PG8_BAR; PG8_MMA8(1, 0, At8, B08); PG8_MMA8(1, 1, At8, B18); PG8_BAR; PG8_SCHED;
            }
        }
        if (wr == 0) PG8_BAR;
        { int tz = threadIdx.x; asm volatile("" : "+v"(tz)); const int ln = tz & 63; E(acc, cur, wr, wc, ln & 15, ln >> 4); }
        if (!has_next) break;
#pragma unroll
        for (int a = 0; a < 2; ++a)
#pragma unroll
            for (int b = 0; b < 2; ++b)
#pragma unroll
                for (int m = 0; m < 4; ++m)
#pragma unroll
                    for (int n = 0; n < 2; ++n) acc[a][b][m][n] = (f32x4){0.f, 0.f, 0.f, 0.f};
        cur = nxt; cB = nB; ++ui;
        if (wr == 1) PG8_BAR;
    }
    PG8_WAIT_V(0);
    PG8_BAR;
#undef PG8_SA
#undef PG8_SB
#undef PG8_STAGE
#undef PG8_LDA
#undef PG8_LDA8
#undef PG8_LDB8
#undef PG8_MMA8
#undef PG8_LDB
#undef PG8_MMA
#undef PG8_WAIT_V
#undef PG8_WAIT_L
#undef PG8_BAR
#undef PG8_SCHED
}
}
constexpr int NWAVES = 8, NTHR = 512;
constexpr int LDS_RING = 131072;
constexpr int LDS_TBL = LDS_RING;
constexpr int LDS_VOFF = LDS_TBL + 22528;
constexpr int LDS_MISC = LDS_VOFF + 8192;
constexpr int LDS_BYTES = 162304;

struct Params {
    const float* x; const int* pos; const float* w_in; const float* q_norm; const float* w_uq; const float* kv_norm; const float* w_ukv; const float* w_out;
    const float* ln1_g; const float* ln1_b; const float* router_w; const float* router_b; const float* w1; const float* w3; const float* w2;
    const float* sw1; const float* sw3; const float* sw2; const float* ln2_g; const float* ln2_b; const float* rel_bias;
    float* out; unsigned char* ws;
    int ph_lo, ph_hi;
};

struct Frame {
    LAS unsigned char* lds; volatile LAS unsigned* MISC; unsigned* ctl;
    int tid, lane, wave, G, vcu;
    unsigned char* ws;
};
#define FP(name, type, off) __device__ __forceinline__ type* name(const Frame& F) { return (type*)(F.ws + (off)); }
FP(fWin, bf16_t, WS_W + W_IN) FP(fWuq, bf16_t, WS_W + W_UQ) FP(fWukv, bf16_t, WS_W + W_UKV) FP(fWout, bf16_t, WS_W + W_OUT) FP(fWr, bf16_t, WS_W + W_R) FP(fW13, unsigned char, WS_W + W_13) FP(fW2, unsigned char, WS_W + W_2)
FP(fSH, bf16_t, WS_XF) FP(fXB, bf16_t, WS_XB) FP(fH, unsigned char, WS_H) FP(fLST, unsigned, WS_LST) FP(fPK, unsigned, WS_GATE) FP(fGS, float, WS_XF + 64 * MiB) FP(fXB8, unsigned char, WS_XF + 72 * MiB) FP(fROPE, float, WS_ROPE) FP(fDTAB, float, WS_DTAB)
FP(fU, bf16_t, WS_R + R_U) FP(fMQ, bf16_t, WS_R + R_MQ) FP(fMK, bf16_t, WS_R + R_MK) FP(fMV, bf16_t, WS_R + R_MV) FP(fKR, bf16_t, WS_R + R_KR) FP(fAO, bf16_t, WS_R + R_AO)
FP(fMASK, unsigned, WS_R + R_MASK) FP(fSCR, float, WS_R + R_SCR) FP(fLG, float, WS_R + R_LG) FP(fYB, unsigned char, WS_R)
__device__ __forceinline__ Frame phase_frame(const Frame& F0) { Frame F = F0; int tz = threadIdx.x; asm volatile("" : "+v"(tz)); F.tid = tz; F.lane = tz & 63; return F; }

constexpr float YB_SCALE = 64.0f;
constexpr float W13_SCALE = 128.0f, X8_SCALE = 32.0f, W2_SCALE = 256.0f, H8_SCALE = 16.0f;
constexpr int E8_W = 0x79797979  , E8_X = 0x79797979, E8_H = 0x79797979;
__device__ __forceinline__ unsigned pk_fp8x4(float a, float b, float c, float d) {
    a = __builtin_amdgcn_fmed3f(a, -448.f, 448.f); b = __builtin_amdgcn_fmed3f(b, -448.f, 448.f); c = __builtin_amdgcn_fmed3f(c, -448.f, 448.f); d = __builtin_amdgcn_fmed3f(d, -448.f, 448.f);
    int p = __builtin_amdgcn_cvt_pk_fp8_f32(a, b, 0, false); p = __builtin_amdgcn_cvt_pk_fp8_f32(c, d, p, true); return (unsigned)p; }
struct MapIn  { __device__ int row(int n) const { return n < 2504 ? n : n + 56; }   __device__ float sc(int k, int n) const { return (n < 384 || (n >= 1152 && n < 1408)) ? QSCALE : 1.0f; } };
struct MapUq  { const float* g; __device__ int row(int n) const { return n; }         __device__ float sc(int k, int n) const { return g[k] * MLA_QSCALE; } };
struct MapUkv { const float* g; __device__ int row(int n) const { const int h = n >> 7, c = n & 127; return c < 64 ? h * 64 + c : 384 + h * 64 + (c - 64); } __device__ float sc(int k, int n) const { return g[k]; } };
struct MapId  { __device__ int row(int n) const { return n; }                         __device__ float sc(int k, int n) const { return 1.0f; } };
struct MapW13 { int add; __device__ int row(int f) const { return 32 * (f >> 4) + (f & 15) + add; } __device__ float sc(int k, int n) const { return W13_SCALE; } };
struct MapW2  { __device__ int row(int n) const { return n; }                         __device__ float sc(int k, int n) const { return W2_SCALE; } };

template <class MAP>
__device__ __forceinline__ void tr_item(const float* W, int N, int kb, int nb, bf16_t* WT, int ldk, const MAP map, LAS float* scr, int lane) {
    const int k0 = 64 * kb, n0 = 32 * nb;
    const int nq = n0 + 4 * (lane & 7); const bool ok = nq < N;
    f32x4 w4[8];
#pragma unroll
    for (int i = 0; i < 8; ++i) { const int kk = 8 * i + (lane >> 3); w4[i] = ok ? __builtin_nontemporal_load((const f32x4*)(W + (size_t)(k0 + kk) * N + nq)) : (f32x4){0.f, 0.f, 0.f, 0.f}; }
#pragma unroll
    for (int i = 0; i < 8; ++i) { const int kk = 8 * i + (lane >> 3);
#pragma unroll
        for (int j = 0; j < 4; ++j) scr[kk * 33 + 4 * (lane & 7) + j] = w4[i][j] * map.sc(k0 + kk, nq + j); }
    LDS_WAIT(); asm volatile("" ::: "memory");
    const int c = lane & 7;
#pragma unroll
    for (int j = 0; j < 4; ++j) { const int n = (lane >> 3) + 8 * j; const LAS float* s = scr + (8 * c) * 33 + n;
        u32x4 o; o.x = cvt_pk(s[0 * 33], s[1 * 33]); o.y = cvt_pk(s[2 * 33], s[3 * 33]); o.z = cvt_pk(s[4 * 33], s[5 * 33]); o.w = cvt_pk(s[6 * 33], s[7 * 33]);
        if (n0 + n < N) *(u32x4*)(WT + (size_t)map.row(n0 + n) * ldk + k0 + 8 * c) = o; }
    LDS_WAIT(); asm volatile("" ::: "memory");
}

template <class MAP>
__device__ __forceinline__ void tr_item8(const float* W, int N, int kb, int nb, unsigned char* WT, int ldk, const MAP map, LAS float* scr, int lane) {
    const int k0 = 64 * kb, n0 = 32 * nb;
    const int nq = n0 + 4 * (lane & 7);
    f32x4 w4[8];
#pragma unroll
    for (int i = 0; i < 8; ++i) { const int kk = 8 * i + (lane >> 3); w4[i] = __builtin_nontemporal_load((const f32x4*)(W + (size_t)(k0 + kk) * N + nq)); }
#pragma unroll
    for (int i = 0; i < 8; ++i) { const int kk = 8 * i + (lane >> 3);
#pragma unroll
        for (int j = 0; j < 4; ++j) scr[kk * 33 + 4 * (lane & 7) + j] = w4[i][j] * map.sc(k0 + kk, nq + j); }
    LDS_WAIT(); asm volatile("" ::: "memory");
    const int n = lane >> 1, hf = lane & 1; const LAS float* sp = scr + (32 * hf) * 33 + n;
    unsigned o[8];
#pragma unroll
    for (int q = 0; q < 8; ++q) o[q] = pk_fp8x4(sp[(4 * q) * 33], sp[(4 * q + 1) * 33], sp[(4 * q + 2) * 33], sp[(4 * q + 3) * 33]);
    unsigned char* dst = WT + (size_t)map.row(n0 + n) * ldk + k0 + 32 * hf;
    *(u32x4*)dst = (u32x4){o[0], o[1], o[2], o[3]}; *(u32x4*)(dst + 16) = (u32x4){o[4], o[5], o[6], o[7]};
    LDS_WAIT(); asm volatile("" ::: "memory");
}

__device__ __forceinline__ void zero_rows(bf16_t* base, int row0, int nrows, int ldk, int k0, int kn, int gt, int ngt) {
    const int per = kn / 8; const int total = nrows * per;
    for (int i = gt; i < total; i += ngt) { const int r = i / per, c = i % per; *(u32x4*)(base + (size_t)(row0 + r) * ldk + k0 + 8 * c) = (u32x4){0u, 0u, 0u, 0u}; }
}

__device__ __forceinline__ void convert_small(const Frame& F, const Params& p, int l) {
    LAS float* scr = (LAS float*)(F.lds + F.wave * 16384);
    const int gw = F.vcu * NWAVES + F.wave, NGW = F.G * NWAVES;
    constexpr int I_IN = 16 * 92, I_UQ = 4 * 18, I_UKV = 2 * 24, I_OUT = 16 * 32, I_R = 16 * 2;
    constexpr int NIT = I_IN + I_UQ + I_UKV + I_OUT + I_R;
    const float* w_in = p.w_in + (size_t)l * 1024 * IN_W;
    const float* w_uq = p.w_uq + (size_t)l * 256 * 576; const float* w_ukv = p.w_ukv + (size_t)l * 128 * 768;
    const float* w_out = p.w_out + (size_t)l * 1024 * 1024; const float* rw = p.router_w + (size_t)l * 1024 * 64;
    for (int it = gw; it < NIT; it += NGW) {
        int r = it;
        if (r < I_IN) { tr_item(w_in, IN_W, r / 92, r % 92, fWin(F), 1024, MapIn{}, scr, F.lane); continue; } r -= I_IN;
        if (r < I_UQ) { tr_item(w_uq, 576, r / 18, r % 18, fWuq(F), 256, MapUq{p.q_norm + l * 256}, scr, F.lane); continue; } r -= I_UQ;
        if (r < I_UKV) { tr_item(w_ukv, 768, r / 24, r % 24, fWukv(F), 256, MapUkv{p.kv_norm + l * 128}, scr, F.lane); continue; } r -= I_UKV;
        if (r < I_OUT) { tr_item(w_out, 1024, r / 32, r % 32, fWout(F), 1024, MapId{}, scr, F.lane); continue; } r -= I_OUT;
        tr_item(rw, 64, r / 2, r % 2, fWr(F), 1024, MapId{}, scr, F.lane);
    }
    const int gt = F.vcu * NTHR + F.tid, ngt = F.G * NTHR;
    zero_rows(fWin(F), 2504, 56, 1024, 0, 1024, gt, ngt); zero_rows(fWin(F), 2976, 96, 1024, 0, 1024, gt, ngt);
    zero_rows(fWuq(F), 576, 192, 256, 0, 256, gt, ngt);
    zero_rows(fWukv(F), 0, 768, 256, 128, 128, gt, ngt);
    zero_rows(fWr(F), 64, 192, 1024, 0, 1024, gt, ngt);
}
__device__ __forceinline__ void convert_experts(const Frame& F, const Params& p, int l, int k0, int k1, int scr_off) {
    LAS float* scr = (LAS float*)(F.lds + scr_off + F.wave * 8448);
    const int gw = F.vcu * NWAVES + F.wave, NGW = F.G * NWAVES;
    constexpr int I_E1 = 16 * 8, I_E2 = 4 * 32, I_EXP = 2 * I_E1 + I_E2, NIT = 65 * I_EXP;
    for (int k = k0; k < k1; ++k) { const int it = gw + k * NGW; if (it >= NIT) break;
        const int e = it / I_EXP; int r = it - e * I_EXP;
        const float *s1, *s3, *s2;
        if (e < 64) { s1 = p.w1 + ((size_t)l * 64 + e) * 1024 * 256; s3 = p.w3 + ((size_t)l * 64 + e) * 1024 * 256; s2 = p.w2 + ((size_t)l * 64 + e) * 256 * 1024; }
        else { s1 = p.sw1 + (size_t)l * 1024 * 256; s3 = p.sw3 + (size_t)l * 1024 * 256; s2 = p.sw2 + (size_t)l * 256 * 1024; }
        unsigned char* d13 = fW13(F) + (size_t)e * 512 * 1024; unsigned char* d2 = fW2(F) + (size_t)e * 1024 * 256;
        if (r < I_E1) { tr_item8(s1, 256, r / 8, r % 8, d13, 1024, MapW13{0}, scr, F.lane); continue; } r -= I_E1;
        if (r < I_E1) { tr_item8(s3, 256, r / 8, r % 8, d13, 1024, MapW13{16}, scr, F.lane); continue; } r -= I_E1;
        tr_item8(s2, 1024, r / 32, r % 32, d2, 256, MapW2{}, scr, F.lane);
    }
}

typedef f32x4 Acc[2][2][4][2];
#define EPI_ROWS(ai, m) for (int ai = 0; ai < 2; ++ai) for (int m = 0; m < 4; ++m)

struct EpiU {
    static constexpr int PERM = 2; bf16_t* U;
    __device__ __forceinline__ void operator()(const Acc& acc, const pg8::Unit& u, int wr, int wc, int fr, int fq) const {
#pragma unroll
        EPI_ROWS(ai, m) { bf16_t* rowp = U + (size_t)(u.pm * 256 + ai * 128 + wr * 64 + m * 16 + fr) * LDU + u.pn * 256 + wc * 64 + 8 * fq;
#pragma unroll
            for (int bj = 0; bj < 2; ++bj) { const f32x4 a = acc[ai][bj][m][0], b = acc[ai][bj][m][1];
                *(u32x4*)(rowp + bj * 32) = (u32x4){cvt_pk(a[0], a[1]), cvt_pk(a[2], a[3]), cvt_pk(b[0], b[1]), cvt_pk(b[2], b[3])}; } }
    }
};
struct EpiQup {
    static constexpr int PERM = 0; bf16_t* MQ; const LAS float* tbl; const float* rope;
    __device__ __forceinline__ void operator()(const Acc& acc, const pg8::Unit& u, int wr, int wc, int fr, int fq) const {
#pragma unroll
        EPI_ROWS(ai, m) { const int rl = ai * 128 + wr * 64 + m * 16 + fr, row = u.pm * 256 + rl; const float rs = tbl[u.seq * 256 + rl];
#pragma unroll
            for (int bj = 0; bj < 2; ++bj) { const int c0 = u.pn * 256 + bj * 128 + wc * 32; f32x4 a = acc[ai][bj][m][0] * rs, b = acc[ai][bj][m][1] * rs;
                if (((c0 >> 5) % 3) == 2) {
                    const f32x4 cs = *(const f32x4*)(rope + (size_t)row * 32 + 4 * fq), sn = *(const f32x4*)(rope + (size_t)row * 32 + 16 + 4 * fq);
                    const f32x4 x1 = a, x2 = b; a = x1 * cs - x2 * sn; b = x2 * cs + x1 * sn; }
                if (c0 < 576) { bf16_t* o = MQ + (size_t)row * 576 + c0 + 4 * fq; *(u32x2*)o = (u32x2){cvt_pk(a[0], a[1]), cvt_pk(a[2], a[3])}; *(u32x2*)(o + 16) = (u32x2){cvt_pk(b[0], b[1]), cvt_pk(b[2], b[3])}; } }
            asm volatile("" ::: "memory"); }
    }
};
struct EpiKVup {
    static constexpr int PERM = 1; bf16_t* MK; bf16_t* MV; const LAS float* tbl;
    __device__ __forceinline__ void operator()(const Acc& acc, const pg8::Unit& u, int wr, int wc, int fr, int fq) const {
#pragma unroll
        EPI_ROWS(ai, m) { const int rl = ai * 128 + wr * 64 + m * 16 + fr, row = u.pm * 256 + rl; const float rs = tbl[u.seq * 256 + rl];
#pragma unroll
            for (int bj = 0; bj < 2; ++bj) { const int c = u.pn * 256 + bj * 128 + wc * 32 + 8 * fq; const f32x4 a = acc[ai][bj][m][0] * rs, b = acc[ai][bj][m][1] * rs;
                bf16_t* o = c < 384 ? MK + (size_t)row * 384 + c : MV + (size_t)row * 384 + (c - 384);
                *(u32x4*)o = (u32x4){cvt_pk(a[0], a[1]), cvt_pk(a[2], a[3]), cvt_pk(b[0], b[1]), cvt_pk(b[2], b[3])}; } }
    }
};
struct EpiResB {
    static constexpr int PERM = 2; bf16_t* X;
    __device__ __forceinline__ void operator()(const Acc& acc, const pg8::Unit& u, int wr, int wc, int fr, int fq) const {
        u32x4 r[2][4][2];
#pragma unroll
        EPI_ROWS(ai, m) { const bf16_t* rowp = X + (size_t)(u.pm * 256 + ai * 128 + wr * 64 + m * 16 + fr) * 1024 + u.pn * 256 + wc * 64 + 8 * fq;
            r[ai][m][0] = *(const u32x4*)rowp; r[ai][m][1] = *(const u32x4*)(rowp + 32); }
#pragma unroll
        EPI_ROWS(ai, m) { bf16_t* rowp = X + (size_t)(u.pm * 256 + ai * 128 + wr * 64 + m * 16 + fr) * 1024 + u.pn * 256 + wc * 64 + 8 * fq;
#pragma unroll
            for (int bj = 0; bj < 2; ++bj) { const f32x4 a = acc[ai][bj][m][0], b = acc[ai][bj][m][1]; const u32x4 q = r[ai][m][bj];
                *(u32x4*)(rowp + bj * 32) = (u32x4){cvt_pk(DN_ALPHA * bf2f(q[0] & 0xffffu) + a[0], DN_ALPHA * bf2f(q[0] >> 16) + a[1]), cvt_pk(DN_ALPHA * bf2f(q[1] & 0xffffu) + a[2], DN_ALPHA * bf2f(q[1] >> 16) + a[3]),
                                                       cvt_pk(DN_ALPHA * bf2f(q[2] & 0xffffu) + b[0], DN_ALPHA * bf2f(q[2] >> 16) + b[1]), cvt_pk(DN_ALPHA * bf2f(q[3] & 0xffffu) + b[2], DN_ALPHA * bf2f(q[3] >> 16) + b[3])}; } }
    }
};
struct EpiSH {
    static constexpr int PERM = 2; static constexpr int SCALE_W = E8_W, SCALE_A = E8_H; bf16_t* SH;
    __device__ __forceinline__ void operator()(const Acc& acc, const pg8::Unit& u, int wr, int wc, int fr, int fq) const {
#pragma unroll
        EPI_ROWS(ai, m) { bf16_t* rowp = SH + (size_t)(u.pm * 256 + ai * 128 + wr * 64 + m * 16 + fr) * 1024 + u.pn * 256 + wc * 64 + 8 * fq;
#pragma unroll
            for (int bj = 0; bj < 2; ++bj) { const f32x4 a = acc[ai][bj][m][0], b = acc[ai][bj][m][1];
                *(u32x4*)(rowp + bj * 32) = (u32x4){cvt_pk(a[0], a[1]), cvt_pk(a[2], a[3]), cvt_pk(b[0], b[1]), cvt_pk(b[2], b[3])}; } }
    }
};
struct EpiLogit {
    static constexpr int PERM = 0; float* LG;
    __device__ __forceinline__ void operator()(const Acc& acc, const pg8::Unit& u, int wr, int wc, int fr, int fq) const {
        if (wc >= 2) return;
#pragma unroll
        EPI_ROWS(ai, m) { float* o = LG + ((size_t)u.pn * T + (u.pm * 256 + ai * 128 + wr * 64 + m * 16 + fr)) * 64 + wc * 32 + 4 * fq;
            *(f32x4*)o = acc[ai][0][m][0]; *(f32x4*)(o + 16) = acc[ai][0][m][1]; }
    }
};
__device__ __forceinline__ float silu_f(float v) { return v / (1.0f + __expf(-v)); }
struct EpiG1 {
    static constexpr int PERM = 0; static constexpr int SCALE_W = E8_W, SCALE_A = E8_X;
    unsigned char* H; const float* GS; const LAS int* cnt; int shared_base; const LAS int* cb;
    __device__ __forceinline__ void operator()(const Acc& acc, const pg8::Unit& u, int wr, int wc, int fr, int fq) const {
        float g[2][4]; const int n = GS ? cnt[u.e] : 0x7fffffff;
#pragma unroll
        EPI_ROWS(ai, m) { const int idx = u.pm * 256 + ai * 128 + wr * 64 + m * 16 + fr; g[ai][m] = GS ? (idx < n ? GS[(size_t)u.e * T + idx] * H8_SCALE : 0.f) : H8_SCALE; }
#pragma unroll
        EPI_ROWS(ai, m) { const int idx = u.pm * 256 + ai * 128 + wr * 64 + m * 16 + fr; const float gg = g[ai][m];
            const f32x4 a0 = acc[ai][0][m][0], b0 = acc[ai][0][m][1] * gg, a1 = acc[ai][1][m][0], b1 = acc[ai][1][m][1] * gg;
            const auto pr = __builtin_amdgcn_permlane16_swap(pk_fp8x4(silu_f(a0[0]) * b0[0], silu_f(a0[1]) * b0[1], silu_f(a0[2]) * b0[2], silu_f(a0[3]) * b0[3]),
                                                             pk_fp8x4(silu_f(a1[0]) * b1[0], silu_f(a1[1]) * b1[1], silu_f(a1[2]) * b1[2], silu_f(a1[3]) * b1[3]), false, false);
            if (idx >= n) continue;
            const size_t hr = GS ? (size_t)(cb[u.e] + idx) : (size_t)(shared_base + idx);
            unsigned char* o = H + hr * 256 + u.pn * 128 + wc * 16 + 4 * (fq & ~1) + (fq & 1) * 64;
            *(u32x2*)o = (u32x2){pr[0], pr[1]}; }
    }
};
struct EpiG2 {
    static constexpr int PERM = 1; static constexpr int SCALE_W = E8_W, SCALE_A = E8_H; unsigned char* YB; const LAS int* cnt; const LAS int* cb;
    __device__ __forceinline__ void operator()(const Acc& acc, const pg8::Unit& u, int wr, int wc, int fr, int fq) const {
        const int n = cnt[u.e];
#pragma unroll
        EPI_ROWS(ai, m) { const int idx = u.pm * 256 + ai * 128 + wr * 64 + m * 16 + fr;
            const f32x4 a0 = acc[ai][0][m][0] * YB_SCALE, b0 = acc[ai][0][m][1] * YB_SCALE, a1 = acc[ai][1][m][0] * YB_SCALE, b1 = acc[ai][1][m][1] * YB_SCALE;
            const auto lo = __builtin_amdgcn_permlane16_swap(pk_fp8x4(a0[0], a0[1], a0[2], a0[3]), pk_fp8x4(a1[0], a1[1], a1[2], a1[3]), false, false);
            const auto hi = __builtin_amdgcn_permlane16_swap(pk_fp8x4(b0[0], b0[1], b0[2], b0[3]), pk_fp8x4(b1[0], b1[1], b1[2], b1[3]), false, false);
            if (idx >= n) continue;
            unsigned char* o = YB + (size_t)(cb[u.e] + idx) * 1024 + u.pn * 256 + wc * 32 + 8 * (fq & ~1) + (fq & 1) * 128;
            *(u32x4*)o = (u32x4){lo[0], hi[0], lo[1], hi[1]}; }
    }
};

struct MoeOrder {
    const LAS int* cnt; const LAS int* ubase;
    int npn, total, G, c; const unsigned* LST; int shift  ; unsigned lda; const LAS int* cb; const char* Bt; size_t bexp  ; unsigned ldb;
    __device__ __forceinline__ bool next(int i, pg8::Unit& u) const {
        const long L = (long)i * G + c; if (L >= total) return false;
        const int w = pg8::xcd_remap((int)L, total);
        int lo = 0, hi = 64;
        while (hi - lo > 1) { const int mid = (lo + hi) >> 1; if (ubase[mid] <= w) lo = mid; else hi = mid; }
        const int loc = w - ubase[lo]; u.e = lo; u.pn = loc % npn; u.pm = loc / npn; u.seq = i; return true;
    }
    __device__ __forceinline__ void a_voff(const pg8::Unit& u, int tid, unsigned (&v)[2][2]) const {
        const int n = cnt[u.e];
#pragma unroll
        for (int i = 0; i < 2; ++i) { int R, C; pg8::stage_rc(tid * 16 + i * 8192, R, C);
#pragma unroll
            for (int h = 0; h < 2; ++h) { int idx = u.pm * 256 + h * 128 + R; idx = idx < n ? idx : 0;
                if (shift < 0) { v[h][i] = ((unsigned)(cb[u.e] + idx) * lda + (unsigned)C) * 2u; }
                else { const unsigned ent = LST[(size_t)u.e * T + idx];
                    v[h][i] = ((ent >> shift) * lda + (unsigned)C) * 2u; } } }
    }
    __device__ __forceinline__ const char* b_base(const pg8::Unit& u) const { return Bt + (size_t)u.e * bexp + (size_t)u.pn * 256 * ldb * 2; }
};
struct RouterOrder {
    int G, c; const char* Bt;
    __device__ __forceinline__ bool next(int i, pg8::Unit& u) const { const long L = (long)i * G + c; if (L >= 256) return false; u.pm = (int)L >> 1; u.pn = (int)L & 1; u.e = 0; u.seq = i; return true; }
    __device__ __forceinline__ void a_voff(const pg8::Unit& u, int tid, unsigned (&v)[2][2]) const {
#pragma unroll
        for (int i = 0; i < 2; ++i) { int R, C; pg8::stage_rc(tid * 16 + i * 8192, R, C);
#pragma unroll
            for (int h = 0; h < 2; ++h) v[h][i] = ((unsigned)(u.pm * 256 + h * 128 + R) * 1024u + (unsigned)(u.pn * 512 + C)) * 2u; }
    }
    __device__ __forceinline__ const char* b_base(const pg8::Unit& u) const { return Bt + (size_t)u.pn * 512 * 2; }
};

__device__ __forceinline__ void phase_x_to_xb(const Frame& F, const float* x) {
    const size_t n8 = (size_t)T * 1024 / 8;
    for (size_t i = (size_t)F.vcu * NTHR + F.tid; i < n8; i += (size_t)F.G * NTHR) {
        const f32x4 a = __builtin_nontemporal_load((const f32x4*)(x + i * 8)), b = __builtin_nontemporal_load((const f32x4*)(x + i * 8 + 4));
        *(u32x4*)(fXB(F) + i * 8) = (u32x4){cvt_pk(a[0], a[1]), cvt_pk(a[2], a[3]), cvt_pk(b[0], b[1]), cvt_pk(b[2], b[3])};
    }
}

__device__ __forceinline__ void phase_rope_table(const Frame& F, const int* pos) {
    for (int i = F.vcu * NTHR + F.tid; i < T * 16; i += F.G * NTHR) { const int t = i >> 4, j = i & 15;
        const double inv = exp2(-(double)j * (13.287712379549449 / 16.0));
        const double rev = (double)pos[t] * inv * 0.15915494309189535; const float fr = (float)(rev - floor(rev));
        fROPE(F)[(size_t)t * 32 + j] = __builtin_amdgcn_cosf(fr); fROPE(F)[(size_t)t * 32 + 16 + j] = __builtin_amdgcn_sinf(fr); }
}

__device__ __forceinline__ void phase_inproj(const Frame& F) {
    pg8::DenseOrder S; S.init(T, LDU, F.G, (int)blockIdx.x, 1024, 0, fWin(F), 1024);
    EpiU E{fU(F)};
    pg8::gemm_phase<EpiU, pg8::DenseOrder>(F.lds, F.lds + LDS_VOFF, (const char*)fXB(F), 1024, 1024, S, E);
}

template <int WIDTH>
__device__ __forceinline__ void rms_tables(const Frame& F, const pg8::DenseOrder& S, LAS float* tbl, int col0) {
    pg8::Unit u;
    for (int i = 0; i < 4 && S.next(i, u); ++i) {
        const int r = F.tid >> 1, hf = F.tid & 1; const bf16_t* xr = fU(F) + (size_t)(u.pm * 256 + r) * LDU + col0 + hf * (WIDTH / 2);
        u32x4 v[WIDTH / 16];
#pragma unroll
        for (int c = 0; c < WIDTH / 16; ++c) v[c] = *(const u32x4*)(xr + 8 * c);
        float ss = 0.f;
#pragma unroll
        for (int c = 0; c < WIDTH / 16; ++c)
#pragma unroll
            for (int j = 0; j < 4; ++j) { const float lo = bf2f(v[c][j] & 0xffffu), hi = bf2f(v[c][j] >> 16); ss += lo * lo + hi * hi; }
        ss += __shfl_xor(ss, 1);
        if (hf == 0) tbl[i * 256 + r] = 1.0f / sqrtf(ss / (float)WIDTH + RMS_EPS);
    }
}

__device__ __forceinline__ void phase_mla_up(const Frame& F, const Params& p) {
    LAS float* tq = (LAS float*)(F.lds + LDS_TBL); LAS float* tkv = tq + 1024;
    pg8::DenseOrder Sq; Sq.init(T, 768, F.G, (int)blockIdx.x, LDU, U_CQ, fWuq(F), 256);
    pg8::DenseOrder Sk; Sk.init(T, 768, F.G, (int)blockIdx.x, LDU, U_CKV, fWukv(F), 256);
    rms_tables<256>(F, Sq, tq, U_CQ); rms_tables<128>(F, Sk, tkv, U_CKV);
    __syncthreads();
    { EpiQup E{fMQ(F), tq, fROPE(F)}; pg8::gemm_phase<EpiQup, pg8::DenseOrder>(F.lds, F.lds + LDS_VOFF, (const char*)fU(F), 256, 256, Sq, E); }
    { EpiKVup E{fMK(F), fMV(F), tkv}; pg8::gemm_phase<EpiKVup, pg8::DenseOrder>(F.lds, F.lds + LDS_VOFF, (const char*)fU(F), 256, 256, Sk, E); }
    for (int i = F.vcu * NTHR + F.tid; i < T * 16; i += F.G * NTHR) { const int t = i >> 4, j = i & 15;
        const float x1 = bf2f(fU(F)[(size_t)t * LDU + U_KR + j]), x2 = bf2f(fU(F)[(size_t)t * LDU + U_KR + 16 + j]);
        const float cs = fROPE(F)[(size_t)t * 32 + j], sn = fROPE(F)[(size_t)t * 32 + 16 + j];
        fKR(F)[(size_t)t * 32 + j] = (bf16_t)f2bf(x1 * cs - x2 * sn); fKR(F)[(size_t)t * 32 + 16 + j] = (bf16_t)f2bf(x2 * cs + x1 * sn); }
}

__device__ __forceinline__ void phase_outproj(const Frame& F) {
    pg8::DenseOrder S; S.init(T, 1024, F.G, (int)blockIdx.x, 1024, 0, fWout(F), 1024);
    EpiResB E{fXB(F)};
    pg8::gemm_phase<EpiResB, pg8::DenseOrder>(F.lds, F.lds + LDS_VOFF, (const char*)fAO(F), 1024, 1024, S, E);
}

__device__ __forceinline__ void phase_router_sharedg1(const Frame& F) {
    { RouterOrder S{F.G, (int)blockIdx.x, (const char*)fWr(F)}; EpiLogit E{fLG(F)}; pg8::gemm_phase<EpiLogit, RouterOrder>(F.lds, F.lds + LDS_VOFF, (const char*)fXB(F), 512, 1024, S, E); }
    { pg8::DenseOrder S; S.init(T, 512, F.G, (int)blockIdx.x, 512, 0, fW13(F) + (size_t)64 * 512 * 1024, 512);
      EpiG1 E{fH(F), nullptr, nullptr, T * 8, nullptr}; pg8::gemm_phase<EpiG1, pg8::DenseOrder, true>(F.lds, F.lds + LDS_VOFF, (const char*)fXB8(F), 512, 512, S, E); }
}

__device__ __forceinline__ void phase_shared_g2(const Frame& F) {
    pg8::DenseOrder S; S.init(T, 1024, F.G, (int)blockIdx.x, 128, 0, fW2(F) + (size_t)64 * 1024 * 256, 128);
    EpiSH E{fSH(F)};
    pg8::gemm_phase<EpiSH, pg8::DenseOrder, true>(F.lds, F.lds + LDS_VOFF, (const char*)(fH(F) + (size_t)T * 8 * 256), 128, 128, S, E);
}

__device__ __forceinline__ void moe_tables(const Frame& F, int l, int npn, LAS int*& cnt, LAS int*& ubase) {
    cnt = (LAS int*)(F.lds + LDS_TBL); ubase = cnt + 64;
    __syncthreads();
    if (F.tid < 64) cnt[F.tid] = (int)F.ctl[CW_CNT + l * 64 + F.tid];
    __syncthreads();
    if (F.tid == 0) { int s = 0, c = 0; for (int e = 0; e < 64; ++e) { ubase[e] = s; s += ((cnt[e] + 255) >> 8) * npn; ubase[65 + e] = c; c += cnt[e]; } ubase[64] = s; }
    __syncthreads();
}
__device__ __forceinline__ void phase_moe_g1(const Frame& F, int l) {
    LAS int *cnt, *ubase; moe_tables(F, l, 2, cnt, ubase);
    MoeOrder S{cnt, ubase, 2, ubase[64], F.G, (int)blockIdx.x, fLST(F), 0, 512u, ubase + 65, (const char*)fW13(F), (size_t)512 * 1024, 512u};
    EpiG1 E{fH(F), fGS(F), cnt, 0, ubase + 65};
    pg8::gemm_phase<EpiG1, MoeOrder, true>(F.lds, F.lds + LDS_VOFF, (const char*)fXB8(F), 512, 512, S, E);
}
__device__ __forceinline__ void phase_moe_g2(const Frame& F, int l) {
    LAS int *cnt, *ubase; moe_tables(F, l, 4, cnt, ubase);
    MoeOrder S{cnt, ubase, 4, ubase[64], F.G, (int)blockIdx.x, fLST(F), -1, 128u, ubase + 65, (const char*)fW2(F), (size_t)1024 * 256, 128u};
    EpiG2 E{fYB(F), cnt, ubase + 65};
    pg8::gemm_phase<EpiG2, MoeOrder, true>(F.lds, F.lds + LDS_VOFF, (const char*)fH(F), 128, 128, S, E);
}
constexpr int AT_K0 = 0, AT_KSZ = 12288, AT_V0 = 2 * AT_KSZ, AT_VSZ = 8192, AT_TBL = AT_V0 + 2 * AT_VSZ;

__device__ __forceinline__ float t5_dist_bias(const float* rel_bias, int head10, int d) {
    int bk;
    if (d < 16) bk = d;
    else { const float v = logf((float)d / 16.0f) / 4.852030263919617f * 16.0f; bk = 16 + (int)v; bk = bk < 31 ? bk : 31; }
    return rel_bias[bk * 10 + head10];
}

__device__ __forceinline__ void phase_dist_tables(const Frame& F, const float* rel_bias) {
    for (int i = F.vcu * NTHR + F.tid; i < 10 * 2112; i += F.G * NTHR) { const int h = i / 2112, e = i % 2112, d = e - 64; float v;
        if (h < 6) { const int mlt = (d <= 128 ? 1 : 0) + (((d & 3) == 0 && d <= 512) ? 1 : 0) + (((d & 15) == 0) ? 1 : 0);
            v = (d >= 0 && mlt) ? (t5_dist_bias(rel_bias, h, d) + logf((float)mlt)) * LOG2E : -INFINITY; }
        else v = d >= 0 ? t5_dist_bias(rel_bias, h, d) * LOG2E : 0.f;
        fDTAB(F)[i] = v; }
}

template <int MODE, int KS>
__device__ __forceinline__ void attn_unit(const Frame& F, const int b, const int qb,
                                          const bf16_t* __restrict__ Qp, const int ldq, const bf16_t* __restrict__ Kp, const int ldk, const bf16_t* __restrict__ KRp,
                                          const bf16_t* __restrict__ Vp, const int ldv, bf16_t* __restrict__ Op, const unsigned* __restrict__ maskp, const float* dtab, const int head10) {
    LAS unsigned char* lds = F.lds;
    const int tid = F.tid, lane = F.lane, w = F.wave, q32 = lane & 31, hh = lane >> 5;
    const size_t tb = (size_t)b * SEQ;
    const int qw0 = qb * 256 + 32 * w, qpos = qw0 + q32;
    const int ntile = 4 * (qb + 1);
    __syncthreads();
    if (MODE != 0) {
        LAS float* tblw = (LAS float*)(lds + AT_TBL); const float* src = dtab + head10 * 2112;
        for (int i = tid; i < SEQ + 64; i += NTHR) tblw[i] = src[i];
    }
    bf16x8 qf[KS];
    { const bf16_t* qr = Qp + (tb + qpos) * (size_t)ldq + 8 * hh;
#pragma unroll
      for (int ks = 0; ks < KS; ++ks) { if (MODE == 0 && ks >= 4) qf[ks] = *(const bf16x8*)(qr + 16 * ks); else qf[ks] = *(const bf16x8*)(qr + 16 * ks); } }
    const int skey = tid >> 3, sch = tid & 7;
    const bf16_t* kg = Kp + (tb + skey) * (size_t)ldk + 8 * sch;
    const bf16_t* vg = Vp + (tb + skey) * (size_t)ldv + 8 * sch;
    const bf16_t* rg = (MODE == 0) ? KRp + (tb + (tid >> 2)) * 32 + 8 * (tid & 3) : nullptr;
    const int kdst = sch * 1024 + ((skey ^ sch) << 4);
    const int rdst = (8 + (tid & 3)) * 1024 + ((((tid >> 2) & 63) ^ (tid & 3)) << 4);
    const int vdst = (sch >> 2) * 4096 + skey * 64 + (sch & 3) * 16;
    const unsigned* mg = (MODE == 1) ? maskp + (tb + qpos) * 64 : nullptr;
    u32x4 kreg, vreg, rreg; u32x2 mw = {0u, 0u}, mwn = {0u, 0u};
    kreg = *(const u32x4*)kg; vreg = *(const u32x4*)vg; if (MODE == 0 && tid < 256) rreg = *(const u32x4*)rg;
    if (MODE == 1) mw = *(const u32x2*)mg;
    *(LAS u32x4*)(lds + AT_K0 + kdst) = kreg; *(LAS u32x4*)(lds + AT_V0 + vdst) = vreg; if (MODE == 0 && tid < 256) *(LAS u32x4*)(lds + AT_K0 + rdst) = rreg;
    __syncthreads();
    f32x16 o0, o1;
#pragma unroll
    for (int r = 0; r < 16; ++r) { o0[r] = 0.f; o1[r] = 0.f; }
    float lsum = 0.f; bool started = false;
    f32x16 negm;
#pragma unroll
    for (int r = 0; r < 16; ++r) negm[r] = 0.f;
    const LAS float* tbl = (const LAS float*)(lds + AT_TBL);
    for (int t = 0; t < ntile; ++t) {
        const int buf = t & 1;
        if (t + 1 < ntile) { kreg = *(const u32x4*)(kg + (size_t)(t + 1) * 64 * ldk); vreg = *(const u32x4*)(vg + (size_t)(t + 1) * 64 * ldv);
            if (MODE == 0 && tid < 256) rreg = *(const u32x4*)(rg + (size_t)(t + 1) * 64 * 32);
            if (MODE == 1) mwn = *(const u32x2*)(mg + 2 * (t + 1)); }
        const int k0 = 64 * t;
        if (k0 <= qw0 + 31) {
            const LAS unsigned char* kb = lds + AT_K0 + buf * AT_KSZ; const LAS unsigned char* vb = lds + AT_V0 + buf * AT_VSZ;
            f32x16 s0, s1;
#pragma unroll
            for (int ks = 0; ks < KS; ++ks) { const int c = 2 * ks + hh;
                const bf16x8 a0 = *(const LAS bf16x8*)(kb + c * 1024 + ((q32 ^ (c & 7)) << 4));
                const bf16x8 a1 = *(const LAS bf16x8*)(kb + c * 1024 + (((32 + q32) ^ (c & 7)) << 4));
                if (ks == 0) { s0 = __builtin_amdgcn_mfma_f32_32x32x16_bf16(a0, qf[0], negm, 0, 0, 0); s1 = __builtin_amdgcn_mfma_f32_32x32x16_bf16(a1, qf[0], negm, 0, 0, 0); }
                else { s0 = __builtin_amdgcn_mfma_f32_32x32x16_bf16(a0, qf[ks], s0, 0, 0, 0); s1 = __builtin_amdgcn_mfma_f32_32x32x16_bf16(a1, qf[ks], s1, 0, 0, 0); } }
            if (MODE == 0) { if (k0 + 63 > qw0) {
#pragma unroll
                for (int r = 0; r < 16; ++r) { const int key = k0 + (r & 3) + 8 * (r >> 2) + 4 * hh; if (key > qpos) s0[r] = -INFINITY; if (key + 32 > qpos) s1[r] = -INFINITY; } } }
            if (MODE == 1) { const unsigned w0 = mw[0] >> (4 * hh), w1 = mw[1] >> (4 * hh); const LAS float* tp = tbl + (qpos - k0 - 4 * hh + 64);
#pragma unroll
                for (int r = 0; r < 16; ++r) { const int bit = (r & 3) + 8 * (r >> 2);
                    const float t0 = tp[-bit], t1 = tp[-bit - 32];
                    s0[r] = ((w0 >> bit) & 1u) ? s0[r] + t0 : -INFINITY; s1[r] = ((w1 >> bit) & 1u) ? s1[r] + t1 : -INFINITY; } }
            if (MODE == 2) { const LAS float* tp = tbl + (qpos - k0 - 4 * hh + 64);
#pragma unroll
                for (int r = 0; r < 16; ++r) { const int bit = (r & 3) + 8 * (r >> 2); s0[r] += tp[-bit]; s1[r] += tp[-bit - 32]; } }
            float mx = fmaxf(s0[0], s1[0]);
#pragma unroll
            for (int r = 1; r < 16; ++r) mx = fmaxf(mx, fmaxf(s0[r], s1[r]));
            mx = fmaxf(mx, __shfl_xor(mx, 32));
            const bool need = (mx > 8.0f) || (!started && mx > -INFINITY);
            if (__any(need)) {
                const float delta = need ? mx : 0.f, alpha = __builtin_amdgcn_exp2f(-delta);
                lsum *= alpha;
#pragma unroll
                for (int r = 0; r < 16; ++r) { o0[r] *= alpha; o1[r] *= alpha; negm[r] -= delta; s0[r] -= delta; s1[r] -= delta; }
            }
            started = started || (mx > -INFINITY);
            float ps = 0.f;
#pragma unroll
            for (int r = 0; r < 16; ++r) { s0[r] = __builtin_amdgcn_exp2f(s0[r]); s1[r] = __builtin_amdgcn_exp2f(s1[r]); ps += s0[r] + s1[r]; }
            lsum += ps;
            bf16x8 pb[4];
#pragma unroll
            for (int s2 = 0; s2 < 2; ++s2) {
                u32x4 a = {cvt_pk(s0[8 * s2 + 0], s0[8 * s2 + 1]), cvt_pk(s0[8 * s2 + 2], s0[8 * s2 + 3]), cvt_pk(s0[8 * s2 + 4], s0[8 * s2 + 5]), cvt_pk(s0[8 * s2 + 6], s0[8 * s2 + 7])};
                u32x4 c = {cvt_pk(s1[8 * s2 + 0], s1[8 * s2 + 1]), cvt_pk(s1[8 * s2 + 2], s1[8 * s2 + 3]), cvt_pk(s1[8 * s2 + 4], s1[8 * s2 + 5]), cvt_pk(s1[8 * s2 + 6], s1[8 * s2 + 7])};
                pb[s2] = __builtin_bit_cast(bf16x8, a); pb[2 + s2] = __builtin_bit_cast(bf16x8, c); }
            const int vlane = (4 * hh + ((lane & 15) >> 2)) * 64 + (((lane >> 4) & 1) * 16 + 4 * (lane & 3)) * 2;
#pragma unroll
            for (int dt = 0; dt < 2; ++dt) {
#pragma unroll
                for (int kk = 0; kk < 4; ++kk) {
                    const LAS unsigned char* va = vb + dt * 4096 + kk * 16 * 64 + vlane;
                    const s16x4 lo = __builtin_bit_cast(s16x4, __builtin_amdgcn_ds_read_tr16_b64_v4i16((LAS s16x4*)(va)));
                    const s16x4 hi = __builtin_bit_cast(s16x4, __builtin_amdgcn_ds_read_tr16_b64_v4i16((LAS s16x4*)(va + 8 * 64)));
                    const bf16x8 vf = {lo[0], lo[1], lo[2], lo[3], hi[0], hi[1], hi[2], hi[3]};
                    if (dt == 0) o0 = __builtin_amdgcn_mfma_f32_32x32x16_bf16(vf, pb[kk], o0, 0, 0, 0);
                    else o1 = __builtin_amdgcn_mfma_f32_32x32x16_bf16(vf, pb[kk], o1, 0, 0, 0); } }
        }
        if (t + 1 < ntile) { const int nb = (t + 1) & 1;
            *(LAS u32x4*)(lds + AT_K0 + nb * AT_KSZ + kdst) = kreg; *(LAS u32x4*)(lds + AT_V0 + nb * AT_VSZ + vdst) = vreg;
            if (MODE == 0 && tid < 256) *(LAS u32x4*)(lds + AT_K0 + nb * AT_KSZ + rdst) = rreg;
            if (MODE == 1) mw = mwn; }
        __syncthreads();
    }
    const float ltot = lsum + __shfl_xor(lsum, 32);
    const float inv = ltot > 0.f ? 1.0f / ltot : 0.f;
    bf16_t* orow = Op + (tb + qpos) * 1024 + 4 * hh;
#pragma unroll
    for (int g = 0; g < 4; ++g) {
        *(u32x2*)(orow + 8 * g) = (u32x2){cvt_pk(o0[4 * g] * inv, o0[4 * g + 1] * inv), cvt_pk(o0[4 * g + 2] * inv, o0[4 * g + 3] * inv)};
        *(u32x2*)(orow + 32 + 8 * g) = (u32x2){cvt_pk(o1[4 * g] * inv, o1[4 * g + 1] * inv), cvt_pk(o1[4 * g + 2] * inv, o1[4 * g + 3] * inv)}; }
}

__device__ __forceinline__ void phase_attention(const Frame& F, const Params& p, const int l) {
    int slice = 0;
    constexpr int KTOT = (65 * 384 + 2047) / 2048 + 1;
    for (int L = (int)blockIdx.x; L < 2048; L += F.G) {
        const int level = L >> 8, idx = ((L & 255) + 37 * level) & 255, qb = 7 - level;
        if (idx < 96) { const int b = idx / 6, h = idx % 6;
            attn_unit<0, 6>(F, b, qb, fMQ(F) + h * 96, 576, fMK(F) + h * 64, 384, fKR(F), fMV(F) + h * 64, 384, fAO(F) + 640 + h * 64, nullptr, nullptr, 0);
        } else if (idx < 160) { const int j = idx - 96, b = j >> 2, h = j & 3;
            attn_unit<1, 4>(F, b, qb, fU(F) + U_SQ + h * 64, LDU, fU(F) + U_SK + h * 64, LDU, nullptr, fU(F) + U_SV + h * 64, LDU, fAO(F) + 384 + h * 64, fMASK(F), fDTAB(F), 6 + h);
        } else { const int j = idx - 160, b = j / 6, h = j % 6;
            attn_unit<2, 4>(F, b, qb, fU(F) + U_DQ + h * 64, LDU, fU(F) + U_DK + h * 64, LDU, nullptr, fU(F) + U_DV + h * 64, LDU, fAO(F) + h * 64, nullptr, fDTAB(F), h);
        }
        convert_experts(F, p, l, 2 * slice, 2 * slice + 2, 65536); ++slice;
    }
    { const int NGW = F.G * NWAVES; const int kmax = (65 * 384 + NGW - 1) / NGW; if (2 * slice < kmax) convert_experts(F, p, l, 2 * slice, kmax, 65536); }
}
__device__ __forceinline__ int wave_isum(int c) {
    c += __builtin_amdgcn_update_dpp(0, c, 0x128, 0xf, 0xf, false);
    c += __builtin_amdgcn_update_dpp(0, c, 0x124, 0xf, 0xf, false);
    c += __builtin_amdgcn_update_dpp(0, c, 0x122, 0xf, 0xf, false);
    c += __builtin_amdgcn_update_dpp(0, c, 0x121, 0xf, 0xf, false);
    return __builtin_amdgcn_readlane(c, 0) + __builtin_amdgcn_readlane(c, 16) + __builtin_amdgcn_readlane(c, 32) + __builtin_amdgcn_readlane(c, 48);
}
__device__ __forceinline__ float wave_fmax(float v) {
#define DPPF(x, c) __builtin_bit_cast(float, __builtin_amdgcn_update_dpp(0, __builtin_bit_cast(int, x), c, 0xf, 0xf, false))
    v = fmaxf(v, DPPF(v, 0x128)); v = fmaxf(v, DPPF(v, 0x124)); v = fmaxf(v, DPPF(v, 0x122)); v = fmaxf(v, DPPF(v, 0x121));
    const int i = __builtin_bit_cast(int, v);
    return fmaxf(fmaxf(__builtin_bit_cast(float, __builtin_amdgcn_readlane(i, 0)), __builtin_bit_cast(float, __builtin_amdgcn_readlane(i, 16))), fmaxf(__builtin_bit_cast(float, __builtin_amdgcn_readlane(i, 32)), __builtin_bit_cast(float, __builtin_amdgcn_readlane(i, 48))));
}
__device__ __forceinline__ float wave_fmin(float v) {
    v = fminf(v, DPPF(v, 0x128)); v = fminf(v, DPPF(v, 0x124)); v = fminf(v, DPPF(v, 0x122)); v = fminf(v, DPPF(v, 0x121));
    const int i = __builtin_bit_cast(int, v);
    return fminf(fminf(__builtin_bit_cast(float, __builtin_amdgcn_readlane(i, 0)), __builtin_bit_cast(float, __builtin_amdgcn_readlane(i, 16))), fminf(__builtin_bit_cast(float, __builtin_amdgcn_readlane(i, 32)), __builtin_bit_cast(float, __builtin_amdgcn_readlane(i, 48))));
#undef DPPF
}
template <int NJ> __device__ __forceinline__ int count_ge(const float (&x)[32], const float v) {
    unsigned acc = 0u;
#pragma unroll
    for (int j = 0; j < NJ; ++j) acc = __builtin_amdgcn_alignbit(acc, __builtin_bit_cast(unsigned, x[j] - v), 31);
    return 64 * NJ - wave_isum(__builtin_popcount(acc));
}
template <int NJ> __device__ __forceinline__ unsigned long long select_row(const LAS float* srow, const int q, const int lane) {
    float x[32];
#pragma unroll
    for (int j = 0; j < NJ; ++j) x[j] = srow[64 * j];
#pragma unroll
    for (int j = 0; j < NJ; ++j) x[j] = (64 * j + lane <= q) ? x[j] : -INFINITY;
    float mx = -INFINITY, mn = INFINITY;
#pragma unroll
    for (int j = 0; j < NJ; ++j) { mx = fmaxf(mx, x[j]); mn = fminf(mn, x[j] == -INFINITY ? INFINITY : x[j]); }
    float lo = wave_fmin(mn), hi = wave_fmax(mx);
    float thr = 0.f; bool exact = false;
    int c_hi = count_ge<NJ>(x, hi), c_lo = q + 1;
    if (c_hi < 256) {
#pragma unroll 1
        for (int it = 0; it < 320; ++it) {
            float mid = 0.5f * lo + 0.5f * hi;
            if (!(mid > lo && mid < hi)) break;
            if (false) { const float fr = ((float)(c_lo - 256) + 0.5f) / (float)(c_lo - c_hi), tc = lo + fr * (hi - lo); if (tc > lo && tc < hi) mid = tc; }
            const int c = count_ge<NJ>(x, mid);
            if (c == 256) { thr = mid; exact = true; break; }
            if (c > 256) { lo = mid; c_lo = c; } else { hi = mid; c_hi = c; }
        }
    } else { lo = hi; hi = INFINITY; c_hi = 0; }
    unsigned long long myw = 0ull;
    if (exact) {
#pragma unroll
        for (int j = 0; j < NJ; ++j) { const unsigned long long sel = __ballot(x[j] >= thr); if (lane == j) myw = sel; }
    } else {
        int need = 256 - c_hi;
#pragma unroll 1
        for (int j = 0; j < NJ; ++j) { float xj = x[0];
#pragma unroll
            for (int k = 1; k < NJ; ++k) xj = (k == j) ? x[k] : xj;
            const unsigned long long eq = __ballot(xj == lo); const int rank = __builtin_popcountll(eq & ((1ull << lane) - 1ull));
            const unsigned long long sel = __ballot(xj >= hi) | __ballot(xj == lo && rank < need); const int ne = __builtin_popcountll(eq); need = need > ne ? need - ne : 0;
            if (lane == j) myw = sel; }
    }
    return myw;
}
constexpr int IX_PITCH = 2052, IX_IQ = 16 * IX_PITCH * 4, IX_IW = IX_IQ + 16384;
typedef float f32x4_t __attribute__((ext_vector_type(4)));
__device__ __forceinline__ void indexer_block(const Frame& F, const int b, const int qk) {
    LAS unsigned char* lds = F.lds;
    const int tid = F.tid, lane = F.lane, w = F.wave, q16 = lane & 15, kg = lane >> 4;
    const size_t tb = (size_t)b * SEQ; const int q0 = 16 * qk, ntile = qk + 1;
    LAS float* sl = (LAS float*)lds;
    __syncthreads();
#pragma unroll
    for (int i = 0; i < 2; ++i) { const int idx = tid + 512 * i, q = idx >> 6, c = idx & 63;
        *(LAS u32x4*)(lds + IX_IQ + c * 256 + q * 16) = *(const u32x4*)(fU(F) + (tb + q0 + q) * LDU + U_IQ + 8 * c); }
    if (tid < 128) { const int q = tid >> 3, h8 = tid & 7; ((LAS float*)(lds + IX_IW))[h8 * 16 + q] = bf2f(fU(F)[(tb + q0 + q) * LDU + U_IW + h8]); }
    __syncthreads();
    const int qpos = q0 + q16;
    bf16x8 kf[2];
    if (w < ntile) { const bf16_t* kr = fU(F) + (tb + 16 * w + q16) * LDU + U_IK + 8 * kg; kf[0] = *(const bf16x8*)kr; kf[1] = *(const bf16x8*)(kr + 32); }
#pragma unroll 1
    for (int ti = w; ti < ntile; ti += NWAVES) {
        const int key0 = 16 * ti;
        bf16x8 kn[2];
        { const int tn = (ti + NWAVES < ntile) ? ti + NWAVES : ti; const bf16_t* kr = fU(F) + (tb + 16 * tn + q16) * LDU + U_IK + 8 * kg; kn[0] = *(const bf16x8*)kr; kn[1] = *(const bf16x8*)(kr + 32); }
        f32x4 sc = {0.f, 0.f, 0.f, 0.f};
#pragma unroll
        for (int h8 = 0; h8 < 8; ++h8) {
            const float iwq = ((const LAS float*)(lds + IX_IW))[h8 * 16 + q16];
            f32x4 a = {0.f, 0.f, 0.f, 0.f};
#pragma unroll
            for (int ks = 0; ks < 2; ++ks) { const bf16x8 qv = *(const LAS bf16x8*)(lds + IX_IQ + (8 * h8 + 4 * ks + kg) * 256 + q16 * 16);
                a = __builtin_amdgcn_mfma_f32_16x16x32_bf16(kf[ks], qv, a, 0, 0, 0); }
#pragma unroll
            for (int r = 0; r < 4; ++r) sc[r] += iwq * fmaxf(a[r], 0.f);
        }
        if (ti == qk) {
#pragma unroll
            for (int r = 0; r < 4; ++r) { const int key = key0 + 4 * kg + r; if (key > qpos) sc[r] = -INFINITY; } }
        *(LAS f32x4*)(sl + q16 * IX_PITCH + key0 + 4 * kg) = sc;
        kf[0] = kn[0]; kf[1] = kn[1];
    }
    __syncthreads();
#pragma unroll 1
    for (int rr = 0; rr < 2; ++rr) {
        const int ql = w + 8 * rr, q = q0 + ql, n = q + 1;
        unsigned long long myw = 0ull;
        if (n <= 256) {
            if (lane < 32) { const int lo = 64 * lane; myw = (lo + 63 <= q) ? ~0ull : (lo <= q ? ((1ull << (q - lo + 1)) - 1ull) : 0ull); }
        } else {
            const LAS float* srow = sl + ql * IX_PITCH + lane; const int nj = (q0 + 16 + 63) >> 6;
            if (nj <= 8) myw = select_row<8>(srow, q, lane); else if (nj <= 16) myw = select_row<16>(srow, q, lane); else if (nj <= 24) myw = select_row<24>(srow, q, lane); else myw = select_row<32>(srow, q, lane);
        }
        if (lane < 32) *(unsigned long long*)(fMASK(F) + (tb + q) * 64 + 2 * lane) = myw;
    }
}
__device__ __forceinline__ void phase_indexer(const Frame& F) {
    for (int L = (int)blockIdx.x; L < 1024; L += F.G) { const int b = L >> 6, j = L & 63;
#pragma unroll 1
        for (int s = 0; s < 2; ++s) indexer_block(F, b, s ? j : 127 - j); }
}

__device__ __forceinline__ void ln_finish(const Frame& F, float (&v)[16], const float* g, const float* bta, bf16_t* ob, float* of, unsigned char* o8 = nullptr) {
    float s = 0.f;
#pragma unroll
    for (int j = 0; j < 16; ++j) s += v[j];
    const float mean = wave_sum(s) * (1.f / 1024.f); float s2 = 0.f;
#pragma unroll
    for (int j = 0; j < 16; ++j) { v[j] -= mean; s2 += v[j] * v[j]; }
    const float rstd = 1.f / sqrtf(wave_sum(s2) * (1.f / 1024.f) + LN_EPS);
    const int c0 = 16 * F.lane; float o[16];
#pragma unroll
    for (int q4 = 0; q4 < 4; ++q4) { const f32x4 gg = *(const f32x4*)(g + c0 + 4 * q4), bb = *(const f32x4*)(bta + c0 + 4 * q4);
#pragma unroll
        for (int j = 0; j < 4; ++j) o[4 * q4 + j] = v[4 * q4 + j] * rstd * gg[j] + bb[j]; }
    if (ob) { *(u32x4*)(ob + c0) = (u32x4){cvt_pk(o[0], o[1]), cvt_pk(o[2], o[3]), cvt_pk(o[4], o[5]), cvt_pk(o[6], o[7])};
              *(u32x4*)(ob + c0 + 8) = (u32x4){cvt_pk(o[8], o[9]), cvt_pk(o[10], o[11]), cvt_pk(o[12], o[13]), cvt_pk(o[14], o[15])}; }
    if (o8) *(u32x4*)(o8 + c0) = (u32x4){pk_fp8x4(o[0] * X8_SCALE, o[1] * X8_SCALE, o[2] * X8_SCALE, o[3] * X8_SCALE), pk_fp8x4(o[4] * X8_SCALE, o[5] * X8_SCALE, o[6] * X8_SCALE, o[7] * X8_SCALE),
                                          pk_fp8x4(o[8] * X8_SCALE, o[9] * X8_SCALE, o[10] * X8_SCALE, o[11] * X8_SCALE), pk_fp8x4(o[12] * X8_SCALE, o[13] * X8_SCALE, o[14] * X8_SCALE, o[15] * X8_SCALE)};
    if (of) {
#pragma unroll
        for (int q4 = 0; q4 < 4; ++q4) *(f32x4*)(of + c0 + 4 * q4) = (f32x4){o[4 * q4], o[4 * q4 + 1], o[4 * q4 + 2], o[4 * q4 + 3]}; }
}
__device__ __forceinline__ void ld16(float (&v)[16], const bf16_t* row, int lane, float sc) {
#pragma unroll
    for (int h = 0; h < 2; ++h) { const u32x4 q = *(const u32x4*)(row + 16 * lane + 8 * h);
#pragma unroll
        for (int j = 0; j < 4; ++j) { v[8 * h + 2 * j] = sc * bf2f(q[j] & 0xffffu); v[8 * h + 2 * j + 1] = sc * bf2f(q[j] >> 16); } }
}
__device__ __forceinline__ void add16(float (&v)[16], const bf16_t* row, int lane) {
#pragma unroll
    for (int h = 0; h < 2; ++h) { const u32x4 q = *(const u32x4*)(row + 16 * lane + 8 * h);
#pragma unroll
        for (int j = 0; j < 4; ++j) { v[8 * h + 2 * j] += bf2f(q[j] & 0xffffu); v[8 * h + 2 * j + 1] += bf2f(q[j] >> 16); } }
}
typedef float f32x2v __attribute__((ext_vector_type(2)));
__device__ __forceinline__ void add16_fp8(float (&v)[16], const unsigned char* row, int lane) {
    const u32x4 q = __builtin_nontemporal_load((const u32x4*)(row + 16 * lane));
#pragma unroll
    for (int j = 0; j < 4; ++j) { const f32x2v a = __builtin_amdgcn_cvt_pk_f32_fp8((int)q[j], false), b = __builtin_amdgcn_cvt_pk_f32_fp8((int)q[j], true);
        v[4 * j] += a[0]; v[4 * j + 1] += a[1]; v[4 * j + 2] += b[0]; v[4 * j + 3] += b[1]; }
}
__device__ __forceinline__ void phase_ln1(const Frame& F, const Params& p, int l) {
    const int gw = F.vcu * NWAVES + F.wave, NGW = F.G * NWAVES;
    for (int m = gw; m < T; m += NGW) { bf16_t* row = fXB(F) + (size_t)m * 1024; float v[16]; ld16(v, row, F.lane, 1.0f);
        ln_finish(F, v, p.ln1_g + l * 1024, p.ln1_b + l * 1024, row, nullptr, fXB8(F) + (size_t)m * 1024); }
}
__device__ __forceinline__ void phase_ln2(const Frame& F, const Params& p, int l) {
    const int gw = F.vcu * NWAVES + F.wave, NGW = F.G * NWAVES; const bool lastl = (l == NL - 1);
    LAS int* cb = (LAS int*)(F.lds + LDS_TBL);
    __syncthreads();
    if (F.tid == 0) { int c = 0; for (int e = 0; e < 64; ++e) { cb[e] = c; c += (int)F.ctl[CW_CNT + l * 64 + e]; } }
    __syncthreads();
    for (int m = gw; m < T; m += NGW) { bf16_t* row = fXB(F) + (size_t)m * 1024;
        const unsigned pkv = fPK(F)[(size_t)m * 8 + (F.lane & 7)];
        float r[16];
#pragma unroll
        for (int j = 0; j < 16; ++j) r[j] = 0.f;
#pragma unroll
        for (int k = 0; k < 8; ++k) { const unsigned pe = (unsigned)__builtin_amdgcn_readlane((int)pkv, k); const int srow = cb[pe >> 16] + (int)(pe & 0xffffu);
            add16_fp8(r, fYB(F) + (size_t)srow * 1024, F.lane); }
        float v[16]; ld16(v, row, F.lane, DN_ALPHA); add16(v, fSH(F) + (size_t)m * 1024, F.lane);
#pragma unroll
        for (int j = 0; j < 16; ++j) v[j] += r[j] * (1.0f / YB_SCALE);
        ln_finish(F, v, p.ln2_g + l * 1024, p.ln2_b + l * 1024, lastl ? nullptr : row, lastl ? p.out + (size_t)m * 1024 : nullptr); }
}

__device__ __forceinline__ void phase_route(const Frame& F, const Params& p, int l) {
    LAS int* lcnt = (LAS int*)(F.lds + LDS_TBL + 8192); LAS int* lbase = lcnt + 64;
    const float* rb = p.router_b + l * 64;
    const int nth = F.G * NTHR, iters = (T + nth - 1) / nth;
    for (int it = 0; it < iters; ++it) {
        const int t = it * nth + F.vcu * NTHR + F.tid; const bool act = t < T;
        __syncthreads();
        if (F.tid < 64) lcnt[F.tid] = 0;
        __syncthreads();
        int ek[8], pk[8]; float gk[8];
        if (act) {
            float sel[64];
            const float* l0 = fLG(F) + (size_t)t * 64; const float* l1 = fLG(F) + ((size_t)T + t) * 64;
#pragma unroll
            for (int e4 = 0; e4 < 16; ++e4) { const f32x4 a = *(const f32x4*)(l0 + 4 * e4), c = *(const f32x4*)(l1 + 4 * e4), bb = *(const f32x4*)(rb + 4 * e4);
#pragma unroll
                for (int j = 0; j < 4; ++j) sel[4 * e4 + j] = 1.0f / (1.0f + __expf(-(a[j] + c[j]))) + bb[j]; }
            float gs = 0.f;
#pragma unroll
            for (int k = 0; k < 8; ++k) { float best = -INFINITY; int bi = 0;
#pragma unroll
                for (int e = 0; e < 64; ++e) { const bool gt = sel[e] > best; best = gt ? sel[e] : best; bi = gt ? e : bi; }
#pragma unroll
                for (int e = 0; e < 64; ++e) sel[e] = (e == bi) ? -INFINITY : sel[e];
                ek[k] = bi; gk[k] = best - rb[bi]; gs += gk[k]; }
            const float sc = ROUTED_SCALE / gs;
#pragma unroll
            for (int k = 0; k < 8; ++k) { gk[k] *= sc; pk[k] = __hip_atomic_fetch_add(lcnt + ek[k], 1, __ATOMIC_RELAXED, __HIP_MEMORY_SCOPE_WORKGROUP); }
        }
        __syncthreads();
        if (F.tid < 64) { const int c = lcnt[F.tid]; lbase[F.tid] = c ? (int)__hip_atomic_fetch_add(F.ctl + CW_CNT + l * 64 + F.tid, (unsigned)c, __ATOMIC_RELAXED, __HIP_MEMORY_SCOPE_AGENT) : 0; }
        __syncthreads();
        if (act) {
#pragma unroll
            for (int k = 0; k < 8; ++k) { const int pos = lbase[ek[k]] + pk[k]; fLST(F)[(size_t)ek[k] * T + pos] = (unsigned)t; fGS(F)[(size_t)ek[k] * T + pos] = gk[k]; fPK(F)[(size_t)t * 8 + k] = ((unsigned)ek[k] << 16) | (unsigned)pos; } }
    }
}
__device__ __forceinline__ void frame_init(Frame& F, const Params& p, unsigned char* lds) {
    F.lds = (LAS unsigned char*)lds; F.MISC = (volatile LAS unsigned*)(F.lds + LDS_MISC);
    F.tid = threadIdx.x; F.lane = F.tid & 63; F.wave = __builtin_amdgcn_readfirstlane(F.tid >> 6);
    F.G = gridDim.x; { const int bx = blockIdx.x; F.vcu = (F.G % 8 == 0) ? (bx % 8) * (F.G / 8) + bx / 8 : bx; }
    F.ws = p.ws; F.ctl = (unsigned*)(p.ws + WS_CTL);
}

constexpr int NPHASE = 1 + 10 * NL;
__global__ void __launch_bounds__(NTHR, 2) mega(Params p) {
    extern __shared__ __attribute__((aligned(16))) unsigned char lds_raw[];
    Frame F; frame_init(F, p, lds_raw);
    if (F.tid < 64) F.MISC[F.tid] = 0u;
    __syncthreads();
    const int lo = p.ph_lo, hi = p.ph_hi;
    XcdBarrier bar; bar.bar = F.ctl + CW_BAR; bar.x = 0; bar.st = F.MISC + 8;
    if (hi - lo > 1) bar = xcd_barrier_post(F.ctl + CW_BAR, F.MISC + 8);
#define IN(k) (lo <= (k) && (k) < hi)
#define SEAM(k) do { if (IN(k) && IN((k) + 1)) xcd_barrier(bar); } while (0)
    if (IN(0)) { const Frame Fp = phase_frame(F); phase_x_to_xb(Fp, p.x); phase_rope_table(Fp, p.pos); phase_dist_tables(Fp, p.rel_bias); convert_small(Fp, p, 0); }
    SEAM(0);
    for (int l = 0; l < NL; ++l) {
        const int pb = 1 + 10 * l;
        if (IN(pb + 0)) phase_inproj(phase_frame(F));
        SEAM(pb + 0);
        if (IN(pb + 1)) { phase_indexer(phase_frame(F)); phase_mla_up(phase_frame(F), p); }
        SEAM(pb + 1);
        if (IN(pb + 2)) phase_attention(phase_frame(F), p, l);
        SEAM(pb + 2);
        if (IN(pb + 3)) phase_outproj(phase_frame(F));
        SEAM(pb + 3);
        if (IN(pb + 4)) phase_ln1(phase_frame(F), p, l);
        SEAM(pb + 4);
        if (IN(pb + 5)) phase_router_sharedg1(phase_frame(F));
        SEAM(pb + 5);
        if (IN(pb + 6)) phase_route(phase_frame(F), p, l);
        SEAM(pb + 6);
        if (IN(pb + 7)) phase_moe_g1(phase_frame(F), l);
        SEAM(pb + 7);
        if (IN(pb + 8)) { phase_moe_g2(phase_frame(F), l); phase_shared_g2(phase_frame(F)); }
        SEAM(pb + 8);
        if (IN(pb + 9)) { phase_ln2(phase_frame(F), p, l); if (l + 1 < NL) convert_small(phase_frame(F), p, l + 1); }
        SEAM(pb + 9);
    }
#undef IN
#undef SEAM
}
#ifndef DBG
#define DBG 0
#endif
#if DBG
#endif
extern "C" void kernel_launch(void* const* d_in, const int* in_sizes, int n_in, void* d_out, int out_size, void* d_ws, size_t ws_size, hipStream_t stream) {
    static int grid = 0;
    if (grid == 0) {
        if (n_in != 21 || out_size != T * DM || ws_size < WS_END) { fprintf(stderr, "kernel_launch: unexpected problem (n_in %d, out %d, ws %zu < %zu); nothing launched\n", n_in, out_size, ws_size, (size_t)WS_END); grid = -1; return; }
        int dev = 0, cus = 0, per_cu = 0;
        if (hipGetDevice(&dev) != hipSuccess || hipDeviceGetAttribute(&cus, hipDeviceAttributeMultiprocessorCount, dev) != hipSuccess) { grid = -1; return; }
        if (hipFuncSetAttribute((const void*)mega, hipFuncAttributeMaxDynamicSharedMemorySize, LDS_BYTES) != hipSuccess) { fprintf(stderr, "kernel_launch: hipFuncSetAttribute failed\n"); grid = -1; return; }
        if (hipOccupancyMaxActiveBlocksPerMultiprocessor(&per_cu, (const void*)mega, NTHR, LDS_BYTES) != hipSuccess || per_cu < 1) { fprintf(stderr, "kernel_launch: occupancy query says %d\n", per_cu); (void)hipGetLastError(); per_cu = 1; }
        grid = cus > 256 ? 256 : cus;
    }
    if (grid < 0) return;
    (void)hipMemsetAsync((char*)d_ws + WS_CTL, 0, CTL_BYTES, stream);
    Params p{};
    p.x = (const float*)d_in[0]; p.pos = (const int*)d_in[1]; p.w_in = (const float*)d_in[2]; p.q_norm = (const float*)d_in[3]; p.w_uq = (const float*)d_in[4];
    p.kv_norm = (const float*)d_in[5]; p.w_ukv = (const float*)d_in[6]; p.w_out = (const float*)d_in[7]; p.ln1_g = (const float*)d_in[8]; p.ln1_b = (const float*)d_in[9];
    p.router_w = (const float*)d_in[10]; p.router_b = (const float*)d_in[11]; p.w1 = (const float*)d_in[12]; p.w3 = (const float*)d_in[13]; p.w2 = (const float*)d_in[14];
    p.sw1 = (const float*)d_in[15]; p.sw3 = (const float*)d_in[16]; p.sw2 = (const float*)d_in[17]; p.ln2_g = (const float*)d_in[18]; p.ln2_b = (const float*)d_in[19]; p.rel_bias = (const float*)d_in[20];
    p.out = (float*)d_out; p.ws = (unsigned char*)d_ws;
#if DBG
    dbg_run(p, grid, stream);
#elif defined(MULTI_LAUNCH)
    for (int k = 0; k < NPHASE; ++k) { p.ph_lo = k; p.ph_hi = k + 1; mega<<<dim3(grid), dim3(NTHR), LDS_BYTES, stream>>>(p); }
#else
    p.ph_lo = 0; p.ph_hi = NPHASE;
    mega<<<dim3(grid), dim3(NTHR), LDS_BYTES, stream>>>(p);
#endif
}
```

```cpp
#include <hip/hip_runtime.h>
#include <cstdio>
#include <cstdint>

#define LAS __attribute__((address_space(3)))
typedef unsigned short bf16_t;
typedef short bf16x8 __attribute__((ext_vector_type(8)));
typedef short s16x4 __attribute__((ext_vector_type(4)));
typedef float f32x2 __attribute__((ext_vector_type(2)));
typedef float f32x4 __attribute__((ext_vector_type(4)));
typedef float f32x16 __attribute__((ext_vector_type(16)));
typedef unsigned u32x4 __attribute__((ext_vector_type(4)));
typedef unsigned u32x2 __attribute__((ext_vector_type(2)));
typedef __bf16 bf16x2_t __attribute__((ext_vector_type(2)));

constexpr int NB = 16, SEQ = 2048, T = NB * SEQ, DM = 1024, NL = 4;
constexpr int IN_W = 2920, LDU = 3072;
constexpr int U_DQ = 0, U_DK = 384, U_DV = 768, U_SQ = 1152, U_SK = 1408, U_SV = 1664, U_IQ = 1920, U_IK = 2432, U_IW = 2496, U_CQ = 2560, U_CKV = 2816, U_KR = 2944;
constexpr int NE = 64, FF = 256;
constexpr float LOG2E = 1.4426950408889634f;
constexpr float QSCALE = 0.125f * LOG2E;
constexpr float MLA_QSCALE = 0.10206207261596575f * LOG2E;
constexpr float DN_ALPHA = 1.6817928305074290f;
constexpr float LN_EPS = 1e-5f, RMS_EPS = 1e-6f;
constexpr float ROUTED_SCALE = 2.5f;

constexpr size_t MiB = (size_t)1 << 20;
constexpr size_t WS_CTL = 0, CTL_BYTES = 1 * MiB;
constexpr size_t WS_DTAB = 512 * 1024;
constexpr size_t WS_W = 1 * MiB;
constexpr size_t W_IN = 0, W_UQ = W_IN + (size_t)3072 * 1024 * 2, W_UKV = W_UQ + (size_t)768 * 256 * 2, W_OUT = W_UKV + (size_t)768 * 256 * 2,
                 W_R = W_OUT + (size_t)1024 * 1024 * 2, W_13 = W_R + (size_t)256 * 1024 * 2, W_2 = W_13 + (size_t)65 * 512 * 1024 * 2, W_END = W_2 + (size_t)65 * 1024 * 256 * 2;
static_assert(W_END <= 108 * MiB, "weights region");
constexpr size_t WS_XF = 109 * MiB;
constexpr size_t WS_XB = 237 * MiB;
constexpr size_t WS_H = 301 * MiB;
constexpr size_t WS_LST = 445 * MiB;
constexpr size_t WS_GATE = 453 * MiB;
constexpr size_t WS_ROPE = 454 * MiB;
constexpr size_t WS_R = 458 * MiB;
constexpr size_t R_U = 0, R_MQ = 192 * MiB, R_MK = 228 * MiB, R_MV = 252 * MiB, R_KR = 276 * MiB, R_AO = 278 * MiB, R_MASK = 342 * MiB, R_SCR = 350 * MiB, R_LG = 414 * MiB;
constexpr size_t WS_END = 970 * MiB;
constexpr int CW_TMO = 0, CW_FLAG = 16  , CW_BAR = 4096, CW_CNT = 8192  , CW_Q = 16384  ;

__device__ __forceinline__ unsigned f2bf(float f) { unsigned u = __builtin_bit_cast(unsigned, f); return (u + 0x7fffu + ((u >> 16) & 1u)) >> 16; }
__device__ __forceinline__ float bf2f(unsigned b) { return __builtin_bit_cast(float, b << 16); }
__device__ __forceinline__ unsigned cvt_pk(float lo, float hi) { f32x2 v = {lo, hi}; bf16x2_t b = __builtin_convertvector(v, bf16x2_t); return __builtin_bit_cast(unsigned, b); }
#define LDS_WAIT() asm volatile("s_waitcnt lgkmcnt(0)" ::: "memory")
#define VM_WAIT() asm volatile("s_waitcnt vmcnt(0)" ::: "memory")
__device__ __forceinline__ float wave_sum(float v) {
#pragma unroll
    for (int o = 1; o < 64; o <<= 1) v += __shfl_xor(v, o);
    return v;
}

#define XB_TMO      128
#define XB_XCNT(j)  (256  + 64 * (j))
#define XB_XSUB(j)  (1280 + 64 * (j))
#define XB_XGEN(j)  (2304 + 64 * (j))
#define XB_TOP      3328
#define XB_TOPGEN   3392
#define XCD_BAR_WORDS 3456
#define XB_SPIN_CAP (1u << 18)
__device__ __forceinline__ unsigned xb_ld(unsigned* p)              { return __hip_atomic_load(p, __ATOMIC_RELAXED, __HIP_MEMORY_SCOPE_AGENT); }
__device__ __forceinline__ unsigned xb_add(unsigned* p, unsigned v) { return __hip_atomic_fetch_add(p, v, __ATOMIC_RELAXED, __HIP_MEMORY_SCOPE_AGENT); }
__device__ __forceinline__ unsigned xb_xcc_id() { return (unsigned)__builtin_amdgcn_s_getreg((3 << 11) | 20) & 0xFu; }
#define XB_SPIN(cond, bar) do { unsigned _sp = 0; while (cond) { __builtin_amdgcn_s_sleep(1); \
    if ((++_sp & 255u) == 0u) { if (xb_ld(&(bar)[XB_TMO])) break; if (_sp > XB_SPIN_CAP) { atomicAdd(&(bar)[XB_TMO], 1u); break; } } } } while (0)
struct XcdBarrier { unsigned* bar; unsigned x; volatile LAS unsigned* st; };
__device__ __forceinline__ XcdBarrier xcd_barrier_post(unsigned* bar, volatile LAS unsigned* st) {
    XcdBarrier b; b.bar = bar; b.x = xb_xcc_id(); b.st = st;
    if (threadIdx.x == 0) (void)xb_add(&bar[XB_XCNT(b.x)], 1u);
    return b;
}
__device__ __forceinline__ void xcd_barrier_complete(unsigned* bar, unsigned x, unsigned& nloc, unsigned& nx) {
    const unsigned G = gridDim.x * gridDim.y * gridDim.z;
    unsigned sum, cnt, mine, sp = 0u;
    for (;;) {
        sum = 0u; cnt = 0u; mine = 0u;
#pragma unroll
        for (unsigned j = 0; j < 16; ++j) { const unsigned c = xb_ld(&bar[XB_XCNT(j)]); sum += c; cnt += (c > 0u) ? 1u : 0u; mine = (j == x) ? c : mine; }
        if (sum == G) break;
        __builtin_amdgcn_s_sleep(1);
        if ((++sp & 255u) == 0u) { if (xb_ld(&bar[XB_TMO])) break; if (sp > XB_SPIN_CAP) { atomicAdd(&bar[XB_TMO], 1u); break; } }
    }
    nloc = mine > 0u ? mine : 1u; nx = cnt > 0u ? cnt : 1u;
}
__device__ __forceinline__ void xcd_barrier(const XcdBarrier& b) {
    asm volatile("s_waitcnt vmcnt(0)" ::: "memory");
    __syncthreads();
    if (threadIdx.x == 0) {
        unsigned* bar = b.bar;
        __builtin_amdgcn_s_waitcnt(0);
        unsigned nloc = b.st[0], nx = b.st[1];
        if (nloc == 0u) { xcd_barrier_complete(bar, b.x, nloc, nx); b.st[0] = nloc; b.st[1] = nx; }
        const unsigned old = xb_add(&bar[XB_XSUB(b.x)], 1u);
        const unsigned gen = old / nloc;
        if (old + 1u == (gen + 1u) * nloc) {
            __builtin_amdgcn_fence(__ATOMIC_RELEASE, "agent");
            asm volatile("s_waitcnt vmcnt(0)" ::: "memory");
            const unsigned og = xb_add(&bar[XB_TOP], 1u);
            const unsigned tg = og / nx;
            if (og + 1u == (tg + 1u) * nx) xb_add(&bar[XB_TOPGEN], 1u);
            else XB_SPIN(xb_ld(&bar[XB_TOPGEN]) == tg, bar);
            __builtin_amdgcn_fence(__ATOMIC_ACQUIRE, "agent");
            xb_add(&bar[XB_XGEN(b.x)], 1u);
            asm volatile("s_waitcnt vmcnt(0)" ::: "memory");
        } else {
            XB_SPIN(xb_ld(&bar[XB_XGEN(b.x)]) == gen, bar);
            __builtin_amdgcn_fence(__ATOMIC_ACQUIRE, "agent");
            asm volatile("s_waitcnt vmcnt(0)" ::: "memory");
        }
    }
    __syncthreads();
}

namespace pg8 {
constexpr int BM = 256, BK = 64, HALF = 128, HTB = HALF * BK * 2, STAGE_BYTES = 8 * HTB, NXCD = 8, WGM = 4;
__device__ __forceinline__ int lds_byte(int r, int c) { const int st = (r >> 4) * 2 + (c >> 5), rr = r & 15, cc = c & 31, ob = rr * 64 + cc * 2; return st * 1024 + (ob ^ (((ob >> 9) & 1) << 5)); }
__device__ __forceinline__ void stage_rc(int b, int& R, int& C) { const int st = b / 1024, sb = b % 1024, swz = sb ^ (((sb >> 9) & 1) << 5); R = (st >> 1) * 16 + swz / 64; C = (st & 1) * 32 + (swz % 64) / 2; }
__device__ __forceinline__ int perm32(int rho) { const int n = rho >> 4, i = rho & 15; return 8 * (i >> 2) + 4 * n + (i & 3); }
struct Unit { int pm, pn, e, seq; };

__device__ __forceinline__ int xcd_remap(int L, int nwg) { const int q = nwg / NXCD, r = nwg % NXCD, xcd = L % NXCD, off = L / NXCD; return (xcd < r ? xcd * (q + 1) : r * (q + 1) + (xcd - r) * q) + off; }

struct DenseOrder {
    int nM, nN, nwg, G, c; unsigned lda, acol; const char* Bt; unsigned ldb;
    __device__ void init(int M, int N, int G_, int c_, unsigned lda_, unsigned acol_, const void* Bt_, unsigned ldb_) { nM = M / BM; nN = N / BM; nwg = nM * nN; G = G_; c = c_; lda = lda_; acol = acol_; Bt = (const char*)Bt_; ldb = ldb_; }
    __device__ __forceinline__ bool next(int i, Unit& u) const {
        const long L = (long)i * G + c; if (L >= nwg) return false;
        const int wgid = xcd_remap((int)L, nwg);
        const int nig = WGM * nN, gid = wgid / nig, fm = gid * WGM, gsz = (nM - fm) < WGM ? (nM - fm) : WGM;
        u.pm = fm + ((wgid % nig) % gsz); u.pn = (wgid % nig) / gsz; u.e = 0; u.seq = i; return true;
    }
    __device__ __forceinline__ void a_voff(const Unit& u, int tid, unsigned (&v)[2][2]) const {
#pragma unroll
        for (int i = 0; i < 2; ++i) { int R, C; stage_rc(tid * 16 + i * 8192, R, C);
#pragma unroll
            for (int h = 0; h < 2; ++h) v[h][i] = ((unsigned)(u.pm * BM + h * HALF + R) * lda + acol + (unsigned)C) * 2u; }
    }
    __device__ __forceinline__ const char* b_base(const Unit& u) const { return Bt + (size_t)u.pn * BM * ldb * 2; }
};

typedef int v8i32 __attribute__((ext_vector_type(8)));
template <class Epi, class Sched, bool FP8 = false>
__device__ __forceinline__ void gemm_phase(LAS unsigned char* lds, LAS unsigned char* vslot  , const char* Abase, const int K, const unsigned ldb, const Sched& S, const Epi& E) {
    int tid = threadIdx.x; asm volatile("" : "+v"(tid));
    const int wid = __builtin_amdgcn_readfirstlane(tid >> 6), wr = wid >> 2, wc = wid & 3;
    int nt = K / BK; asm volatile("" : "+s"(nt));
    unsigned voffB[2];
#pragma unroll
    for (int i = 0; i < 2; ++i) { int R, C; stage_rc(tid * 16 + i * 8192, R, C); const int Rb = (Epi::PERM == 2) ? (((R >> 5) & 3) * 64 + perm32(R & 31)) : (Epi::PERM ? ((R & ~31) + perm32(R & 31)) : R); voffB[i] = ((unsigned)Rb * ldb + (unsigned)C) * 2u; }
    const size_t kstep = (size_t)(BK * 2);
    const size_t hstepB = (size_t)(Epi::PERM == 2 ? 32 : HALF) * ldb * 2;
    const unsigned ldsw = (unsigned)wid * 1024u;
    const int aoff = lds_byte(wr * 64 + (tid & 15), ((tid & 63) >> 4) * 8), boff = lds_byte(wc * 32 + (tid & 15), ((tid & 63) >> 4) * 8);
#define PG8_SA(b, h) (((b) * 2 + (h)) * HTB)
#define PG8_SB(b, h) ((4 + (b) * 2 + (h)) * HTB)
#define PG8_STAGE(bufoff, gbase, voff) do { _Pragma("unroll") for (int _i = 0; _i < 2; ++_i) \
        __builtin_amdgcn_global_load_lds((const unsigned*)((const char*)(gbase) + (voff)[_i]), (LAS unsigned*)(lds + (bufoff) + ldsw + _i * 8192), 16, 0, 0); } while (0)
typedef int v4i32 __attribute__((ext_vector_type(4)));
#define PG8_LDA8(dst, b, h) do { _Pragma("unroll") for (int m = 0; m < 4; ++m) { dst[m].lo = *(const LAS v4i32*)(lds + PG8_SA(b, h) + aoff + m * 2048); dst[m].hi = *(const LAS v4i32*)(lds + PG8_SA(b, h) + aoff + m * 2048 + 1024); } } while (0)
#define PG8_LDB8(dst, b, h) do { _Pragma("unroll") for (int n = 0; n < 2; ++n) { dst[n].lo = *(const LAS v4i32*)(lds + PG8_SB(b, h) + boff + n * 2048); dst[n].hi = *(const LAS v4i32*)(lds + PG8_SB(b, h) + boff + n * 2048 + 1024); } } while (0)
#define PG8_MMA8(ai, bj, At, Bt) do { __builtin_amdgcn_s_setprio(1); _Pragma("unroll") for (int m = 0; m < 4; ++m) _Pragma("unroll") for (int n = 0; n < 2; ++n) \
        acc[ai][bj][m][n] = __builtin_amdgcn_mfma_scale_f32_16x16x128_f8f6f4(Bt[n], At[m], acc[ai][bj][m][n], 0, 0, 0, Epi::SCALE_W, 0, Epi::SCALE_A); __builtin_amdgcn_s_setprio(0); } while (0)
#define PG8_LDA(dst, b, h) do { _Pragma("unroll") for (int m = 0; m < 4; ++m) _Pragma("unroll") for (int k = 0; k < 2; ++k) dst[m][k] = *(const LAS bf16x8*)(lds + PG8_SA(b, h) + aoff + m * 2048 + k * 1024); } while (0)
#define PG8_LDB(dst, b, h) do { _Pragma("unroll") for (int n = 0; n < 2; ++n) _Pragma("unroll") for (int k = 0; k < 2; ++k) dst[n][k] = *(const LAS bf16x8*)(lds + PG8_SB(b, h) + boff + n * 2048 + k * 1024); } while (0)
#define PG8_MMA(ai, bj, At, Bt) do { __builtin_amdgcn_s_setprio(1); _Pragma("unroll") for (int m = 0; m < 4; ++m) _Pragma("unroll") for (int n = 0; n < 2; ++n) _Pragma("unroll") for (int k = 0; k < 2; ++k) \
        acc[ai][bj][m][n] = __builtin_amdgcn_mfma_f32_16x16x32_bf16(Bt[n][k], At[m][k], acc[ai][bj][m][n], 0, 0, 0); __builtin_amdgcn_s_setprio(0); } while (0)
#define PG8_WAIT_V(n) asm volatile("s_waitcnt vmcnt(" #n ")" ::: "memory")
#define PG8_WAIT_L(n) asm volatile("s_waitcnt lgkmcnt(" #n ")" ::: "memory")
#define PG8_BAR __builtin_amdgcn_s_barrier()
#define PG8_SCHED __builtin_amdgcn_sched_barrier(0)
    Unit cur, nxt; int ui = 0;
    if (!S.next(0, cur)) return;
    f32x4 acc[2][2][4][2];
#pragma unroll
    for (int a = 0; a < 2; ++a)
#pragma unroll
        for (int b = 0; b < 2; ++b)
#pragma unroll
            for (int m = 0; m < 4; ++m)
#pragma unroll
                for (int n = 0; n < 2; ++n) acc[a][b][m][n] = (f32x4){0.f, 0.f, 0.f, 0.f};
    bf16x8 At[4][2], B0[2][2], B1[2][2];
    v8i32 At8[4], B08[2], B18[2];
    unsigned vc[2][2];
    S.a_voff(cur, tid, vc);
    const char* cB = S.b_base(cur);
    PG8_STAGE(PG8_SB(0, 0), cB, voffB); PG8_STAGE(PG8_SB(0, 1), cB + hstepB, voffB); PG8_STAGE(PG8_SA(0, 0), Abase, vc[0]); PG8_STAGE(PG8_SA(0, 1), Abase, vc[1]);
    if (wr == 1) PG8_BAR;
    PG8_WAIT_V(2); PG8_BAR;
    PG8_STAGE(PG8_SB(1, 0), cB + kstep, voffB); PG8_STAGE(PG8_SA(1, 0), Abase + kstep, vc[0]); PG8_STAGE(PG8_SB(1, 1), cB + hstepB + kstep, voffB);
    PG8_WAIT_V(6); PG8_BAR;
    for (;;) {
        const bool has_next = S.next(ui + 1, nxt);
        const char* nB = has_next ? S.b_base(nxt) : cB;
        if (has_next) { unsigned vn[2][2]; int tz = threadIdx.x; asm volatile("" : "+v"(tz)); S.a_voff(nxt, tz, vn); *(LAS u32x4*)(vslot + tz * 16) = (u32x4){vn[0][0], vn[0][1], vn[1][0], vn[1][1]}; }
#pragma unroll 1
        for (int t = 0; t < nt; t += 2) {
            const bool last = (t == nt - 2);
            const char* a1 = Abase + (size_t)(t + 1) * kstep;
            const char* a2 = last ? Abase : Abase + (size_t)(t + 2) * kstep; const char* b2 = last ? nB : cB + (size_t)(t + 2) * kstep;
            const char* a3 = a2 + kstep; const char* b3 = b2 + kstep;
            if constexpr (!FP8) {
            PG8_LDB(B0, 0, 0); PG8_LDB(B1, 0, 1); PG8_SCHED; PG8_LDA(At, 0, 0); PG8_STAGE(PG8_SA(1, 1), a1, vc[1]);
            if (last && has_next) { const u32x4 vnx = *(const LAS u32x4*)(vslot + tid * 16); vc[0][0] = vnx[0]; vc[0][1] = vnx[1]; vc[1][0] = vnx[2]; vc[1][1] = vnx[3]; }
            PG8_WAIT_V(8); PG8_WAIT_L(0); PG8_BAR; PG8_MMA(0, 0, At, B0); PG8_MMA(0, 1, At, B1); PG8_BAR; PG8_SCHED;
            PG8_LDA(At, 0, 1); PG8_STAGE(PG8_SB(0, 0), b2, voffB); PG8_STAGE(PG8_SB(0, 1), b2 + hstepB, voffB); PG8_STAGE(PG8_SA(0, 0), a2, vc[0]);
            PG8_WAIT_V(8); PG8_WAIT_L(0); PG8_BAR; PG8_MMA(1, 0, At, B0); PG8_MMA(1, 1, At, B1); PG8_BAR; PG8_SCHED;
            PG8_LDB(B0, 1, 0); PG8_LDB(B1, 1, 1); PG8_SCHED; PG8_LDA(At, 1, 0); PG8_STAGE(PG8_SA(0, 1), a2, vc[1]);
            PG8_WAIT_V(8); PG8_WAIT_L(0); PG8_BAR; PG8_MMA(0, 0, At, B0); PG8_MMA(0, 1, At, B1); PG8_BAR; PG8_SCHED;
            PG8_LDA(At, 1, 1); PG8_STAGE(PG8_SB(1, 0), b3, voffB); PG8_STAGE(PG8_SB(1, 1), b3 + hstepB, voffB); PG8_STAGE(PG8_SA(1, 0), a3, vc[0]);
            PG8_WAIT_V(8); PG8_WAIT_L(0); PG8_BAR; PG8_MMA(1, 0, At, B0); PG8_MMA(1, 1, At, B1); PG8_BAR; PG8_SCHED;
            } else {
            PG8_LDB8(B08, 0, 0); PG8_LDB8(B18, 0, 1); PG8_SCHED; PG8_LDA8(At8, 0, 0); PG8_STAGE(PG8_SA(1, 1), a1, vc[1]);
            if (last && has_next) { const u32x4 vnx = *(const LAS u32x4*)(vslot + tid * 16); vc[0][0] = vnx[0]; vc[0][1] = vnx[1]; vc[1][0] = vnx[2]; vc[1][1] = vnx[3]; }
            PG8_WAIT_V(8); PG8_WAIT_L(0); PG8_BAR; PG8_MMA8(0, 0, At8, B08); PG8_MMA8(0, 1, At8, B18); PG8_BAR; PG8_SCHED;
            PG8_LDA8(At8, 0, 1); PG8_STAGE(PG8_SB(0, 0), b2, voffB); PG8_STAGE(PG8_SB(0, 1), b2 + hstepB, voffB); PG8_STAGE(PG8_SA(0, 0), a2, vc[0]);
            PG8_WAIT_V(8); PG8_WAIT_L(0); PG8_BAR; PG8_MMA8(1, 0, At8, B08); PG8_MMA8(1, 1, At8, B18); PG8_BAR; PG8_SCHED;
            PG8_LDB8(B08, 1, 0); PG8_LDB8(B18, 1, 1); PG8_SCHED; PG8_LDA8(At8, 1, 0); PG8_STAGE(PG8_SA(0, 1), a2, vc[1]);
            PG8_WAIT_V(8); PG8_WAIT_L(0); PG8_BAR; PG8_MMA8(0, 0, At8, B08); PG8_MMA8(0, 1, At8, B18); PG8_BAR; PG8_SCHED;
            PG8_LDA8(At8, 1, 1); PG8_STAGE(PG8_SB(1, 0), b3, voffB); PG8_STAGE(PG8_SB(1, 1), b3 + hstepB, voffB); PG8_STAGE(PG8_SA(1, 0), a3, vc[0]);
            PG8_WAIT_V(8); PG8_WAIT_L(0); PG8_BAR; PG8_MMA8(1, 0, At8, B08); PG8_MMA8(1, 1, At8, B18); PG8_BAR; PG8_SCHED;
            }
        }
        if (wr == 0) PG8_BAR;
        { int tz = threadIdx.x; asm volatile("" : "+v"(tz)); const int ln = tz & 63; E(acc, cur, wr, wc, ln & 15, ln >> 4); }
        if (!has_next) break;
#pragma unroll
        for (int a = 0; a < 2; ++a)
#pragma unroll
            for (int b = 0; b < 2; ++b)
#pragma unroll
                for (int m = 0; m < 4; ++m)
#pragma unroll
                    for (int n = 0; n < 2; ++n) acc[a][b][m][n] = (f32x4){0.f, 0.f, 0.f, 0.f};
        cur = nxt; cB = nB; ++ui;
        if (wr == 1) PG8_BAR;
    }
    PG8_WAIT_V(0);
    PG8_BAR;
#undef PG8_SA
#undef PG8_SB
#undef PG8_STAGE
#undef PG8_LDA
#undef PG8_LDA8
#undef PG8_LDB8
#undef PG8_MMA8
#undef PG8_LDB
#undef PG8_MMA
#undef PG8_WAIT_V
#undef PG8_WAIT_L
#undef PG8_BAR
#undef PG8_SCHED
}
}
constexpr int NWAVES = 8, NTHR = 512;
constexpr int LDS_RING = 131072;
constexpr int LDS_TBL = LDS_RING;
constexpr int LDS_VOFF = LDS_TBL + 22528;
constexpr int LDS_MISC = LDS_VOFF + 8192;
constexpr int LDS_BYTES = 162304;

struct Params {
    const float* x; const int* pos; const float* w_in; const float* q_norm; const float* w_uq; const float* kv_norm; const float* w_ukv; const float* w_out;
    const float* ln1_g; const float* ln1_b; const float* router_w; const float* router_b; const float* w1; const float* w3; const float* w2;
    const float* sw1; const float* sw3; const float* sw2; const float* ln2_g; const float* ln2_b; const float* rel_bias;
    float* out; unsigned char* ws;
    int ph_lo, ph_hi;
};

struct Frame {
    LAS unsigned char* lds; volatile LAS unsigned* MISC; unsigned* ctl;
    int tid, lane, wave, G, vcu;
    unsigned char* ws;
};
#define FP(name, type, off) __device__ __forceinline__ type* name(const Frame& F) { return (type*)(F.ws + (off)); }
FP(fWin, unsigned char, WS_W + W_IN) FP(fWuq, bf16_t, WS_W + W_UQ) FP(fWukv, bf16_t, WS_W + W_UKV) FP(fWout, unsigned char, WS_W + W_OUT) FP(fWr, bf16_t, WS_W + W_R) FP(fW13, unsigned char, WS_W + W_13) FP(fW2, unsigned char, WS_W + W_2)
FP(fSH, bf16_t, WS_XF) FP(fXB, bf16_t, WS_XB) FP(fH, unsigned char, WS_H) FP(fLST, unsigned, WS_LST) FP(fPK, unsigned, WS_GATE) FP(fGS, float, WS_XF + 64 * MiB) FP(fXB8, unsigned char, WS_XF + 72 * MiB) FP(fROPE, float, WS_ROPE) FP(fDTAB, float, WS_DTAB)
FP(fU, bf16_t, WS_R + R_U) FP(fMQ, bf16_t, WS_R + R_MQ) FP(fMK, bf16_t, WS_R + R_MK) FP(fMV, bf16_t, WS_R + R_MV) FP(fKR, bf16_t, WS_R + R_KR) FP(fAO, unsigned char, WS_R + R_AO)
FP(fMASK, unsigned, WS_R + R_MASK) FP(fSCR, float, WS_R + R_SCR) FP(fLG, float, WS_R + R_LG) FP(fYB, unsigned char, WS_R)
__device__ __forceinline__ Frame phase_frame(const Frame& F0) { Frame F = F0; int tz = threadIdx.x; asm volatile("" : "+v"(tz)); F.tid = tz; F.lane = tz & 63; return F; }

constexpr float YB_SCALE = 64.0f;
constexpr float W13_SCALE = 128.0f, X8_SCALE = 32.0f, W2_SCALE = 256.0f, H8_SCALE = 16.0f;
constexpr float AO_SCALE = 16.0f, WOUT_SCALE = 256.0f, WIN_SCALE = 128.0f;
constexpr int E8_W = 0x79797979  , E8_X = 0x79797979, E8_H = 0x79797979;
__device__ __forceinline__ unsigned pk_fp8x4(float a, float b, float c, float d) {
    a = __builtin_amdgcn_fmed3f(a, -448.f, 448.f); b = __builtin_amdgcn_fmed3f(b, -448.f, 448.f); c = __builtin_amdgcn_fmed3f(c, -448.f, 448.f); d = __builtin_amdgcn_fmed3f(d, -448.f, 448.f);
    int p = __builtin_amdgcn_cvt_pk_fp8_f32(a, b, 0, false); p = __builtin_amdgcn_cvt_pk_fp8_f32(c, d, p, true); return (unsigned)p; }
struct MapIn  { __device__ int row(int n) const { return n < 2504 ? n : n + 56; }   __device__ float sc(int k, int n) const { return (n < 384 || (n >= 1152 && n < 1408)) ? QSCALE * WIN_SCALE : WIN_SCALE; } };
struct MapUq  { const float* g; __device__ int row(int n) const { return n; }         __device__ float sc(int k, int n) const { return g[k] * MLA_QSCALE; } };
struct MapUkv { const float* g; __device__ int row(int n) const { const int h = n >> 7, c = n & 127; return c < 64 ? h * 64 + c : 384 + h * 64 + (c - 64); } __device__ float sc(int k, int n) const { return g[k]; } };
struct MapId  { __device__ int row(int n) const { return n; }                         __device__ float sc(int k, int n) const { return 1.0f; } };
struct MapW13 { int add; __device__ int row(int f) const { return 32 * (f >> 4) + (f & 15) + add; } __device__ float sc(int k, int n) const { return W13_SCALE; } };
struct MapWo  { __device__ int row(int n) const { return n; }                         __device__ float sc(int k, int n) const { return WOUT_SCALE; } };
struct MapW2  { __device__ int row(int n) const { return n; }                         __device__ float sc(int k, int n) const { return W2_SCALE; } };

template <class MAP>
__device__ __forceinline__ void tr_item(const float* W, int N, int kb, int nb, bf16_t* WT, int ldk, const MAP map, LAS float* scr, int lane) {
    const int k0 = 64 * kb, n0 = 32 * nb;
    const int nq = n0 + 4 * (lane & 7); const bool ok = nq < N;
    f32x4 w4[8];
#pragma unroll
    for (int i = 0; i < 8; ++i) { const int kk = 8 * i + (lane >> 3); w4[i] = ok ? __builtin_nontemporal_load((const f32x4*)(W + (size_t)(k0 + kk) * N + nq)) : (f32x4){0.f, 0.f, 0.f, 0.f}; }
#pragma unroll
    for (int i = 0; i < 8; ++i) { const int kk = 8 * i + (lane >> 3);
#pragma unroll
        for (int j = 0; j < 4; ++j) scr[kk * 33 + 4 * (lane & 7) + j] = w4[i][j] * map.sc(k0 + kk, nq + j); }
    LDS_WAIT(); asm volatile("" ::: "memory");
    const int c = lane & 7;
#pragma unroll
    for (int j = 0; j < 4; ++j) { const int n = (lane >> 3) + 8 * j; const LAS float* s = scr + (8 * c) * 33 + n;
        u32x4 o; o.x = cvt_pk(s[0 * 33], s[1 * 33]); o.y = cvt_pk(s[2 * 33], s[3 * 33]); o.z = cvt_pk(s[4 * 33], s[5 * 33]); o.w = cvt_pk(s[6 * 33], s[7 * 33]);
        if (n0 + n < N) *(u32x4*)(WT + (size_t)map.row(n0 + n) * ldk + k0 + 8 * c) = o; }
    LDS_WAIT(); asm volatile("" ::: "memory");
}

template <class MAP>
__device__ __forceinline__ void tr_item8(const float* W, int N, int kb, int nb, unsigned char* WT, int ldk, const MAP map, LAS float* scr, int lane) {
    const int k0 = 64 * kb, n0 = 32 * nb;
    const int nq = n0 + 4 * (lane & 7);
    f32x4 w4[8];
#pragma unroll
    for (int i = 0; i < 8; ++i) { const int kk = 8 * i + (lane >> 3); w4[i] = nq < N ? __builtin_nontemporal_load((const f32x4*)(W + (size_t)(k0 + kk) * N + nq)) : (f32x4){0.f, 0.f, 0.f, 0.f}; }
#pragma unroll
    for (int i = 0; i < 8; ++i) { const int kk = 8 * i + (lane >> 3);
#pragma unroll
        for (int j = 0; j < 4; ++j) scr[kk * 33 + 4 * (lane & 7) + j] = w4[i][j] * map.sc(k0 + kk, nq + j); }
    LDS_WAIT(); asm volatile("" ::: "memory");
    const int n = lane >> 1, hf = lane & 1; const LAS float* sp = scr + (32 * hf) * 33 + n;
    unsigned o[8];
#pragma unroll
    for (int q = 0; q < 8; ++q) o[q] = pk_fp8x4(sp[(4 * q) * 33], sp[(4 * q + 1) * 33], sp[(4 * q + 2) * 33], sp[(4 * q + 3) * 33]);
    unsigned char* dst = WT + (size_t)map.row(n0 + n) * ldk + k0 + 32 * hf;
    if (n0 + n < N) { *(u32x4*)dst = (u32x4){o[0], o[1], o[2], o[3]}; *(u32x4*)(dst + 16) = (u32x4){o[4], o[5], o[6], o[7]}; }
    LDS_WAIT(); asm volatile("" ::: "memory");
}

__device__ __forceinline__ void zero_rows(bf16_t* base, int row0, int nrows, int ldk, int k0, int kn, int gt, int ngt) {
    const int per = kn / 8; const int total = nrows * per;
    for (int i = gt; i < total; i += ngt) { const int r = i / per, c = i % per; *(u32x4*)(base + (size_t)(row0 + r) * ldk + k0 + 8 * c) = (u32x4){0u, 0u, 0u, 0u}; }
}

__device__ __forceinline__ void convert_small(const Frame& F, const Params& p, int l) {
    LAS float* scr = (LAS float*)(F.lds + F.wave * 16384);
    const int gw = F.vcu * NWAVES + F.wave, NGW = F.G * NWAVES;
    constexpr int I_IN = 16 * 92, I_UQ = 4 * 18, I_UKV = 2 * 24, I_OUT = 16 * 32, I_R = 16 * 2;
    constexpr int NIT = I_IN + I_UQ + I_UKV + I_OUT + I_R;
    const float* w_in = p.w_in + (size_t)l * 1024 * IN_W;
    const float* w_uq = p.w_uq + (size_t)l * 256 * 576; const float* w_ukv = p.w_ukv + (size_t)l * 128 * 768;
    const float* w_out = p.w_out + (size_t)l * 1024 * 1024; const float* rw = p.router_w + (size_t)l * 1024 * 64;
    for (int it = gw; it < NIT; it += NGW) {
        int r = it;
        if (r < I_IN) { tr_item8(w_in, IN_W, r / 92, r % 92, fWin(F), 1024, MapIn{}, scr, F.lane); continue; } r -= I_IN;
        if (r < I_UQ) { tr_item(w_uq, 576, r / 18, r % 18, fWuq(F), 256, MapUq{p.q_norm + l * 256}, scr, F.lane); continue; } r -= I_UQ;
        if (r < I_UKV) { tr_item(w_ukv, 768, r / 24, r % 24, fWukv(F), 256, MapUkv{p.kv_norm + l * 128}, scr, F.lane); continue; } r -= I_UKV;
        if (r < I_OUT) { tr_item8(w_out, 1024, r / 32, r % 32, fWout(F), 1024, MapWo{}, scr, F.lane); continue; } r -= I_OUT;
        tr_item(rw, 64, r / 2, r % 2, fWr(F), 1024, MapId{}, scr, F.lane);
    }
    const int gt = F.vcu * NTHR + F.tid, ngt = F.G * NTHR;
    zero_rows((bf16_t*)fWin(F), 2504, 56, 512, 0, 512, gt, ngt); zero_rows((bf16_t*)fWin(F), 2976, 96, 512, 0, 512, gt, ngt);
    zero_rows(fWuq(F), 576, 192, 256, 0, 256, gt, ngt);
    zero_rows(fWukv(F), 0, 768, 256, 128, 128, gt, ngt);
    zero_rows(fWr(F), 64, 192, 1024, 0, 1024, gt, ngt);
}
__device__ __forceinline__ void convert_experts(const Frame& F, const Params& p, int l, int k0, int k1, int scr_off) {
    LAS float* scr = (LAS float*)(F.lds + scr_off + F.wave * 8448);
    const int gw = F.vcu * NWAVES + F.wave, NGW = F.G * NWAVES;
    constexpr int I_E1 = 16 * 8, I_E2 = 4 * 32, I_EXP = 2 * I_E1 + I_E2, NIT = 65 * I_EXP;
    for (int k = k0; k < k1; ++k) { const int it = gw + k * NGW; if (it >= NIT) break;
        const int e = it / I_EXP; int r = it - e * I_EXP;
        const float *s1, *s3, *s2;
        if (e < 64) { s1 = p.w1 + ((size_t)l * 64 + e) * 1024 * 256; s3 = p.w3 + ((size_t)l * 64 + e) * 1024 * 256; s2 = p.w2 + ((size_t)l * 64 + e) * 256 * 1024; }
        else { s1 = p.sw1 + (size_t)l * 1024 * 256; s3 = p.sw3 + (size_t)l * 1024 * 256; s2 = p.sw2 + (size_t)l * 256 * 1024; }
        unsigned char* d13 = fW13(F) + (size_t)e * 512 * 1024; unsigned char* d2 = fW2(F) + (size_t)e * 1024 * 256;
        if (r < I_E1) { tr_item8(s1, 256, r / 8, r % 8, d13, 1024, MapW13{0}, scr, F.lane); continue; } r -= I_E1;
        if (r < I_E1) { tr_item8(s3, 256, r / 8, r % 8, d13, 1024, MapW13{16}, scr, F.lane); continue; } r -= I_E1;
        tr_item8(s2, 1024, r / 32, r % 32, d2, 256, MapW2{}, scr, F.lane);
    }
}

typedef f32x4 Acc[2][2][4][2];
#define EPI_ROWS(ai, m) for (int ai = 0; ai < 2; ++ai) for (int m = 0; m < 4; ++m)

struct EpiU {
    static constexpr int PERM = 2; static constexpr int SCALE_W = E8_W, SCALE_A = E8_X; bf16_t* U;
    __device__ __forceinline__ void operator()(const Acc& acc, const pg8::Unit& u, int wr, int wc, int fr, int fq) const {
#pragma unroll
        EPI_ROWS(ai, m) { bf16_t* rowp = U + (size_t)(u.pm * 256 + ai * 128 + wr * 64 + m * 16 + fr) * LDU + u.pn * 256 + wc * 64 + 8 * fq;
#pragma unroll
            for (int bj = 0; bj < 2; ++bj) { const f32x4 a = acc[ai][bj][m][0], b = acc[ai][bj][m][1];
                *(u32x4*)(rowp + bj * 32) = (u32x4){cvt_pk(a[0], a[1]), cvt_pk(a[2], a[3]), cvt_pk(b[0], b[1]), cvt_pk(b[2], b[3])}; } }
    }
};
struct EpiQup {
    static constexpr int PERM = 0; bf16_t* MQ; const LAS float* tbl; const float* rope;
    __device__ __forceinline__ void operator()(const Acc& acc, const pg8::Unit& u, int wr, int wc, int fr, int fq) const {
#pragma unroll
        EPI_ROWS(ai, m) { const int rl = ai * 128 + wr * 64 + m * 16 + fr, row = u.pm * 256 + rl; const float rs = tbl[u.seq * 256 + rl];
#pragma unroll
            for (int bj = 0; bj < 2; ++bj) { const int c0 = u.pn * 256 + bj * 128 + wc * 32; f32x4 a = acc[ai][bj][m][0] * rs, b = acc[ai][bj][m][1] * rs;
                if (((c0 >> 5) % 3) == 2) {
                    const f32x4 cs = *(const f32x4*)(rope + (size_t)row * 32 + 4 * fq), sn = *(const f32x4*)(rope + (size_t)row * 32 + 16 + 4 * fq);
                    const f32x4 x1 = a, x2 = b; a = x1 * cs - x2 * sn; b = x2 * cs + x1 * sn; }
                if (c0 < 576) { bf16_t* o = MQ + (size_t)row * 576 + c0 + 4 * fq; *(u32x2*)o = (u32x2){cvt_pk(a[0], a[1]), cvt_pk(a[2], a[3])}; *(u32x2*)(o + 16) = (u32x2){cvt_pk(b[0], b[1]), cvt_pk(b[2], b[3])}; } }
            asm volatile("" ::: "memory"); }
    }
};
struct EpiKVup {
    static constexpr int PERM = 1; bf16_t* MK; bf16_t* MV; const LAS float* tbl;
    __device__ __forceinline__ void operator()(const Acc& acc, const pg8::Unit& u, int wr, int wc, int fr, int fq) const {
#pragma unroll
        EPI_ROWS(ai, m) { const int rl = ai * 128 + wr * 64 + m * 16 + fr, row = u.pm * 256 + rl; const float rs = tbl[u.seq * 256 + rl];
#pragma unroll
            for (int bj = 0; bj < 2; ++bj) { const int c = u.pn * 256 + bj * 128 + wc * 32 + 8 * fq; const f32x4 a = acc[ai][bj][m][0] * rs, b = acc[ai][bj][m][1] * rs;
                bf16_t* o = c < 384 ? MK + (size_t)row * 384 + c : MV + (size_t)row * 384 + (c - 384);
                *(u32x4*)o = (u32x4){cvt_pk(a[0], a[1]), cvt_pk(a[2], a[3]), cvt_pk(b[0], b[1]), cvt_pk(b[2], b[3])}; } }
    }
};
struct EpiResB {
    static constexpr int PERM = 2; static constexpr int SCALE_W = E8_W, SCALE_A = E8_X; bf16_t* X;
    __device__ __forceinline__ void operator()(const Acc& acc, const pg8::Unit& u, int wr, int wc, int fr, int fq) const {
        u32x4 r[2][4][2];
#pragma unroll
        EPI_ROWS(ai, m) { const bf16_t* rowp = X + (size_t)(u.pm * 256 + ai * 128 + wr * 64 + m * 16 + fr) * 1024 + u.pn * 256 + wc * 64 + 8 * fq;
            r[ai][m][0] = *(const u32x4*)rowp; r[ai][m][1] = *(const u32x4*)(rowp + 32); }
#pragma unroll
        EPI_ROWS(ai, m) { bf16_t* rowp = X + (size_t)(u.pm * 256 + ai * 128 + wr * 64 + m * 16 + fr) * 1024 + u.pn * 256 + wc * 64 + 8 * fq;
#pragma unroll
            for (int bj = 0; bj < 2; ++bj) { const f32x4 a = acc[ai][bj][m][0], b = acc[ai][bj][m][1]; const u32x4 q = r[ai][m][bj];
                *(u32x4*)(rowp + bj * 32) = (u32x4){cvt_pk(DN_ALPHA * bf2f(q[0] & 0xffffu) + a[0], DN_ALPHA * bf2f(q[0] >> 16) + a[1]), cvt_pk(DN_ALPHA * bf2f(q[1] & 0xffffu) + a[2], DN_ALPHA * bf2f(q[1] >> 16) + a[3]),
                                                       cvt_pk(DN_ALPHA * bf2f(q[2] & 0xffffu) + b[0], DN_ALPHA * bf2f(q[2] >> 16) + b[1]), cvt_pk(DN_ALPHA * bf2f(q[3] & 0xffffu) + b[2], DN_ALPHA * bf2f(q[3] >> 16) + b[3])}; } }
    }
};
struct EpiSH {
    static constexpr int PERM = 2; static constexpr int SCALE_W = E8_W, SCALE_A = E8_H; bf16_t* SH;
    __device__ __forceinline__ void operator()(const Acc& acc, const pg8::Unit& u, int wr, int wc, int fr, int fq) const {
#pragma unroll
        EPI_ROWS(ai, m) { bf16_t* rowp = SH + (size_t)(u.pm * 256 + ai * 128 + wr * 64 + m * 16 + fr) * 1024 + u.pn * 256 + wc * 64 + 8 * fq;
#pragma unroll
            for (int bj = 0; bj < 2; ++bj) { const f32x4 a = acc[ai][bj][m][0], b = acc[ai][bj][m][1];
                *(u32x4*)(rowp + bj * 32) = (u32x4){cvt_pk(a[0], a[1]), cvt_pk(a[2], a[3]), cvt_pk(b[0], b[1]), cvt_pk(b[2], b[3])}; } }
    }
};
struct EpiLogit {
    static constexpr int PERM = 0; float* LG;
    __device__ __forceinline__ void operator()(const Acc& acc, const pg8::Unit& u, int wr, int wc, int fr, int fq) const {
        if (wc >= 2) return;
#pragma unroll
        EPI_ROWS(ai, m) { float* o = LG + ((size_t)u.pn * T + (u.pm * 256 + ai * 128 + wr * 64 + m * 16 + fr)) * 64 + wc * 32 + 4 * fq;
            *(f32x4*)o = acc[ai][0][m][0]; *(f32x4*)(o + 16) = acc[ai][0][m][1]; }
    }
};
__device__ __forceinline__ float silu_f(float v) { return v / (1.0f + __expf(-v)); }
struct EpiG1 {
    static constexpr int PERM = 0; static constexpr int SCALE_W = E8_W, SCALE_A = E8_X;
    unsigned char* H; const float* GS; const LAS int* cnt; int shared_base; const LAS int* cb;
    __device__ __forceinline__ void operator()(const Acc& acc, const pg8::Unit& u, int wr, int wc, int fr, int fq) const {
        float g[2][4]; const int n = GS ? cnt[u.e] : 0x7fffffff;
#pragma unroll
        EPI_ROWS(ai, m) { const int idx = u.pm * 256 + ai * 128 + wr * 64 + m * 16 + fr; g[ai][m] = GS ? (idx < n ? GS[(size_t)u.e * T + idx] * H8_SCALE : 0.f) : H8_SCALE; }
#pragma unroll
        EPI_ROWS(ai, m) { const int idx = u.pm * 256 + ai * 128 + wr * 64 + m * 16 + fr; const float gg = g[ai][m];
            const f32x4 a0 = acc[ai][0][m][0], b0 = acc[ai][0][m][1] * gg, a1 = acc[ai][1][m][0], b1 = acc[ai][1][m][1] * gg;
            const auto pr = __builtin_amdgcn_permlane16_swap(pk_fp8x4(silu_f(a0[0]) * b0[0], silu_f(a0[1]) * b0[1], silu_f(a0[2]) * b0[2], silu_f(a0[3]) * b0[3]),
                                                             pk_fp8x4(silu_f(a1[0]) * b1[0], silu_f(a1[1]) * b1[1], silu_f(a1[2]) * b1[2], silu_f(a1[3]) * b1[3]), false, false);
            if (idx >= n) continue;
            const size_t hr = GS ? (size_t)(cb[u.e] + idx) : (size_t)(shared_base + idx);
            unsigned char* o = H + hr * 256 + u.pn * 128 + wc * 16 + 4 * (fq & ~1) + (fq & 1) * 64;
            *(u32x2*)o = (u32x2){pr[0], pr[1]}; }
    }
};
struct EpiG2 {
    static constexpr int PERM = 1; static constexpr int SCALE_W = E8_W, SCALE_A = E8_H; unsigned char* YB; const LAS int* cnt; const LAS int* cb;
    __device__ __forceinline__ void operator()(const Acc& acc, const pg8::Unit& u, int wr, int wc, int fr, int fq) const {
        const int n = cnt[u.e];
#pragma unroll
        EPI_ROWS(ai, m) { const int idx = u.pm * 256 + ai * 128 + wr * 64 + m * 16 + fr;
            const f32x4 a0 = acc[ai][0][m][0] * YB_SCALE, b0 = acc[ai][0][m][1] * YB_SCALE, a1 = acc[ai][1][m][0] * YB_SCALE, b1 = acc[ai][1][m][1] * YB_SCALE;
            const auto lo = __builtin_amdgcn_permlane16_swap(pk_fp8x4(a0[0], a0[1], a0[2], a0[3]), pk_fp8x4(a1[0], a1[1], a1[2], a1[3]), false, false);
            const auto hi = __builtin_amdgcn_permlane16_swap(pk_fp8x4(b0[0], b0[1], b0[2], b0[3]), pk_fp8x4(b1[0], b1[1], b1[2], b1[3]), false, false);
            if (idx >= n) continue;
            unsigned char* o = YB + (size_t)(cb[u.e] + idx) * 1024 + u.pn * 256 + wc * 32 + 8 * (fq & ~1) + (fq & 1) * 128;
            *(u32x4*)o = (u32x4){lo[0], hi[0], lo[1], hi[1]}; }
    }
};

struct MoeOrder {
    const LAS int* cnt; const LAS int* ubase;
    int npn, total, G, c; const unsigned* LST; int shift  ; unsigned lda; const LAS int* cb; const char* Bt; size_t bexp  ; unsigned ldb;
    __device__ __forceinline__ bool next(int i, pg8::Unit& u) const {
        const long L = (long)i * G + c; if (L >= total) return false;
        const int w = pg8::xcd_remap((int)L, total);
        int lo = 0, hi = 64;
        while (hi - lo > 1) { const int mid = (lo + hi) >> 1; if (ubase[mid] <= w) lo = mid; else hi = mid; }
        const int loc = w - ubase[lo]; u.e = lo; u.pn = loc % npn; u.pm = loc / npn; u.seq = i; return true;
    }
    __device__ __forceinline__ void a_voff(const pg8::Unit& u, int tid, unsigned (&v)[2][2]) const {
        const int n = cnt[u.e];
#pragma unroll
        for (int i = 0; i < 2; ++i) { int R, C; pg8::stage_rc(tid * 16 + i * 8192, R, C);
#pragma unroll
            for (int h = 0; h < 2; ++h) { int idx = u.pm * 256 + h * 128 + R; idx = idx < n ? idx : 0;
                if (shift < 0) { v[h][i] = ((unsigned)(cb[u.e] + idx) * lda + (unsigned)C) * 2u; }
                else { const unsigned ent = LST[(size_t)u.e * T + idx];
                    v[h][i] = ((ent >> shift) * lda + (unsigned)C) * 2u; } } }
    }
    __device__ __forceinline__ const char* b_base(const pg8::Unit& u) const { return Bt + (size_t)u.e * bexp + (size_t)u.pn * 256 * ldb * 2; }
};
struct RouterOrder {
    int G, c; const char* Bt;
    __device__ __forceinline__ bool next(int i, pg8::Unit& u) const { const long L = (long)i * G + c; if (L >= 256) return false; u.pm = (int)L >> 1; u.pn = (int)L & 1; u.e = 0; u.seq = i; return true; }
    __device__ __forceinline__ void a_voff(const pg8::Unit& u, int tid, unsigned (&v)[2][2]) const {
#pragma unroll
        for (int i = 0; i < 2; ++i) { int R, C; pg8::stage_rc(tid * 16 + i * 8192, R, C);
#pragma unroll
            for (int h = 0; h < 2; ++h) v[h][i] = ((unsigned)(u.pm * 256 + h * 128 + R) * 1024u + (unsigned)(u.pn * 512 + C)) * 2u; }
    }
    __device__ __forceinline__ const char* b_base(const pg8::Unit& u) const { return Bt + (size_t)u.pn * 512 * 2; }
};

__device__ __forceinline__ void phase_x_to_xb(const Frame& F, const float* x) {
    const size_t n8 = (size_t)T * 1024 / 8;
    for (size_t i = (size_t)F.vcu * NTHR + F.tid; i < n8; i += (size_t)F.G * NTHR) {
        const f32x4 a = __builtin_nontemporal_load((const f32x4*)(x + i * 8)), b = __builtin_nontemporal_load((const f32x4*)(x + i * 8 + 4));
        *(u32x4*)(fXB(F) + i * 8) = (u32x4){cvt_pk(a[0], a[1]), cvt_pk(a[2], a[3]), cvt_pk(b[0], b[1]), cvt_pk(b[2], b[3])};
        *(u32x2*)(fXB8(F) + i * 8) = (u32x2){pk_fp8x4(a[0] * X8_SCALE, a[1] * X8_SCALE, a[2] * X8_SCALE, a[3] * X8_SCALE), pk_fp8x4(b[0] * X8_SCALE, b[1] * X8_SCALE, b[2] * X8_SCALE, b[3] * X8_SCALE)};
    }
}

__device__ __forceinline__ void phase_rope_table(const Frame& F, const int* pos) {
    for (int i = F.vcu * NTHR + F.tid; i < T * 16; i += F.G * NTHR) { const int t = i >> 4, j = i & 15;
        const double inv = exp2(-(double)j * (13.287712379549449 / 16.0));
        const double rev = (double)pos[t] * inv * 0.15915494309189535; const float fr = (float)(rev - floor(rev));
        fROPE(F)[(size_t)t * 32 + j] = __builtin_amdgcn_cosf(fr); fROPE(F)[(size_t)t * 32 + 16 + j] = __builtin_amdgcn_sinf(fr); }
}

__device__ __forceinline__ void phase_inproj(const Frame& F) {
    pg8::DenseOrder S; S.init(T, LDU, F.G, (int)blockIdx.x, 512, 0, fWin(F), 512);
    EpiU E{fU(F)};
    pg8::gemm_phase<EpiU, pg8::DenseOrder, true>(F.lds, F.lds + LDS_VOFF, (const char*)fXB8(F), 512, 512, S, E);
}

template <int WIDTH>
__device__ __forceinline__ void rms_tables(const Frame& F, const pg8::DenseOrder& S, LAS float* tbl, int col0) {
    pg8::Unit u;
    for (int i = 0; i < 4 && S.next(i, u); ++i) {
        const int r = F.tid >> 1, hf = F.tid & 1; const bf16_t* xr = fU(F) + (size_t)(u.pm * 256 + r) * LDU + col0 + hf * (WIDTH / 2);
        u32x4 v[WIDTH / 16];
#pragma unroll
        for (int c = 0; c < WIDTH / 16; ++c) v[c] = *(const u32x4*)(xr + 8 * c);
        float ss = 0.f;
#pragma unroll
        for (int c = 0; c < WIDTH / 16; ++c)
#pragma unroll
            for (int j = 0; j < 4; ++j) { const float lo = bf2f(v[c][j] & 0xffffu), hi = bf2f(v[c][j] >> 16); ss += lo * lo + hi * hi; }
        ss += __shfl_xor(ss, 1);
        if (hf == 0) tbl[i * 256 + r] = 1.0f / sqrtf(ss / (float)WIDTH + RMS_EPS);
    }
}

__device__ __forceinline__ void phase_mla_up(const Frame& F, const Params& p) {
    LAS float* tq = (LAS float*)(F.lds + LDS_TBL); LAS float* tkv = tq + 1024;
    pg8::DenseOrder Sq; Sq.init(T, 768, F.G, (int)blockIdx.x, LDU, U_CQ, fWuq(F), 256);
    pg8::DenseOrder Sk; Sk.init(T, 768, F.G, (int)blockIdx.x, LDU, U_CKV, fWukv(F), 256);
    rms_tables<256>(F, Sq, tq, U_CQ); rms_tables<128>(F, Sk, tkv, U_CKV);
    __syncthreads();
    { EpiQup E{fMQ(F), tq, fROPE(F)}; pg8::gemm_phase<EpiQup, pg8::DenseOrder>(F.lds, F.lds + LDS_VOFF, (const char*)fU(F), 256, 256, Sq, E); }
    { EpiKVup E{fMK(F), fMV(F), tkv}; pg8::gemm_phase<EpiKVup, pg8::DenseOrder>(F.lds, F.lds + LDS_VOFF, (const char*)fU(F), 256, 256, Sk, E); }
    for (int i = F.vcu * NTHR + F.tid; i < T * 16; i += F.G * NTHR) { const int t = i >> 4, j = i & 15;
        const float x1 = bf2f(fU(F)[(size_t)t * LDU + U_KR + j]), x2 = bf2f(fU(F)[(size_t)t * LDU + U_KR + 16 + j]);
        const float cs = fROPE(F)[(size_t)t * 32 + j], sn = fROPE(F)[(size_t)t * 32 + 16 + j];
        fKR(F)[(size_t)t * 32 + j] = (bf16_t)f2bf(x1 * cs - x2 * sn); fKR(F)[(size_t)t * 32 + 16 + j] = (bf16_t)f2bf(x2 * cs + x1 * sn); }
}

__device__ __forceinline__ void phase_outproj(const Frame& F) {
    pg8::DenseOrder S; S.init(T, 1024, F.G, (int)blockIdx.x, 512, 0, fWout(F), 512);
    EpiResB E{fXB(F)};
    pg8::gemm_phase<EpiResB, pg8::DenseOrder, true>(F.lds, F.lds + LDS_VOFF, (const char*)fAO(F), 512, 512, S, E);
}

__device__ __forceinline__ void phase_router_sharedg1(const Frame& F) {
    { RouterOrder S{F.G, (int)blockIdx.x, (const char*)fWr(F)}; EpiLogit E{fLG(F)}; pg8::gemm_phase<EpiLogit, RouterOrder>(F.lds, F.lds + LDS_VOFF, (const char*)fXB(F), 512, 1024, S, E); }
    { pg8::DenseOrder S; S.init(T, 512, F.G, (int)blockIdx.x, 512, 0, fW13(F) + (size_t)64 * 512 * 1024, 512);
      EpiG1 E{fH(F), nullptr, nullptr, T * 8, nullptr}; pg8::gemm_phase<EpiG1, pg8::DenseOrder, true>(F.lds, F.lds + LDS_VOFF, (const char*)fXB8(F), 512, 512, S, E); }
}

__device__ __forceinline__ void phase_shared_g2(const Frame& F) {
    pg8::DenseOrder S; S.init(T, 1024, F.G, (int)blockIdx.x, 128, 0, fW2(F) + (size_t)64 * 1024 * 256, 128);
    EpiSH E{fSH(F)};
    pg8::gemm_phase<EpiSH, pg8::DenseOrder, true>(F.lds, F.lds + LDS_VOFF, (const char*)(fH(F) + (size_t)T * 8 * 256), 128, 128, S, E);
}

__device__ __forceinline__ void moe_tables(const Frame& F, int l, int npn, LAS int*& cnt, LAS int*& ubase) {
    cnt = (LAS int*)(F.lds + LDS_TBL); ubase = cnt + 64;
    __syncthreads();
    if (F.tid < 64) cnt[F.tid] = (int)F.ctl[CW_CNT + l * 64 + F.tid];
    __syncthreads();
    if (F.tid == 0) { int s = 0, c = 0; for (int e = 0; e < 64; ++e) { ubase[e] = s; s += ((cnt[e] + 255) >> 8) * npn; ubase[65 + e] = c; c += cnt[e]; } ubase[64] = s; }
    __syncthreads();
}
__device__ __forceinline__ void phase_moe_g1(const Frame& F, int l) {
    LAS int *cnt, *ubase; moe_tables(F, l, 2, cnt, ubase);
    MoeOrder S{cnt, ubase, 2, ubase[64], F.G, (int)blockIdx.x, fLST(F), 0, 512u, ubase + 65, (const char*)fW13(F), (size_t)512 * 1024, 512u};
    EpiG1 E{fH(F), fGS(F), cnt, 0, ubase + 65};
    pg8::gemm_phase<EpiG1, MoeOrder, true>(F.lds, F.lds + LDS_VOFF, (const char*)fXB8(F), 512, 512, S, E);
}
__device__ __forceinline__ void phase_moe_g2(const Frame& F, int l) {
    LAS int *cnt, *ubase; moe_tables(F, l, 4, cnt, ubase);
    MoeOrder S{cnt, ubase, 4, ubase[64], F.G, (int)blockIdx.x, fLST(F), -1, 128u, ubase + 65, (const char*)fW2(F), (size_t)1024 * 256, 128u};
    EpiG2 E{fYB(F), cnt, ubase + 65};
    pg8::gemm_phase<EpiG2, MoeOrder, true>(F.lds, F.lds + LDS_VOFF, (const char*)fH(F), 128, 128, S, E);
}
constexpr int AT_K0 = 0, AT_KSZ = 12288, AT_V0 = 2 * AT_KSZ, AT_VSZ = 8192, AT_TBL = AT_V0 + 2 * AT_VSZ;

__device__ __forceinline__ float t5_dist_bias(const float* rel_bias, int head10, int d) {
    int bk;
    if (d < 16) bk = d;
    else { const float v = logf((float)d / 16.0f) / 4.852030263919617f * 16.0f; bk = 16 + (int)v; bk = bk < 31 ? bk : 31; }
    return rel_bias[bk * 10 + head10];
}

__device__ __forceinline__ void phase_dist_tables(const Frame& F, const float* rel_bias) {
    for (int i = F.vcu * NTHR + F.tid; i < 10 * 2112; i += F.G * NTHR) { const int h = i / 2112, e = i % 2112, d = e - 64; float v;
        if (h < 6) { const int mlt = (d <= 128 ? 1 : 0) + (((d & 3) == 0 && d <= 512) ? 1 : 0) + (((d & 15) == 0) ? 1 : 0);
            v = (d >= 0 && mlt) ? (t5_dist_bias(rel_bias, h, d) + logf((float)mlt)) * LOG2E : -INFINITY; }
        else v = d >= 0 ? t5_dist_bias(rel_bias, h, d) * LOG2E : 0.f;
        fDTAB(F)[i] = v; }
}

template <int MODE, int KS>
__device__ __forceinline__ void attn_unit(const Frame& F, const int b, const int qb,
                                          const bf16_t* __restrict__ Qp, const int ldq, const bf16_t* __restrict__ Kp, const int ldk, const bf16_t* __restrict__ KRp,
                                          const bf16_t* __restrict__ Vp, const int ldv, unsigned char* __restrict__ Op, const unsigned* __restrict__ maskp, const float* dtab, const int head10) {
    LAS unsigned char* lds = F.lds;
    const int tid = F.tid, lane = F.lane, w = F.wave, q32 = lane & 31, hh = lane >> 5;
    const size_t tb = (size_t)b * SEQ;
    const int qw0 = qb * 256 + 32 * w, qpos = qw0 + q32;
    const int ntile = 4 * (qb + 1);
    __syncthreads();
    if (MODE != 0) {
        LAS float* tblw = (LAS float*)(lds + AT_TBL); const float* src = dtab + head10 * 2112;
        for (int i = tid; i < SEQ + 64; i += NTHR) tblw[i] = src[i];
    }
    bf16x8 qf[KS];
    { const bf16_t* qr = Qp + (tb + qpos) * (size_t)ldq + 8 * hh;
#pragma unroll
      for (int ks = 0; ks < KS; ++ks) { if (MODE == 0 && ks >= 4) qf[ks] = *(const bf16x8*)(qr + 16 * ks); else qf[ks] = *(const bf16x8*)(qr + 16 * ks); } }
    const int skey = tid >> 3, sch = tid & 7;
    const bf16_t* kg = Kp + (tb + skey) * (size_t)ldk + 8 * sch;
    const bf16_t* vg = Vp + (tb + skey) * (size_t)ldv + 8 * sch;
    const bf16_t* rg = (MODE == 0) ? KRp + (tb + (tid >> 2)) * 32 + 8 * (tid & 3) : nullptr;
    const int kdst = sch * 1024 + ((skey ^ sch) << 4);
    const int rdst = (8 + (tid & 3)) * 1024 + ((((tid >> 2) & 63) ^ (tid & 3)) << 4);
    const int vdst = (sch >> 2) * 4096 + skey * 64 + (sch & 3) * 16;
    const unsigned* mg = (MODE == 1) ? maskp + (tb + qpos) * 64 : nullptr;
    u32x4 kreg, vreg, rreg; u32x2 mw = {0u, 0u}, mwn = {0u, 0u};
    kreg = *(const u32x4*)kg; vreg = *(const u32x4*)vg; if (MODE == 0 && tid < 256) rreg = *(const u32x4*)rg;
    if (MODE == 1) mw = *(const u32x2*)mg;
    *(LAS u32x4*)(lds + AT_K0 + kdst) = kreg; *(LAS u32x4*)(lds + AT_V0 + vdst) = vreg; if (MODE == 0 && tid < 256) *(LAS u32x4*)(lds + AT_K0 + rdst) = rreg;
    __syncthreads();
    f32x16 o0, o1;
#pragma unroll
    for (int r = 0; r < 16; ++r) { o0[r] = 0.f; o1[r] = 0.f; }
    float lsum = 0.f; bool started = false;
    f32x16 negm;
#pragma unroll
    for (int r = 0; r < 16; ++r) negm[r] = 0.f;
    const LAS float* tbl = (const LAS float*)(lds + AT_TBL);
    for (int t = 0; t < ntile; ++t) {
        const int buf = t & 1;
        if (t + 1 < ntile) { kreg = *(const u32x4*)(kg + (size_t)(t + 1) * 64 * ldk); vreg = *(const u32x4*)(vg + (size_t)(t + 1) * 64 * ldv);
            if (MODE == 0 && tid < 256) rreg = *(const u32x4*)(rg + (size_t)(t + 1) * 64 * 32);
            if (MODE == 1) mwn = *(const u32x2*)(mg + 2 * (t + 1)); }
        const int k0 = 64 * t;
        if (k0 <= qw0 + 31) {
            const LAS unsigned char* kb = lds + AT_K0 + buf * AT_KSZ; const LAS unsigned char* vb = lds + AT_V0 + buf * AT_VSZ;
            f32x16 s0, s1;
#pragma unroll
            for (int ks = 0; ks < KS; ++ks) { const int c = 2 * ks + hh;
                const bf16x8 a0 = *(const LAS bf16x8*)(kb + c * 1024 + ((q32 ^ (c & 7)) << 4));
                const bf16x8 a1 = *(const LAS bf16x8*)(kb + c * 1024 + (((32 + q32) ^ (c & 7)) << 4));
                if (ks == 0) { s0 = __builtin_amdgcn_mfma_f32_32x32x16_bf16(a0, qf[0], negm, 0, 0, 0); s1 = __builtin_amdgcn_mfma_f32_32x32x16_bf16(a1, qf[0], negm, 0, 0, 0); }
                else { s0 = __builtin_amdgcn_mfma_f32_32x32x16_bf16(a0, qf[ks], s0, 0, 0, 0); s1 = __builtin_amdgcn_mfma_f32_32x32x16_bf16(a1, qf[ks], s1, 0, 0, 0); } }
            if (MODE == 0) { if (k0 + 63 > qw0) {
#pragma unroll
                for (int r = 0; r < 16; ++r) { const int key = k0 + (r & 3) + 8 * (r >> 2) + 4 * hh; if (key > qpos) s0[r] = -INFINITY; if (key + 32 > qpos) s1[r] = -INFINITY; } } }
            if (MODE == 1) { const unsigned w0 = mw[0] >> (4 * hh), w1 = mw[1] >> (4 * hh); const LAS float* tp = tbl + (qpos - k0 - 4 * hh + 64);
#pragma unroll
                for (int r = 0; r < 16; ++r) { const int bit = (r & 3) + 8 * (r >> 2);
                    const float t0 = tp[-bit], t1 = tp[-bit - 32];
                    s0[r] = ((w0 >> bit) & 1u) ? s0[r] + t0 : -INFINITY; s1[r] = ((w1 >> bit) & 1u) ? s1[r] + t1 : -INFINITY; } }
            if (MODE == 2) { const LAS float* tp = tbl + (qpos - k0 - 4 * hh + 64);
#pragma unroll
                for (int r = 0; r < 16; ++r) { const int bit = (r & 3) + 8 * (r >> 2); s0[r] += tp[-bit]; s1[r] += tp[-bit - 32]; } }
            float mx = fmaxf(s0[0], s1[0]);
#pragma unroll
            for (int r = 1; r < 16; ++r) mx = fmaxf(mx, fmaxf(s0[r], s1[r]));
            mx = fmaxf(mx, __shfl_xor(mx, 32));
            const bool need = (mx > 8.0f) || (!started && mx > -INFINITY);
            if (__any(need)) {
                const float delta = need ? mx : 0.f, alpha = __builtin_amdgcn_exp2f(-delta);
                lsum *= alpha;
#pragma unroll
                for (int r = 0; r < 16; ++r) { o0[r] *= alpha; o1[r] *= alpha; negm[r] -= delta; s0[r] -= delta; s1[r] -= delta; }
            }
            started = started || (mx > -INFINITY);
            float ps = 0.f;
#pragma unroll
            for (int r = 0; r < 16; ++r) { s0[r] = __builtin_amdgcn_exp2f(s0[r]); s1[r] = __builtin_amdgcn_exp2f(s1[r]); ps += s0[r] + s1[r]; }
            lsum += ps;
            bf16x8 pb[4];
#pragma unroll
            for (int s2 = 0; s2 < 2; ++s2) {
                u32x4 a = {cvt_pk(s0[8 * s2 + 0], s0[8 * s2 + 1]), cvt_pk(s0[8 * s2 + 2], s0[8 * s2 + 3]), cvt_pk(s0[8 * s2 + 4], s0[8 * s2 + 5]), cvt_pk(s0[8 * s2 + 6], s0[8 * s2 + 7])};
                u32x4 c = {cvt_pk(s1[8 * s2 + 0], s1[8 * s2 + 1]), cvt_pk(s1[8 * s2 + 2], s1[8 * s2 + 3]), cvt_pk(s1[8 * s2 + 4], s1[8 * s2 + 5]), cvt_pk(s1[8 * s2 + 6], s1[8 * s2 + 7])};
                pb[s2] = __builtin_bit_cast(bf16x8, a); pb[2 + s2] = __builtin_bit_cast(bf16x8, c); }
            const int vlane = (4 * hh + ((lane & 15) >> 2)) * 64 + (((lane >> 4) & 1) * 16 + 4 * (lane & 3)) * 2;
#pragma unroll
            for (int dt = 0; dt < 2; ++dt) {
#pragma unroll
                for (int kk = 0; kk < 4; ++kk) {
                    const LAS unsigned char* va = vb + dt * 4096 + kk * 16 * 64 + vlane;
                    const s16x4 lo = __builtin_bit_cast(s16x4, __builtin_amdgcn_ds_read_tr16_b64_v4i16((LAS s16x4*)(va)));
                    const s16x4 hi = __builtin_bit_cast(s16x4, __builtin_amdgcn_ds_read_tr16_b64_v4i16((LAS s16x4*)(va + 8 * 64)));
                    const bf16x8 vf = {lo[0], lo[1], lo[2], lo[3], hi[0], hi[1], hi[2], hi[3]};
                    if (dt == 0) o0 = __builtin_amdgcn_mfma_f32_32x32x16_bf16(vf, pb[kk], o0, 0, 0, 0);
                    else o1 = __builtin_amdgcn_mfma_f32_32x32x16_bf16(vf, pb[kk], o1, 0, 0, 0); } }
        }
        if (t + 1 < ntile) { const int nb = (t + 1) & 1;
            *(LAS u32x4*)(lds + AT_K0 + nb * AT_KSZ + kdst) = kreg; *(LAS u32x4*)(lds + AT_V0 + nb * AT_VSZ + vdst) = vreg;
            if (MODE == 0 && tid < 256) *(LAS u32x4*)(lds + AT_K0 + nb * AT_KSZ + rdst) = rreg;
            if (MODE == 1) mw = mwn; }
        __syncthreads();
    }
    const float ltot = lsum + __shfl_xor(lsum, 32);
    const float inv = ltot > 0.f ? 1.0f / ltot : 0.f;
    const float inv16 = inv * AO_SCALE;
    unsigned char* orow = Op + (tb + qpos) * 1024 + 8 * hh;
#pragma unroll
    for (int k = 0; k < 2; ++k) {
        const auto r0 = __builtin_amdgcn_permlane32_swap(pk_fp8x4(o0[8 * k] * inv16, o0[8 * k + 1] * inv16, o0[8 * k + 2] * inv16, o0[8 * k + 3] * inv16),
                                                         pk_fp8x4(o0[8 * k + 4] * inv16, o0[8 * k + 5] * inv16, o0[8 * k + 6] * inv16, o0[8 * k + 7] * inv16), false, false);
        const auto r1 = __builtin_amdgcn_permlane32_swap(pk_fp8x4(o1[8 * k] * inv16, o1[8 * k + 1] * inv16, o1[8 * k + 2] * inv16, o1[8 * k + 3] * inv16),
                                                         pk_fp8x4(o1[8 * k + 4] * inv16, o1[8 * k + 5] * inv16, o1[8 * k + 6] * inv16, o1[8 * k + 7] * inv16), false, false);
        *(u32x2*)(orow + 16 * k) = (u32x2){r0[0], r0[1]}; *(u32x2*)(orow + 32 + 16 * k) = (u32x2){r1[0], r1[1]}; }
}

__device__ __forceinline__ void phase_attention(const Frame& F, const Params& p, const int l) {
    int slice = 0;
    constexpr int KTOT = (65 * 384 + 2047) / 2048 + 1;
    for (int L = (int)blockIdx.x; L < 2048; L += F.G) {
        const int level = L >> 8, idx = ((L & 255) + 37 * level) & 255, qb = 7 - level;
        if (idx < 96) { const int b = idx / 6, h = idx % 6;
            attn_unit<0, 6>(F, b, qb, fMQ(F) + h * 96, 576, fMK(F) + h * 64, 384, fKR(F), fMV(F) + h * 64, 384, fAO(F) + 640 + h * 64, nullptr, nullptr, 0);
        } else if (idx < 160) { const int j = idx - 96, b = j >> 2, h = j & 3;
            attn_unit<1, 4>(F, b, qb, fU(F) + U_SQ + h * 64, LDU, fU(F) + U_SK + h * 64, LDU, nullptr, fU(F) + U_SV + h * 64, LDU, fAO(F) + 384 + h * 64, fMASK(F), fDTAB(F), 6 + h);
        } else { const int j = idx - 160, b = j / 6, h = j % 6;
            attn_unit<2, 4>(F, b, qb, fU(F) + U_DQ + h * 64, LDU, fU(F) + U_DK + h * 64, LDU, nullptr, fU(F) + U_DV + h * 64, LDU, fAO(F) + h * 64, nullptr, fDTAB(F), h);
        }
        convert_experts(F, p, l, 2 * slice, 2 * slice + 2, 65536); ++slice;
    }
    { const int NGW = F.G * NWAVES; const int kmax = (65 * 384 + NGW - 1) / NGW; if (2 * slice < kmax) convert_experts(F, p, l, 2 * slice, kmax, 65536); }
}
__device__ __forceinline__ int wave_isum(int c) {
    c += __builtin_amdgcn_update_dpp(0, c, 0x128, 0xf, 0xf, false);
    c += __builtin_amdgcn_update_dpp(0, c, 0x124, 0xf, 0xf, false);
    c += __builtin_amdgcn_update_dpp(0, c, 0x122, 0xf, 0xf, false);
    c += __builtin_amdgcn_update_dpp(0, c, 0x121, 0xf, 0xf, false);
    return __builtin_amdgcn_readlane(c, 0) + __builtin_amdgcn_readlane(c, 16) + __builtin_amdgcn_readlane(c, 32) + __builtin_amdgcn_readlane(c, 48);
}
__device__ __forceinline__ float wave_fmax(float v) {
#define DPPF(x, c) __builtin_bit_cast(float, __builtin_amdgcn_update_dpp(0, __builtin_bit_cast(int, x), c, 0xf, 0xf, false))
    v = fmaxf(v, DPPF(v, 0x128)); v = fmaxf(v, DPPF(v, 0x124)); v = fmaxf(v, DPPF(v, 0x122)); v = fmaxf(v, DPPF(v, 0x121));
    const int i = __builtin_bit_cast(int, v);
    return fmaxf(fmaxf(__builtin_bit_cast(float, __builtin_amdgcn_readlane(i, 0)), __builtin_bit_cast(float, __builtin_amdgcn_readlane(i, 16))), fmaxf(__builtin_bit_cast(float, __builtin_amdgcn_readlane(i, 32)), __builtin_bit_cast(float, __builtin_amdgcn_readlane(i, 48))));
}
__device__ __forceinline__ float wave_fmin(float v) {
    v = fminf(v, DPPF(v, 0x128)); v = fminf(v, DPPF(v, 0x124)); v = fminf(v, DPPF(v, 0x122)); v = fminf(v, DPPF(v, 0x121));
    const int i = __builtin_bit_cast(int, v);
    return fminf(fminf(__builtin_bit_cast(float, __builtin_amdgcn_readlane(i, 0)), __builtin_bit_cast(float, __builtin_amdgcn_readlane(i, 16))), fminf(__builtin_bit_cast(float, __builtin_amdgcn_readlane(i, 32)), __builtin_bit_cast(float, __builtin_amdgcn_readlane(i, 48))));
#undef DPPF
}
template <int NJ> __device__ __forceinline__ int count_ge(const float (&x)[32], const float v) {
    unsigned acc = 0u;
#pragma unroll
    for (int j = 0; j < NJ; ++j) acc = __builtin_amdgcn_alignbit(acc, __builtin_bit_cast(unsigned, x[j] - v), 31);
    return 64 * NJ - wave_isum(__builtin_popcount(acc));
}
template <int NJ> __device__ __forceinline__ unsigned long long select_row(const LAS float* srow, const int q, const int lane) {
    float x[32];
#pragma unroll
    for (int j = 0; j < NJ; ++j) x[j] = srow[64 * j];
#pragma unroll
    for (int j = 0; j < NJ; ++j) x[j] = (64 * j + lane <= q) ? x[j] : -INFINITY;
    float mx = -INFINITY, mn = INFINITY;
#pragma unroll
    for (int j = 0; j < NJ; ++j) { mx = fmaxf(mx, x[j]); mn = fminf(mn, x[j] == -INFINITY ? INFINITY : x[j]); }
    float lo = wave_fmin(mn), hi = wave_fmax(mx);
    float thr = 0.f; bool exact = false;
    int c_hi = count_ge<NJ>(x, hi), c_lo = q + 1;
    if (c_hi < 256) {
#pragma unroll 1
        for (int it = 0; it < 320; ++it) {
            float mid = 0.5f * lo + 0.5f * hi;
            if (!(mid > lo && mid < hi)) break;
            if (false) { const float fr = ((float)(c_lo - 256) + 0.5f) / (float)(c_lo - c_hi), tc = lo + fr * (hi - lo); if (tc > lo && tc < hi) mid = tc; }
            const int c = count_ge<NJ>(x, mid);
            if (c == 256) { thr = mid; exact = true; break; }
            if (c > 256) { lo = mid; c_lo = c; } else { hi = mid; c_hi = c; }
        }
    } else { lo = hi; hi = INFINITY; c_hi = 0; }
    unsigned long long myw = 0ull;
    if (exact) {
#pragma unroll
        for (int j = 0; j < NJ; ++j) { const unsigned long long sel = __ballot(x[j] >= thr); if (lane == j) myw = sel; }
    } else {
        int need = 256 - c_hi;
#pragma unroll 1
        for (int j = 0; j < NJ; ++j) { float xj = x[0];
#pragma unroll
            for (int k = 1; k < NJ; ++k) xj = (k == j) ? x[k] : xj;
            const unsigned long long eq = __ballot(xj == lo); const int rank = __builtin_popcountll(eq & ((1ull << lane) - 1ull));
            const unsigned long long sel = __ballot(xj >= hi) | __ballot(xj == lo && rank < need); const int ne = __builtin_popcountll(eq); need = need > ne ? need - ne : 0;
            if (lane == j) myw = sel; }
    }
    return myw;
}
constexpr int IX_PITCH = 2052, IX_IQ = 16 * IX_PITCH * 4, IX_IW = IX_IQ + 16384;
typedef float f32x4_t __attribute__((ext_vector_type(4)));
__device__ __forceinline__ void indexer_block(const Frame& F, const int b, const int qk) {
    LAS unsigned char* lds = F.lds;
    const int tid = F.tid, lane = F.lane, w = F.wave, q16 = lane & 15, kg = lane >> 4;
    const size_t tb = (size_t)b * SEQ; const int q0 = 16 * qk, ntile = qk + 1;
    LAS float* sl = (LAS float*)lds;
    __syncthreads();
#pragma unroll
    for (int i = 0; i < 2; ++i) { const int idx = tid + 512 * i, q = idx >> 6, c = idx & 63;
        *(LAS u32x4*)(lds + IX_IQ + c * 256 + q * 16) = *(const u32x4*)(fU(F) + (tb + q0 + q) * LDU + U_IQ + 8 * c); }
    if (tid < 128) { const int q = tid >> 3, h8 = tid & 7; ((LAS float*)(lds + IX_IW))[h8 * 16 + q] = bf2f(fU(F)[(tb + q0 + q) * LDU + U_IW + h8]); }
    __syncthreads();
    const int qpos = q0 + q16;
    bf16x8 kf[2];
    if (w < ntile) { const bf16_t* kr = fU(F) + (tb + 16 * w + q16) * LDU + U_IK + 8 * kg; kf[0] = *(const bf16x8*)kr; kf[1] = *(const bf16x8*)(kr + 32); }
#pragma unroll 1
    for (int ti = w; ti < ntile; ti += NWAVES) {
        const int key0 = 16 * ti;
        bf16x8 kn[2];
        { const int tn = (ti + NWAVES < ntile) ? ti + NWAVES : ti; const bf16_t* kr = fU(F) + (tb + 16 * tn + q16) * LDU + U_IK + 8 * kg; kn[0] = *(const bf16x8*)kr; kn[1] = *(const bf16x8*)(kr + 32); }
        f32x4 sc = {0.f, 0.f, 0.f, 0.f};
#pragma unroll
        for (int h8 = 0; h8 < 8; ++h8) {
            const float iwq = ((const LAS float*)(lds + IX_IW))[h8 * 16 + q16];
            f32x4 a = {0.f, 0.f, 0.f, 0.f};
#pragma unroll
            for (int ks = 0; ks < 2; ++ks) { const bf16x8 qv = *(const LAS bf16x8*)(lds + IX_IQ + (8 * h8 + 4 * ks + kg) * 256 + q16 * 16);
                a = __builtin_amdgcn_mfma_f32_16x16x32_bf16(kf[ks], qv, a, 0, 0, 0); }
#pragma unroll
            for (int r = 0; r < 4; ++r) sc[r] += iwq * fmaxf(a[r], 0.f);
        }
        if (ti == qk) {
#pragma unroll
            for (int r = 0; r < 4; ++r) { const int key = key0 + 4 * kg + r; if (key > qpos) sc[r] = -INFINITY; } }
        *(LAS f32x4*)(sl + q16 * IX_PITCH + key0 + 4 * kg) = sc;
        kf[0] = kn[0]; kf[1] = kn[1];
    }
    __syncthreads();
#pragma unroll 1
    for (int rr = 0; rr < 2; ++rr) {
        const int ql = w + 8 * rr, q = q0 + ql, n = q + 1;
        unsigned long long myw = 0ull;
        if (n <= 256) {
            if (lane < 32) { const int lo = 64 * lane; myw = (lo + 63 <= q) ? ~0ull : (lo <= q ? ((1ull << (q - lo + 1)) - 1ull) : 0ull); }
        } else {
            const LAS float* srow = sl + ql * IX_PITCH + lane; const int nj = (q0 + 16 + 63) >> 6;
            if (nj <= 8) myw = select_row<8>(srow, q, lane); else if (nj <= 16) myw = select_row<16>(srow, q, lane); else if (nj <= 24) myw = select_row<24>(srow, q, lane); else myw = select_row<32>(srow, q, lane);
        }
        if (lane < 32) *(unsigned long long*)(fMASK(F) + (tb + q) * 64 + 2 * lane) = myw;
    }
}
__device__ __forceinline__ void phase_indexer(const Frame& F) {
    for (int L = (int)blockIdx.x; L < 1024; L += F.G) { const int b = L >> 6, j = L & 63;
#pragma unroll 1
        for (int s = 0; s < 2; ++s) indexer_block(F, b, s ? j : 127 - j); }
}

__device__ __forceinline__ void ln_finish(const Frame& F, float (&v)[16], const float* g, const float* bta, bf16_t* ob, float* of, unsigned char* o8 = nullptr) {
    float s = 0.f;
#pragma unroll
    for (int j = 0; j < 16; ++j) s += v[j];
    const float mean = wave_sum(s) * (1.f / 1024.f); float s2 = 0.f;
#pragma unroll
    for (int j = 0; j < 16; ++j) { v[j] -= mean; s2 += v[j] * v[j]; }
    const float rstd = 1.f / sqrtf(wave_sum(s2) * (1.f / 1024.f) + LN_EPS);
    const int c0 = 16 * F.lane; float o[16];
#pragma unroll
    for (int q4 = 0; q4 < 4; ++q4) { const f32x4 gg = *(const f32x4*)(g + c0 + 4 * q4), bb = *(const f32x4*)(bta + c0 + 4 * q4);
#pragma unroll
        for (int j = 0; j < 4; ++j) o[4 * q4 + j] = v[4 * q4 + j] * rstd * gg[j] + bb[j]; }
    if (ob) { *(u32x4*)(ob + c0) = (u32x4){cvt_pk(o[0], o[1]), cvt_pk(o[2], o[3]), cvt_pk(o[4], o[5]), cvt_pk(o[6], o[7])};
              *(u32x4*)(ob + c0 + 8) = (u32x4){cvt_pk(o[8], o[9]), cvt_pk(o[10], o[11]), cvt_pk(o[12], o[13]), cvt_pk(o[14], o[15])}; }
    if (o8) *(u32x4*)(o8 + c0) = (u32x4){pk_fp8x4(o[0] * X8_SCALE, o[1] * X8_SCALE, o[2] * X8_SCALE, o[3] * X8_SCALE), pk_fp8x4(o[4] * X8_SCALE, o[5] * X8_SCALE, o[6] * X8_SCALE, o[7] * X8_SCALE),
                                          pk_fp8x4(o[8] * X8_SCALE, o[9] * X8_SCALE, o[10] * X8_SCALE, o[11] * X8_SCALE), pk_fp8x4(o[12] * X8_SCALE, o[13] * X8_SCALE, o[14] * X8_SCALE, o[15] * X8_SCALE)};
    if (of) {
#pragma unroll
        for (int q4 = 0; q4 < 4; ++q4) *(f32x4*)(of + c0 + 4 * q4) = (f32x4){o[4 * q4], o[4 * q4 + 1], o[4 * q4 + 2], o[4 * q4 + 3]}; }
}
__device__ __forceinline__ void ld16(float (&v)[16], const bf16_t* row, int lane, float sc) {
#pragma unroll
    for (int h = 0; h < 2; ++h) { const u32x4 q = *(const u32x4*)(row + 16 * lane + 8 * h);
#pragma unroll
        for (int j = 0; j < 4; ++j) { v[8 * h + 2 * j] = sc * bf2f(q[j] & 0xffffu); v[8 * h + 2 * j + 1] = sc * bf2f(q[j] >> 16); } }
}
__device__ __forceinline__ void add16(float (&v)[16], const bf16_t* row, int lane) {
#pragma unroll
    for (int h = 0; h < 2; ++h) { const u32x4 q = *(const u32x4*)(row + 16 * lane + 8 * h);
#pragma unroll
        for (int j = 0; j < 4; ++j) { v[8 * h + 2 * j] += bf2f(q[j] & 0xffffu); v[8 * h + 2 * j + 1] += bf2f(q[j] >> 16); } }
}
typedef float f32x2v __attribute__((ext_vector_type(2)));
__device__ __forceinline__ void add16_fp8(float (&v)[16], const unsigned char* row, int lane) {
    const u32x4 q = __builtin_nontemporal_load((const u32x4*)(row + 16 * lane));
#pragma unroll
    for (int j = 0; j < 4; ++j) { const f32x2v a = __builtin_amdgcn_cvt_pk_f32_fp8((int)q[j], false), b = __builtin_amdgcn_cvt_pk_f32_fp8((int)q[j], true);
        v[4 * j] += a[0]; v[4 * j + 1] += a[1]; v[4 * j + 2] += b[0]; v[4 * j + 3] += b[1]; }
}
__device__ __forceinline__ void phase_ln1(const Frame& F, const Params& p, int l) {
    const int gw = F.vcu * NWAVES + F.wave, NGW = F.G * NWAVES;
    for (int m = gw; m < T; m += NGW) { bf16_t* row = fXB(F) + (size_t)m * 1024; float v[16]; ld16(v, row, F.lane, 1.0f);
        ln_finish(F, v, p.ln1_g + l * 1024, p.ln1_b + l * 1024, row, nullptr, fXB8(F) + (size_t)m * 1024); }
}
__device__ __forceinline__ void phase_ln2(const Frame& F, const Params& p, int l) {
    const int gw = F.vcu * NWAVES + F.wave, NGW = F.G * NWAVES; const bool lastl = (l == NL - 1);
    LAS int* cb = (LAS int*)(F.lds + LDS_TBL);
    __syncthreads();
    if (F.tid == 0) { int c = 0; for (int e = 0; e < 64; ++e) { cb[e] = c; c += (int)F.ctl[CW_CNT + l * 64 + e]; } }
    __syncthreads();
    for (int m = gw; m < T; m += NGW) { bf16_t* row = fXB(F) + (size_t)m * 1024;
        const unsigned pkv = fPK(F)[(size_t)m * 8 + (F.lane & 7)];
        float r[16];
#pragma unroll
        for (int j = 0; j < 16; ++j) r[j] = 0.f;
#pragma unroll
        for (int k = 0; k < 8; ++k) { const unsigned pe = (unsigned)__builtin_amdgcn_readlane((int)pkv, k); const int srow = cb[pe >> 16] + (int)(pe & 0xffffu);
            add16_fp8(r, fYB(F) + (size_t)srow * 1024, F.lane); }
        float v[16]; ld16(v, row, F.lane, DN_ALPHA); add16(v, fSH(F) + (size_t)m * 1024, F.lane);
#pragma unroll
        for (int j = 0; j < 16; ++j) v[j] += r[j] * (1.0f / YB_SCALE);
        ln_finish(F, v, p.ln2_g + l * 1024, p.ln2_b + l * 1024, lastl ? nullptr : row, lastl ? p.out + (size_t)m * 1024 : nullptr, lastl ? nullptr : fXB8(F) + (size_t)m * 1024); }
}

__device__ __forceinline__ void phase_route(const Frame& F, const Params& p, int l) {
    LAS int* lcnt = (LAS int*)(F.lds + LDS_TBL + 8192); LAS int* lbase = lcnt + 64;
    const float* rb = p.router_b + l * 64;
    const int nth = F.G * NTHR, iters = (T + nth - 1) / nth;
    for (int it = 0; it < iters; ++it) {
        const int t = it * nth + F.vcu * NTHR + F.tid; const bool act = t < T;
        __syncthreads();
        if (F.tid < 64) lcnt[F.tid] = 0;
        __syncthreads();
        int ek[8], pk[8]; float gk[8];
        if (act) {
            float sel[64];
            const float* l0 = fLG(F) + (size_t)t * 64; const float* l1 = fLG(F) + ((size_t)T + t) * 64;
#pragma unroll
            for (int e4 = 0; e4 < 16; ++e4) { const f32x4 a = *(const f32x4*)(l0 + 4 * e4), c = *(const f32x4*)(l1 + 4 * e4), bb = *(const f32x4*)(rb + 4 * e4);
#pragma unroll
                for (int j = 0; j < 4; ++j) sel[4 * e4 + j] = 1.0f / (1.0f + __expf(-(a[j] + c[j]))) + bb[j]; }
            float gs = 0.f;
#pragma unroll
            for (int k = 0; k < 8; ++k) { float best = -INFINITY; int bi = 0;
#pragma unroll
                for (int e = 0; e < 64; ++e) { const bool gt = sel[e] > best; best = gt ? sel[e] : best; bi = gt ? e : bi; }
#pragma unroll
                for (int e = 0; e < 64; ++e) sel[e] = (e == bi) ? -INFINITY : sel[e];
                ek[k] = bi; gk[k] = best - rb[bi]; gs += gk[k]; }
            const float sc = ROUTED_SCALE / gs;
#pragma unroll
            for (int k = 0; k < 8; ++k) { gk[k] *= sc; pk[k] = __hip_atomic_fetch_add(lcnt + ek[k], 1, __ATOMIC_RELAXED, __HIP_MEMORY_SCOPE_WORKGROUP); }
        }
        __syncthreads();
        if (F.tid < 64) { const int c = lcnt[F.tid]; lbase[F.tid] = c ? (int)__hip_atomic_fetch_add(F.ctl + CW_CNT + l * 64 + F.tid, (unsigned)c, __ATOMIC_RELAXED, __HIP_MEMORY_SCOPE_AGENT) : 0; }
        __syncthreads();
        if (act) {
#pragma unroll
            for (int k = 0; k < 8; ++k) { const int pos = lbase[ek[k]] + pk[k]; fLST(F)[(size_t)ek[k] * T + pos] = (unsigned)t; fGS(F)[(size_t)ek[k] * T + pos] = gk[k]; fPK(F)[(size_t)t * 8 + k] = ((unsigned)ek[k] << 16) | (unsigned)pos; } }
    }
}
__device__ __forceinline__ void frame_init(Frame& F, const Params& p, unsigned char* lds) {
    F.lds = (LAS unsigned char*)lds; F.MISC = (volatile LAS unsigned*)(F.lds + LDS_MISC);
    F.tid = threadIdx.x; F.lane = F.tid & 63; F.wave = __builtin_amdgcn_readfirstlane(F.tid >> 6);
    F.G = gridDim.x; { const int bx = blockIdx.x; F.vcu = (F.G % 8 == 0) ? (bx % 8) * (F.G / 8) + bx / 8 : bx; }
    F.ws = p.ws; F.ctl = (unsigned*)(p.ws + WS_CTL);
}

constexpr int NPHASE = 1 + 10 * NL;
__global__ void __launch_bounds__(NTHR, 2) mega(Params p) {
    extern __shared__ __attribute__((aligned(16))) unsigned char lds_raw[];
    Frame F; frame_init(F, p, lds_raw);
    if (F.tid < 64) F.MISC[F.tid] = 0u;
    __syncthreads();
    const int lo = p.ph_lo, hi = p.ph_hi;
    XcdBarrier bar; bar.bar = F.ctl + CW_BAR; bar.x = 0; bar.st = F.MISC + 8;
    if (hi - lo > 1) bar = xcd_barrier_post(F.ctl + CW_BAR, F.MISC + 8);
#define IN(k) (lo <= (k) && (k) < hi)
#define SEAM(k) do { if (IN(k) && IN((k) + 1)) xcd_barrier(bar); } while (0)
    if (IN(0)) { const Frame Fp = phase_frame(F); phase_x_to_xb(Fp, p.x); phase_rope_table(Fp, p.pos); phase_dist_tables(Fp, p.rel_bias); convert_small(Fp, p, 0); }
    SEAM(0);
    for (int l = 0; l < NL; ++l) {
        const int pb = 1 + 10 * l;
        if (IN(pb + 0)) phase_inproj(phase_frame(F));
        SEAM(pb + 0);
        if (IN(pb + 1)) { phase_indexer(phase_frame(F)); phase_mla_up(phase_frame(F), p); }
        SEAM(pb + 1);
        if (IN(pb + 2)) phase_attention(phase_frame(F), p, l);
        SEAM(pb + 2);
        if (IN(pb + 3)) phase_outproj(phase_frame(F));
        SEAM(pb + 3);
        if (IN(pb + 4)) phase_ln1(phase_frame(F), p, l);
        SEAM(pb + 4);
        if (IN(pb + 5)) phase_router_sharedg1(phase_frame(F));
        SEAM(pb + 5);
        if (IN(pb + 6)) phase_route(phase_frame(F), p, l);
        SEAM(pb + 6);
        if (IN(pb + 7)) phase_moe_g1(phase_frame(F), l);
        SEAM(pb + 7);
        if (IN(pb + 8)) { phase_moe_g2(phase_frame(F), l); phase_shared_g2(phase_frame(F)); }
        SEAM(pb + 8);
        if (IN(pb + 9)) { phase_ln2(phase_frame(F), p, l); if (l + 1 < NL) convert_small(phase_frame(F), p, l + 1); }
        SEAM(pb + 9);
    }
#undef IN
#undef SEAM
}
#ifndef DBG
#define DBG 0
#endif
#if DBG
#endif
extern "C" void kernel_launch(void* const* d_in, const int* in_sizes, int n_in, void* d_out, int out_size, void* d_ws, size_t ws_size, hipStream_t stream) {
    static int grid = 0;
    if (grid == 0) {
        if (n_in != 21 || out_size != T * DM || ws_size < WS_END) { fprintf(stderr, "kernel_launch: unexpected problem (n_in %d, out %d, ws %zu < %zu); nothing launched\n", n_in, out_size, ws_size, (size_t)WS_END); grid = -1; return; }
        int dev = 0, cus = 0, per_cu = 0;
        if (hipGetDevice(&dev) != hipSuccess || hipDeviceGetAttribute(&cus, hipDeviceAttributeMultiprocessorCount, dev) != hipSuccess) { grid = -1; return; }
        if (hipFuncSetAttribute((const void*)mega, hipFuncAttributeMaxDynamicSharedMemorySize, LDS_BYTES) != hipSuccess) { fprintf(stderr, "kernel_launch: hipFuncSetAttribute failed\n"); grid = -1; return; }
        if (hipOccupancyMaxActiveBlocksPerMultiprocessor(&per_cu, (const void*)mega, NTHR, LDS_BYTES) != hipSuccess || per_cu < 1) { fprintf(stderr, "kernel_launch: occupancy query says %d\n", per_cu); (void)hipGetLastError(); per_cu = 1; }
        grid = cus > 256 ? 256 : cus;
    }
    if (grid < 0) return;
    (void)hipMemsetAsync((char*)d_ws + WS_CTL, 0, CTL_BYTES, stream);
    Params p{};
    p.x = (const float*)d_in[0]; p.pos = (const int*)d_in[1]; p.w_in = (const float*)d_in[2]; p.q_norm = (const float*)d_in[3]; p.w_uq = (const float*)d_in[4];
    p.kv_norm = (const float*)d_in[5]; p.w_ukv = (const float*)d_in[6]; p.w_out = (const float*)d_in[7]; p.ln1_g = (const float*)d_in[8]; p.ln1_b = (const float*)d_in[9];
    p.router_w = (const float*)d_in[10]; p.router_b = (const float*)d_in[11]; p.w1 = (const float*)d_in[12]; p.w3 = (const float*)d_in[13]; p.w2 = (const float*)d_in[14];
    p.sw1 = (const float*)d_in[15]; p.sw3 = (const float*)d_in[16]; p.sw2 = (const float*)d_in[17]; p.ln2_g = (const float*)d_in[18]; p.ln2_b = (const float*)d_in[19]; p.rel_bias = (const float*)d_in[20];
    p.out = (float*)d_out; p.ws = (unsigned char*)d_ws;
#if DBG
    dbg_run(p, grid, stream);
#elif defined(MULTI_LAUNCH)
    for (int k = 0; k < NPHASE; ++k) { p.ph_lo = k; p.ph_hi = k + 1; mega<<<dim3(grid), dim3(NTHR), LDS_BYTES, stream>>>(p); }
#else
    p.ph_lo = 0; p.ph_hi = NPHASE;
    mega<<<dim3(grid), dim3(NTHR), LDS_BYTES, stream>>>(p);
#endif
}
```
